# Optimizing an MI355X kernel written in HIP

```python
import jax, jax.numpy as jnp
from jax import lax
import numpy as np

D_MODEL = 1024
BATCH = 16
SEQ = 2048
DEPTH = 2

ATT_HEADS = 8
ATT_KV_HEADS = 2
ATT_HEAD_DIM = 64
ATT_GROUP = ATT_HEADS // ATT_KV_HEADS
WINDOW = 128
ATT_BLOCK = 128
RET_HEADS = 4
RET_KEY_DIM = 128
RET_VAL_DIM = 256
RET_CHUNK = 128
D_FF = -(-8 * D_MODEL // (3 * 256)) * 256
EPS = 1e-6

ATT_Q_W = ATT_HEADS * ATT_HEAD_DIM
ATT_KV_W = ATT_KV_HEADS * ATT_HEAD_DIM
RET_QK_W = RET_HEADS * RET_KEY_DIM
RET_V_W = RET_HEADS * RET_VAL_DIM
IN_WIDTHS = (ATT_Q_W, ATT_KV_W, ATT_KV_W, RET_QK_W, RET_QK_W, RET_V_W, RET_V_W, D_MODEL, D_MODEL)
D_IN = sum(IN_WIDTHS)

kernel_name = "hybrid_swa_sink_alibi_retention_gated_swiglu"


def rms_norm(x, g):
    xf = x.astype(jnp.float32)
    y = xf * lax.rsqrt(jnp.mean(xf * xf, axis=-1, keepdims=True) + EPS) * g.astype(jnp.float32)
    return y.astype(x.dtype)


def alibi_slopes(n_heads):
    return jnp.exp2(-8.0 * (jnp.arange(n_heads, dtype=jnp.float32) + 1.0) / n_heads)


def sliding_window_attention(q, k, v, sinks):
    b, s, _, hd = q.shape
    nb = s // ATT_BLOCK
    f32 = jnp.float32
    qb = q.astype(f32).reshape(b, nb, ATT_BLOCK, ATT_KV_HEADS, ATT_GROUP, hd) * (hd ** -0.5)

    def band(t):
        tp = jnp.pad(t.astype(f32), ((0, 0), (ATT_BLOCK, 0), (0, 0), (0, 0)))
        prev = tp[:, :s].reshape(b, nb, ATT_BLOCK, ATT_KV_HEADS, hd)
        cur = tp[:, ATT_BLOCK:].reshape(b, nb, ATT_BLOCK, ATT_KV_HEADS, hd)
        return jnp.concatenate([prev, cur], axis=2)

    kb, vb = band(k), band(v)
    i = jnp.arange(ATT_BLOCK)[:, None]
    j = jnp.arange(2 * ATT_BLOCK)[None, :]
    dist = i + ATT_BLOCK - j
    key_pos = jnp.arange(nb)[:, None, None] * ATT_BLOCK - ATT_BLOCK + j[None]
    valid = (dist >= 0) & (dist < WINDOW) & (key_pos >= 0)
    slopes = alibi_slopes(ATT_HEADS).reshape(ATT_KV_HEADS, ATT_GROUP)
    scores = jnp.einsum('bnikgd,bnjkd->bnkgij', qb, kb) - slopes[:, :, None, None] * dist.astype(f32)
    scores = jnp.where(valid[None, :, None, None], scores, -jnp.inf)
    sink = jnp.broadcast_to(sinks.astype(f32).reshape(ATT_KV_HEADS, ATT_GROUP)[None, None, :, :, None, None],
                            scores.shape[:-1] + (1,))
    probs = jax.nn.softmax(jnp.concatenate([scores, sink], axis=-1), axis=-1)[..., :-1]
    out = jnp.einsum('bnkgij,bnjkd->bnikgd', probs, vb)
    return out.reshape(b, s, ATT_Q_W)


def retention_chunkwise(q, k, v):
    b, s, h, dk = q.shape
    dv = v.shape[-1]
    nc = s // RET_CHUNK
    f32 = jnp.float32
    log_g = jnp.log(1.0 - jnp.exp2(-5.0 - jnp.arange(h, dtype=f32)))
    idx = jnp.arange(RET_CHUNK, dtype=f32)
    diff = idx[:, None] - idx[None, :]
    decay_intra = jnp.where(diff >= 0, jnp.exp(log_g[:, None, None] * jnp.maximum(diff, 0.0)), 0.0)
    decay_q = jnp.exp(log_g[:, None] * (idx + 1.0)).T[None, :, :, None]
    decay_k = jnp.exp(log_g[:, None] * (RET_CHUNK - 1.0 - idx)).T[None, :, :, None]
    decay_chunk = jnp.exp(log_g * RET_CHUNK)[None, :, None, None]

    def to_chunks(t):
        return t.astype(f32).reshape(b, nc, RET_CHUNK, h, t.shape[-1]).transpose(1, 0, 2, 3, 4)

    qc, kc, vc = to_chunks(q), to_chunks(k * (dk ** -0.5)), to_chunks(v)

    def step(state, inp):
        qi, ki, vi = inp
        scores = jnp.einsum('bihd,bjhd->bhij', qi, ki) * decay_intra
        o = jnp.einsum('bhij,bjhv->bihv', scores, vi)
        o = o + jnp.einsum('bihd,bhdv->bihv', qi, state) * decay_q
        state = decay_chunk * state + jnp.einsum('bjhd,bjhv->bhdv', ki * decay_k, vi)
        return state, o

    state0 = jnp.zeros((b, h, dk, dv), f32)
    _, o = lax.scan(step, state0, (qc, kc, vc))
    return o.transpose(1, 0, 2, 3, 4).reshape(b, s, h, dv)


def head_group_norm(o, gain):
    b, s, h, dv = o.shape
    mu = jnp.mean(o, axis=-1, keepdims=True)
    var = jnp.mean(jnp.square(o - mu), axis=-1, keepdims=True)
    return ((o - mu) * lax.rsqrt(var + EPS)).reshape(b, s, h * dv) * gain.astype(jnp.float32)


def setup_inputs(seed: int = 0) -> dict:
    key = jax.random.key(seed)
    ks = jax.random.split(key, 16)
    f32 = jnp.float32

    def w(k, shape, fan_in):
        return jax.random.normal(k, shape, f32) * (fan_in ** -0.5)

    return {
        "x": jax.random.normal(ks[0], (BATCH, SEQ, D_MODEL), f32),
        "norm_mix": 1.0 + 0.02 * jax.random.normal(ks[1], (DEPTH, D_MODEL), f32),
        "w_in": w(ks[2], (DEPTH, D_MODEL, D_IN), D_MODEL),
        "att_sinks": 0.5 * jax.random.normal(ks[3], (DEPTH, ATT_HEADS), f32),
        "ret_gn_gain": 1.0 + 0.02 * jax.random.normal(ks[4], (DEPTH, RET_V_W), f32),
        "w_att_o": w(ks[5], (DEPTH, ATT_Q_W, D_MODEL), ATT_Q_W),
        "w_ret_o": w(ks[6], (DEPTH, RET_V_W, D_MODEL), RET_V_W),
        "w_out": w(ks[7], (DEPTH, D_MODEL, D_MODEL), D_MODEL),
        "norm_ffn": 1.0 + 0.02 * jax.random.normal(ks[8], (DEPTH, D_MODEL), f32),
        "w_gate": w(ks[9], (DEPTH, D_MODEL, D_FF), D_MODEL),
        "w_up": w(ks[10], (DEPTH, D_MODEL, D_FF), D_MODEL),
        "w_down": w(ks[11], (DEPTH, D_FF, D_MODEL), D_FF),
        "final_norm": 1.0 + 0.02 * jax.random.normal(ks[12], (D_MODEL,), f32),
    }


def reference(x, norm_mix, w_in, att_sinks, ret_gn_gain, w_att_o, w_ret_o, w_out,
              norm_ffn, w_gate, w_up, w_down, final_norm):
    b, s, _ = x.shape
    offsets = [int(o) for o in np.cumsum(IN_WIDTHS)[:-1]]
    for l in range(DEPTH):
        h = rms_norm(x, norm_mix[l])
        proj = h @ w_in[l]
        aq, ak, av, rq, rk, rv, rg, ga, gr = jnp.split(proj, offsets, axis=-1)
        att = sliding_window_attention(
            aq.reshape(b, s, ATT_HEADS, ATT_HEAD_DIM),
            ak.reshape(b, s, ATT_KV_HEADS, ATT_HEAD_DIM),
            av.reshape(b, s, ATT_KV_HEADS, ATT_HEAD_DIM),
            att_sinks[l]).astype(x.dtype)
        ret = retention_chunkwise(
            rq.reshape(b, s, RET_HEADS, RET_KEY_DIM),
            rk.reshape(b, s, RET_HEADS, RET_KEY_DIM),
            rv.reshape(b, s, RET_HEADS, RET_VAL_DIM))
        ret = head_group_norm(ret, ret_gn_gain[l]).astype(x.dtype) * jax.nn.silu(rg)
        merged = jax.nn.sigmoid(ga) * (att @ w_att_o[l]) + jax.nn.sigmoid(gr) * (ret @ w_ret_o[l])
        x = x + merged @ w_out[l]
        h = rms_norm(x, norm_ffn[l])
        x = x + (jax.nn.silu(h @ w_gate[l]) * (h @ w_up[l])) @ w_down[l]
    return rms_norm(x, final_norm)
```

```cpp
#include <hip/hip_runtime.h>
#include <cstdio>
#include <cstdint>

constexpr int D = 1024, BATCH = 16, SEQ = 2048, DEPTH = 2, T = BATCH * SEQ;
constexpr int AH = 8, AHD = 64;
constexpr int RH = 4, RDK = 128, RDV = 256;
constexpr int DFF = 2816, DIN = 5888;
constexpr float EPS = 1e-6f;

typedef unsigned short bf16_t;
typedef unsigned u32x4 __attribute__((ext_vector_type(4)));
typedef float f32x4 __attribute__((ext_vector_type(4)));

constexpr size_t MiB = 1u << 20;
constexpr size_t WS_CTL = 0;
constexpr size_t WS_W = 2 * MiB;
constexpr size_t W_IN = 0, W_AO = W_IN + (size_t)DIN * D * 2, W_RO = W_AO + (size_t)D * 512 * 2, W_OUT = W_RO + (size_t)D * D * 2,
                 W_GU = W_OUT + (size_t)D * D * 2, W_DN = W_GU + (size_t)2 * DFF * D * 2, W_LAYER = W_DN + (size_t)D * DFF * 2;
static_assert(W_LAYER == 33 * MiB, "weights per layer");
constexpr size_t WS_XB = 68 * MiB;
constexpr size_t WS_SSP = 132 * MiB;
constexpr size_t WS_PATT = 134 * MiB;
constexpr size_t WS_PRET = 182 * MiB;
constexpr size_t WS_PRG = 310 * MiB;
constexpr size_t WS_PGA = 374 * MiB;
constexpr size_t WS_PGR = 438 * MiB;
constexpr size_t WS_SSP2 = 502 * MiB;
constexpr size_t WS_END = 504 * MiB;
constexpr size_t WS_ACT = WS_PRET;
static_assert(WS_ACT + (size_t)T * DFF * 2 <= WS_PGA, "act overlay");

__device__ __forceinline__ void st16_wt(void* p, u32x4 v) { asm volatile("global_store_dwordx4 %0, %1, off sc1\n\ts_nop 1" :: "v"(p), "v"(v) : "memory"); }
__device__ __forceinline__ float bf2f(bf16_t b) { return __uint_as_float(((unsigned)b) << 16); }
__device__ __forceinline__ unsigned f2bf(float f) { unsigned u = __float_as_uint(f); return (u + 0x7fffu + ((u >> 16) & 1u)) >> 16; }
typedef float f32x2_hw __attribute__((ext_vector_type(2)));
typedef __bf16 bf16x2_hw __attribute__((ext_vector_type(2)));
__device__ __forceinline__ unsigned pk2(float lo, float hi) { f32x2_hw v = {lo, hi}; bf16x2_hw b = __builtin_convertvector(v, bf16x2_hw); return __builtin_bit_cast(unsigned, b); }
__device__ __forceinline__ float sigmoidf_(float x) { return __builtin_amdgcn_rcpf(1.0f + __builtin_amdgcn_exp2f(x * -1.4426950408889634f)); }
__device__ __forceinline__ float wave_sum(float v) {
#pragma unroll
    for (int o = 1; o < 64; o <<= 1) v += __shfl_xor(v, o);
    return v;
}
__device__ __forceinline__ float wave_max(float v) {
#pragma unroll
    for (int o = 1; o < 64; o <<= 1) v = fmaxf(v, __shfl_xor(v, o));
    return v;
}
__device__ __forceinline__ u32x4 pack8(const float* v, float s) {
    u32x4 w; w.x = pk2(v[0] * s, v[1] * s); w.y = pk2(v[2] * s, v[3] * s); w.z = pk2(v[4] * s, v[5] * s); w.w = pk2(v[6] * s, v[7] * s); return w;
}
__device__ __forceinline__ void unpack8(u32x4 w, float* v) {
    v[0] = __uint_as_float(w.x << 16); v[1] = __uint_as_float(w.x & 0xffff0000u); v[2] = __uint_as_float(w.y << 16); v[3] = __uint_as_float(w.y & 0xffff0000u);
    v[4] = __uint_as_float(w.z << 16); v[5] = __uint_as_float(w.z & 0xffff0000u); v[6] = __uint_as_float(w.w << 16); v[7] = __uint_as_float(w.w & 0xffff0000u);
}

__device__ __forceinline__ void transpose_item(const float* W, int K, int N, const float* g, bf16_t* WT, float* scr, int k0, int n0, int orow0, int lane) {
    float v[32];
    const float* src = W + (size_t)(k0 + (lane >> 5)) * N + n0 + (lane & 31);
#pragma unroll
    for (int i = 0; i < 32; ++i) v[i] = src[(size_t)(2 * i) * N];
    if (g) {
#pragma unroll
        for (int i = 0; i < 32; ++i) v[i] *= g[k0 + 2 * i + (lane >> 5)];
    }
#pragma unroll
    for (int i = 0; i < 32; ++i) scr[(2 * i + (lane >> 5)) * 33 + (lane & 31)] = v[i];
    asm volatile("s_waitcnt lgkmcnt(0)" ::: "memory");
    const int c = lane & 7;
#pragma unroll
    for (int j = 0; j < 4; ++j) { const int n = (lane >> 3) + 8 * j; const float* s = scr + (8 * c) * 33 + n;
        u32x4 o; o.x = pk2(s[0 * 33], s[1 * 33]); o.y = pk2(s[2 * 33], s[3 * 33]); o.z = pk2(s[4 * 33], s[5 * 33]); o.w = pk2(s[6 * 33], s[7 * 33]);
        st16_wt(WT + (size_t)(orow0 + n) * K + k0 + 8 * c, o); }
    asm volatile("s_waitcnt lgkmcnt(0)" ::: "memory");
}
struct WPtrs { const float *norm_mix, *w_in, *w_ao, *w_ro, *w_out, *norm_ffn, *w_gate, *w_up, *w_dn, *gn_gain; };
constexpr int PRO_I_IN0 = (D / 64) * (DIN / 32);
constexpr int PRO_PER_LAYER = (D / 64) * (DIN / 32) + (512 / 64) * (D / 32) + 2 * (D / 64) * (D / 32) + 2 * (D / 64) * (DFF / 32) + (DFF / 64) * (D / 32);
__device__ __forceinline__ void prologue_weights(const WPtrs& P, unsigned char* ws, float* scr, int gw, int ngw, int lane, int it_lo = 0, int it_hi = 1 << 30) {
    constexpr int I_IN = (D / 64) * (DIN / 32), I_AO = (512 / 64) * (D / 32), I_SQ = (D / 64) * (D / 32), I_GU = (D / 64) * (DFF / 32), I_DN = (DFF / 64) * (D / 32);
    constexpr int PER_LAYER = I_IN + I_AO + 2 * I_SQ + 2 * I_GU + I_DN; static_assert(PER_LAYER == PRO_PER_LAYER, "item list");
    const int it_end = it_hi < DEPTH * PER_LAYER ? it_hi : DEPTH * PER_LAYER;
    for (int it = it_lo + gw; it < it_end; it += ngw) {
        const int l = it / PER_LAYER; int r = it % PER_LAYER;
        unsigned char* wl = ws + WS_W + (size_t)l * W_LAYER;
        if (r < I_IN) { const int nb = DIN / 32, kb = r / nb, n0 = 32 * (r % nb); transpose_item(P.w_in + (size_t)l * D * DIN, D, DIN, P.norm_mix + l * D, (bf16_t*)(wl + W_IN), scr, 64 * kb, n0, n0, lane); continue; } r -= I_IN;
        if (r < I_AO) { const int nb = D / 32, kb = r / nb, n0 = 32 * (r % nb); transpose_item(P.w_ao + (size_t)l * 512 * D, 512, D, nullptr, (bf16_t*)(wl + W_AO), scr, 64 * kb, n0, n0, lane); continue; } r -= I_AO;
        if (r < I_SQ) { const int nb = D / 32, kb = r / nb, n0 = 32 * (r % nb); transpose_item(P.w_ro + (size_t)l * D * D, D, D, P.gn_gain + l * D, (bf16_t*)(wl + W_RO), scr, 64 * kb, n0, n0, lane); continue; } r -= I_SQ;
        if (r < I_SQ) { const int nb = D / 32, kb = r / nb, n0 = 32 * (r % nb); transpose_item(P.w_out + (size_t)l * D * D, D, D, nullptr, (bf16_t*)(wl + W_OUT), scr, 64 * kb, n0, n0, lane); continue; } r -= I_SQ;
        if (r < I_GU) { const int nb = DFF / 32, kb = r / nb, n0 = 32 * (r % nb); transpose_item(P.w_gate + (size_t)l * D * DFF, D, DFF, P.norm_ffn + l * D, (bf16_t*)(wl + W_GU), scr, 64 * kb, n0, 256 * (n0 / 128) + 64 * ((n0 % 128) / 32), lane); continue; } r -= I_GU;
        if (r < I_GU) { const int nb = DFF / 32, kb = r / nb, n0 = 32 * (r % nb); transpose_item(P.w_up + (size_t)l * D * DFF, D, DFF, P.norm_ffn + l * D, (bf16_t*)(wl + W_GU), scr, 64 * kb, n0, 256 * (n0 / 128) + 64 * ((n0 % 128) / 32) + 32, lane); continue; } r -= I_GU;
        { const int nb = D / 32, kb = r / nb, n0 = 32 * (r % nb); transpose_item(P.w_dn + (size_t)l * DFF * D, DFF, D, nullptr, (bf16_t*)(wl + W_DN), scr, 64 * kb, n0, n0, lane); }
    }
}
typedef float f32x2p __attribute__((ext_vector_type(2)));
template <class RS> struct EpiAct {
    RS rs; bf16_t* act;
    __device__ __forceinline__ void apply8(int row, int col0, float s, const float* g, const float* u) const {
        const float s2 = s * -1.4426950408889634f, ss = s * s; u32x4 w; float e[8], o[8];
#pragma unroll
        for (int j = 0; j < 8; ++j) e[j] = __builtin_amdgcn_exp2f(g[j] * s2);
#pragma unroll
        for (int j = 0; j < 8; ++j) o[j] = (g[j] * u[j]) * ss;
#pragma unroll
        for (int j = 0; j < 8; ++j) e[j] = __builtin_amdgcn_rcpf(1.0f + e[j]);
#pragma unroll
        for (int j = 0; j < 8; ++j) o[j] *= e[j];
        w.x = pk2(o[0], o[1]); w.y = pk2(o[2], o[3]); w.z = pk2(o[4], o[5]); w.w = pk2(o[6], o[7]);
        st16_wt(act + (size_t)row * DFF + col0, w);
    }
};
#define LAS __attribute__((address_space(3)))
#define GAS __attribute__((address_space(1)))
namespace mx {
typedef short bf16x8 __attribute__((ext_vector_type(8)));
typedef short s16x4 __attribute__((ext_vector_type(4)));
typedef float f32x16 __attribute__((ext_vector_type(16)));
typedef unsigned u32x2 __attribute__((ext_vector_type(2)));
typedef float f32x2_t __attribute__((ext_vector_type(2)));
typedef __bf16 bf16x2_t __attribute__((ext_vector_type(2)));
typedef short v4i16_t __attribute__((ext_vector_type(4)));
constexpr float LOG2E = 1.4426950408889634f;
#define MFMA32(a, b, c) __builtin_amdgcn_mfma_f32_32x32x16_bf16((a), (b), (c), 0, 0, 0)
__device__ __forceinline__ unsigned cvtpk(float lo, float hi) { f32x2_t v = {lo, hi}; bf16x2_t b = __builtin_convertvector(v, bf16x2_t); return __builtin_bit_cast(unsigned, b); }
template <int S> __device__ __forceinline__ bf16x8 pack_step(const f32x16& x) {
    u32x4 p; p.x = cvtpk(x[8 * S + 0], x[8 * S + 1]); p.y = cvtpk(x[8 * S + 2], x[8 * S + 3]); p.z = cvtpk(x[8 * S + 4], x[8 * S + 5]); p.w = cvtpk(x[8 * S + 6], x[8 * S + 7]);
    return __builtin_bit_cast(bf16x8, p);
}
__device__ __forceinline__ bf16x8 join4(s16x4 a, s16x4 b) { bf16x8 r; r[0] = a[0]; r[1] = a[1]; r[2] = a[2]; r[3] = a[3]; r[4] = b[0]; r[5] = b[1]; r[6] = b[2]; r[7] = b[3]; return r; }
__device__ __forceinline__ s16x4 tr_read(const LAS unsigned char* p) { return __builtin_bit_cast(s16x4, __builtin_amdgcn_ds_read_tr16_b64_v4i16((LAS v4i16_t*)p)); }
__device__ __forceinline__ f32x16 zero16() { f32x16 z;
#pragma unroll
    for (int i = 0; i < 16; ++i) z[i] = 0.f; return z; }
__device__ __forceinline__ constexpr int cr(int r) { return (r & 3) + 8 * (r >> 2); }

constexpr int AT_KP = 144, AT_VP = 192;
constexpr int AT_VOFF = 256 * AT_KP;
struct AttnStage { u32x4 kv[4], vv[4]; bf16x8 qn[2][4]; };
__device__ __forceinline__ void attn_load(AttnStage& S, const bf16_t* patt, int item, int tid) {
    const int kvh = item & 1, nb = (item >> 1) & 15, b = item >> 5;
    const int lane = tid & 63, w = __builtin_amdgcn_readfirstlane(tid >> 6), q = lane & 31, hh = lane >> 5, g = w & 3, qh = w >> 2;
    const bf16_t* tb = patt + ((size_t)b * SEQ + (size_t)nb * 128) * 768;
    const bf16_t* base = tb + 512 + kvh * 64;
    const int radd = nb == 0 ? 128 : 0;
#pragma unroll
    for (int i = 0; i < 4; ++i) { const int c = tid + 512 * i, row = c >> 3, ch = c & 7, re = row < 128 ? row + radd : row;
        const bf16_t* src = base + (re - 128) * 768 + ch * 8; S.kv[i] = *(const u32x4*)src; S.vv[i] = *(const u32x4*)(src + 128); }
#pragma unroll
    for (int sb = 0; sb < 2; ++sb)
#pragma unroll
        for (int ks = 0; ks < 4; ++ks) S.qn[sb][ks] = *(const bf16x8*)(tb + (unsigned)((64 * qh + 32 * sb + q) * 768 + kvh * 256 + (8 * g + 2 * ks + hh) * 8));
}
constexpr int AT_QOFF = AT_VOFF + 256 * AT_VP;
constexpr int AT_SINK_OFF = AT_QOFF + 65536;
__device__ __forceinline__ void attn_flush(LAS unsigned char* lds, bf16_t* aout, int item, int tid) {
    const int lane = tid & 63, w = __builtin_amdgcn_readfirstlane(tid >> 6), g = w & 3, qh = w >> 2;
    const int kvh = item & 1, nb = (item >> 1) & 15, b = item >> 5;
    const LAS unsigned char* Ob = lds + AT_QOFF + w * 8192;
    bf16_t* ob_ = aout + ((size_t)b * SEQ + (size_t)nb * 128 + 64 * qh) * 768 + kvh * 256 + g * 64;
    u32x4 yv[8]; const int r8 = lane >> 3, c8 = lane & 7;
#pragma unroll
    for (int i = 0; i < 8; ++i) { const int row = 8 * i + r8; yv[i] = *(const LAS u32x4*)(Ob + row * 128 + ((c8 ^ (row & 7)) << 4)); }
#pragma unroll
    for (int i = 0; i < 8; ++i) { const int row = 8 * i + r8; st16_wt(ob_ + (unsigned)(row * 768 + c8 * 8), yv[i]); }
}
__device__ __forceinline__ void attn_item(LAS unsigned char* lds, const bf16_t* patt, bf16_t* aout, int item, int next_item, int prev_item, AttnStage& S, int tid) {
    asm volatile("" : "+v"(tid));
    const int lane = tid & 63, w = __builtin_amdgcn_readfirstlane(tid >> 6), q = lane & 31, hh = lane >> 5;
    const int kvh = item & 1, nb = (item >> 1) & 15, b = item >> 5;
    const int g = w & 3, qh = w >> 2, h = kvh * 4 + g;
    const size_t tok0 = (size_t)b * SEQ + (size_t)nb * 128;
    LAS unsigned char* Kimg = lds; LAS unsigned char* Vimg = lds + AT_VOFF; LAS unsigned char* Ob = lds + AT_QOFF + w * 8192;
    bf16x8 qc[2][4];
#pragma unroll
    for (int sb = 0; sb < 2; ++sb)
#pragma unroll
        for (int ks = 0; ks < 4; ++ks) qc[sb][ks] = S.qn[sb][ks];
#pragma unroll
    for (int i = 0; i < 4; ++i) { const int c = tid + 512 * i, row = c >> 3, ch = c & 7;
        *(LAS u32x4*)(Kimg + row * AT_KP + ch * 16) = S.kv[i]; *(LAS u32x4*)(Vimg + row * AT_VP + ch * 16) = S.vv[i]; }
    asm volatile("s_waitcnt lgkmcnt(0)" ::: "memory"); __builtin_amdgcn_s_barrier(); asm volatile("" ::: "memory");
    attn_load(S, patt, next_item >= 0 ? next_item : item, tid);
    if (prev_item >= 0) attn_flush(lds, aout, prev_item, tid);
    const float c0s = 0.125f * LOG2E, slr = exp2f(-(float)(h + 1)) * 8.0f  , sink2 = ((const LAS float*)(lds + AT_SINK_OFF))[h] * LOG2E;
    const int q4 = (lane & 15) >> 2, p4 = lane & 3, blk = (lane >> 4) & 1;
#pragma unroll
    for (int sb = 0; sb < 2; ++sb) {
        const int jt0 = 2 * qh + sb;
        const unsigned orb = (unsigned)(32 * sb + q) * 128u, orx = (unsigned)(q & 7);
        int qm = q - 4 * hh; asm volatile("" : "+v"(qm));
        f32x16 sa[5];
#pragma unroll
        for (int u = 0; u < 5; ++u) {
            if (nb > 0 || jt0 + u >= 4) {
                const float offu = -slr * (float)(128 - 32 * u + qm);
#pragma unroll
                for (int r = 0; r < 16; ++r) sa[u][r] = offu + slr * (float)cr(r);
#pragma unroll
                for (int ks = 0; ks < 4; ++ks) { const bf16x8 kf = *(const LAS bf16x8*)(Kimg + (32 * (jt0 + u) + q) * AT_KP + (2 * ks + hh) * 16); sa[u] = MFMA32(kf, qc[sb][ks], sa[u]); }
            } else {
#pragma unroll
                for (int r = 0; r < 16; ++r) sa[u][r] = -INFINITY;
            }
        }
#pragma unroll
        for (int r = 0; r < 16; ++r) { sa[0][r] = (cr(r) > qm) ? sa[0][r] : -INFINITY; sa[4][r] = (cr(r) <= qm) ? sa[4][r] : -INFINITY; }
        float m = -INFINITY;
#pragma unroll
        for (int u = 0; u < 5; ++u)
#pragma unroll
            for (int r = 0; r < 16; ++r) m = fmaxf(m, sa[u][r]);
        m = fmaxf(m, __shfl_xor(m, 32)); const float mc = fmaxf(m * c0s, sink2);
        float l = 0.f;
#pragma unroll
        for (int u = 0; u < 5; ++u)
#pragma unroll
            for (int r = 0; r < 16; ++r) { const float p = __builtin_amdgcn_exp2f(__builtin_fmaf(sa[u][r], c0s, -mc)); sa[u][r] = p; l += p; }
        l += __shfl_xor(l, 32); l += __builtin_amdgcn_exp2f(sink2 - mc);
        f32x16 oa[2]; oa[0] = zero16(); oa[1] = zero16();
#pragma unroll
        for (int u = 0; u < 5; ++u) {
            if (nb > 0 || jt0 + u >= 4) {
                const bf16x8 pf0 = pack_step<0>(sa[u]), pf1 = pack_step<1>(sa[u]);
#pragma unroll
                for (int s2 = 0; s2 < 2; ++s2)
#pragma unroll
                    for (int dt = 0; dt < 2; ++dt) {
                        const LAS unsigned char* vp = Vimg + (32 * (jt0 + u) + 16 * s2 + 4 * hh + q4) * AT_VP + (32 * dt + 16 * blk + 4 * p4) * 2;
                        const bf16x8 vf = join4(tr_read(vp), tr_read(vp + 8 * AT_VP));
                        oa[dt] = MFMA32(vf, s2 == 0 ? pf0 : pf1, oa[dt]);
                    }
            }
        }
        const float inv = __builtin_amdgcn_rcpf(l);
#pragma unroll
        for (int dt = 0; dt < 2; ++dt)
#pragma unroll
            for (int g4 = 0; g4 < 4; ++g4) { u32x2 o; o.x = cvtpk(oa[dt][4 * g4] * inv, oa[dt][4 * g4 + 1] * inv); o.y = cvtpk(oa[dt][4 * g4 + 2] * inv, oa[dt][4 * g4 + 3] * inv);
                *(LAS u32x2*)(Ob + orb + ((((unsigned)(4 * dt + g4)) ^ orx) << 4) + 8 * hh) = o; }
    }
    asm volatile("s_waitcnt lgkmcnt(0)" ::: "memory"); __builtin_amdgcn_s_barrier(); asm volatile("" ::: "memory");
}

constexpr int QP = 272, KP = 320, VP = 512;
constexpr int RT_Q = 0, RT_KD = RT_Q + 128 * QP, RT_V = RT_KD + 128 * KP, RT_ST = RT_V + 128 * VP, RT_END = RT_ST + 8192;
__device__ __forceinline__ void ret_item(LAS unsigned char* lds, const bf16_t* pret, const bf16_t* prg, bf16_t* rout, const float* gain, int b, int h, int c0, int c1, int tid) {
    const int w = __builtin_amdgcn_readfirstlane(tid >> 6);
    LAS unsigned char* Qimg = lds + RT_Q; LAS unsigned char* KDimg = lds + RT_KD; LAS unsigned char* Vimg = lds + RT_V; LAS float* st = (LAS float*)(lds + RT_ST);
    const float lg = log2f(1.0f - exp2f(-5.0f - (float)h));
    const float g128 = exp2f(128.0f * lg), kbase = 0.08838834764831845f;
    const bf16_t* pb = pret + (size_t)b * SEQ * 2048 + h * 128;
    f32x16 state[4];
#pragma unroll
    for (int d = 0; d < 4; ++d) state[d] = zero16();
    u32x4 kr[4], qr[4];
#define RT_OFFS() const unsigned kqoff = (unsigned)(tid >> 4) * 2048u + (unsigned)(tid & 15) * 8u, voff = (unsigned)(tid >> 5) * 2048u + (unsigned)(tid & 31) * 8u
#define RT_LOAD_K(c) do { const bf16_t* cb_ = pb + (size_t)(c) * (128 * 2048) + 512; _Pragma("unroll") for (int i = 0; i < 4; ++i) kr[i] = *(const u32x4*)(cb_ + (size_t)i * (32 * 2048) + kqoff); } while (0)
#define RT_LOAD_Q(c) do { const bf16_t* cb_ = pb + (size_t)(c) * (128 * 2048); _Pragma("unroll") for (int i = 0; i < 4; ++i) qr[i] = *(const u32x4*)(cb_ + (size_t)i * (32 * 2048) + kqoff); } while (0)
#define RT_LOAD_V(c) do { const bf16_t* cb_ = pb + (size_t)(c) * (128 * 2048) + 1024 + h * 128; _Pragma("unroll") for (int i = 0; i < 8; ++i) vr[i] = *(const u32x4*)(cb_ + (size_t)i * (16 * 2048) + voff); } while (0)
#define RT_STORE_KD() do { _Pragma("unroll") for (int i = 0; i < 4; ++i) { const int cc = tid + 512 * i, row = cc >> 4, ch = cc & 15; float f[8]; unpack8(kr[i], f); const float sc = kbase * exp2f(lg * (float)(127 - row)); \
        u32x4 o_; o_.x = cvtpk(f[0] * sc, f[1] * sc); o_.y = cvtpk(f[2] * sc, f[3] * sc); o_.z = cvtpk(f[4] * sc, f[5] * sc); o_.w = cvtpk(f[6] * sc, f[7] * sc); *(LAS u32x4*)(KDimg + row * KP + ch * 16) = o_; } } while (0)
#define RT_STORE_Q() do { _Pragma("unroll") for (int i = 0; i < 4; ++i) { const int cc = tid + 512 * i, row = cc >> 4, ch = cc & 15; *(LAS u32x4*)(Qimg + row * QP + ch * 16) = qr[i]; } } while (0)
#define RT_STORE_V() do { _Pragma("unroll") for (int i = 0; i < 8; ++i) { const int cc = tid + 512 * i, row = cc >> 5, ch = cc & 31; *(LAS u32x4*)(Vimg + row * VP + ((ch ^ ((row & 3) << 2)) * 16)) = vr[i]; } } while (0)
    if (c0 > 0) {
    u32x4 vr[8];
    { asm volatile("" : "+v"(tid)); RT_OFFS(); RT_LOAD_K(0); RT_LOAD_V(0); }
    for (int c = 0; c < c0; ++c) {
        asm volatile("" : "+v"(tid));
        const int lane = tid & 63, hh = lane >> 5, q4 = (lane & 15) >> 2, p4 = lane & 3, blk = (lane >> 4) & 1;
        RT_STORE_KD(); RT_STORE_V();
        { const int cn = (c + 1 < c0) ? c + 1 : c; RT_OFFS(); RT_LOAD_K(cn); RT_LOAD_V(cn); }
        __syncthreads();
#pragma unroll
        for (int d = 0; d < 4; ++d)
#pragma unroll
            for (int r = 0; r < 16; ++r) state[d][r] *= g128;
        {
            const LAS unsigned char* vb = Vimg + (8 * hh + q4) * VP + ((4 * (w ^ q4) + 2 * blk) * 16 + 8 * p4);
            const LAS unsigned char* kb = KDimg + (8 * hh + q4) * KP + (16 * blk + 4 * p4) * 2;
            bf16x8 vf[2], kt[2][4];
#define RT_LDW(s_, b_) do { vf[b_] = join4(tr_read(vb + (16 * (s_)) * VP), tr_read(vb + (16 * (s_) + 4) * VP)); \
                _Pragma("unroll") for (int dkt = 0; dkt < 4; ++dkt) kt[b_][dkt] = join4(tr_read(kb + (16 * (s_)) * KP + 64 * dkt), tr_read(kb + (16 * (s_) + 4) * KP + 64 * dkt)); } while (0)
            RT_LDW(0, 0);
#pragma unroll
            for (int s = 0; s < 8; ++s) {
                if (s < 7) RT_LDW(s + 1, (s + 1) & 1);
#pragma unroll
                for (int dkt = 0; dkt < 4; ++dkt) state[dkt] = MFMA32(kt[s & 1][dkt], vf[s & 1], state[dkt]);
            }
#undef RT_LDW
        }
        __syncthreads();
    }
    }
    { asm volatile("" : "+v"(tid)); RT_OFFS(); RT_LOAD_K(c0); RT_LOAD_Q(c0); }
    __builtin_amdgcn_s_waitcnt(0x0070);
    for (int c = c0; c < c1; ++c) {
        const size_t tokc = (size_t)b * SEQ + (size_t)c * 128;
        asm volatile("" : "+v"(tid));
        const int lane = tid & 63, q = lane & 31, hh = lane >> 5, q4 = (lane & 15) >> 2, p4 = lane & 3, blk = (lane >> 4) & 1;
        RT_STORE_KD(); RT_STORE_Q();
        {
            const int vrow = 16 * w + (lane >> 5), vch = (lane & 31); const bf16_t* cb_ = pb + (size_t)c * (128 * 2048) + 1024 + h * 128;
#pragma unroll
            for (int i = 0; i < 8; ++i) { const int row = vrow + 2 * i, ch = vch ^ ((row & 3) << 2);
                __builtin_amdgcn_global_load_lds((const unsigned*)(cb_ + (unsigned)(row * 2048 + ch * 8)), (LAS unsigned*)(Vimg + (8 * w + i) * 1024), 16, 0, 0); }
        }
        asm volatile("s_waitcnt lgkmcnt(0)" ::: "memory"); __builtin_amdgcn_s_barrier(); asm volatile("" ::: "memory");
        f32x16 o[4];
        unsigned sp[2][8];
#pragma unroll
        for (int sl = 0; sl < 2; ++sl) {
            const int n = w + 8 * sl;
            if (n < 10) {
                const int it = n >= 6 ? 3 : (n >= 3 ? 2 : (n >= 1 ? 1 : 0)), jt = n - (it * (it + 1)) / 2;
                f32x16 a = zero16();
                {
                    const LAS unsigned char* kp1 = KDimg + (32 * jt + q) * KP + hh * 16; const LAS unsigned char* qp1 = Qimg + (32 * it + q) * QP + hh * 16;
                    bf16x8 kf[2], qq[2]; kf[0] = *(const LAS bf16x8*)kp1; qq[0] = *(const LAS bf16x8*)qp1;
#pragma unroll
                    for (int ks = 0; ks < 8; ++ks) { if (ks < 7) { kf[(ks + 1) & 1] = *(const LAS bf16x8*)(kp1 + 32 * (ks + 1)); qq[(ks + 1) & 1] = *(const LAS bf16x8*)(qp1 + 32 * (ks + 1)); }
                        a = MFMA32(kf[ks & 1], qq[ks & 1], a); }
                }
                const float fi = exp2f(lg * (float)(32 * it + q - 127));
#pragma unroll
                for (int r = 0; r < 16; ++r) { float v = a[r] * fi; if (it == jt && (cr(r) + 4 * hh > q)) v = 0.f; a[r] = v; }
#pragma unroll
                for (int g4 = 0; g4 < 4; ++g4) { sp[sl][2 * g4] = cvtpk(a[4 * g4], a[4 * g4 + 1]); sp[sl][2 * g4 + 1] = cvtpk(a[4 * g4 + 2], a[4 * g4 + 3]); }
            }
        }
#pragma unroll
        for (int it = 0; it < 4; ++it) o[it] = zero16();
        {
            const LAS unsigned char* qb3 = Qimg + q * QP + 8 * hh;
            bf16x8 bq[2][4];
#define RT_LD3(g_, b_) do { _Pragma("unroll") for (int it = 0; it < 4; ++it) bq[b_][it] = join4(*(const LAS s16x4*)(qb3 + (32 * it) * QP + 32 * (g_)), *(const LAS s16x4*)(qb3 + (32 * it) * QP + 32 * (g_) + 16)); } while (0)
            RT_LD3(0, 0);
#pragma unroll
            for (int g = 0; g < 8; ++g) {
                if (g < 7) RT_LD3(g + 1, (g + 1) & 1);
                const bf16x8 af = (g & 1) ? pack_step<1>(state[g >> 1]) : pack_step<0>(state[g >> 1]);
#pragma unroll
                for (int it = 0; it < 4; ++it) o[it] = MFMA32(af, bq[g & 1][it], o[it]);
            }
#undef RT_LD3
        }
        asm volatile("" ::: "memory"); __builtin_amdgcn_s_waitcnt(0x0070); __builtin_amdgcn_s_barrier(); asm volatile("" ::: "memory");
#pragma unroll
        for (int sl = 0; sl < 2; ++sl) {
            const int n = w + 8 * sl;
            if (n < 10) {
                const int it = n >= 6 ? 3 : (n >= 3 ? 2 : (n >= 1 ? 1 : 0)), jt = n - (it * (it + 1)) / 2;
#pragma unroll
                for (int g4 = 0; g4 < 4; ++g4) { u32x2 v; v.x = sp[sl][2 * g4]; v.y = sp[sl][2 * g4 + 1]; *(LAS u32x2*)(Qimg + (32 * it + q) * QP + (4 * jt + g4) * 16 + 8 * hh) = v; }
            }
        }
        __syncthreads();
        { const int cn = (c + 1 < c1) ? c + 1 : c; RT_OFFS(); RT_LOAD_K(cn); RT_LOAD_Q(cn); }
#pragma unroll
        for (int it = 0; it < 4; ++it) { const float gi = exp2f(lg * (float)(32 * it + q + 1));
#pragma unroll
            for (int r = 0; r < 16; ++r) o[it][r] *= gi; }
#pragma unroll
        for (int d = 0; d < 4; ++d)
#pragma unroll
            for (int r = 0; r < 16; ++r) state[d][r] *= g128;
        {
            const LAS unsigned char* vb = Vimg + (8 * hh + q4) * VP + ((4 * (w ^ q4) + 2 * blk) * 16 + 8 * p4);
            const LAS unsigned char* sb2 = Qimg + q * QP + hh * 16;
            bf16x8 vf[2], sf[2][4];
#define RT_LD2(s_, b_) do { vf[b_] = join4(tr_read(vb + (16 * (s_)) * VP), tr_read(vb + (16 * (s_) + 4) * VP)); \
                _Pragma("unroll") for (int it = 0; it < 4; ++it) if (2 * it + 1 >= (s_)) sf[b_][it] = *(const LAS bf16x8*)(sb2 + (32 * it) * QP + 32 * (s_)); } while (0)
            RT_LD2(0, 0);
#pragma unroll
            for (int s = 0; s < 8; ++s) {
                if (s < 7) RT_LD2(s + 1, (s + 1) & 1);
#pragma unroll
                for (int it = 0; it < 4; ++it) if (2 * it + 1 >= s) o[it] = MFMA32(vf[s & 1], sf[s & 1][it], o[it]);
            }
#undef RT_LD2
        }
        if (c < 15) {
            const LAS unsigned char* vb = Vimg + (8 * hh + q4) * VP + ((4 * (w ^ q4) + 2 * blk) * 16 + 8 * p4);
            const LAS unsigned char* kb = KDimg + (8 * hh + q4) * KP + (16 * blk + 4 * p4) * 2;
            bf16x8 vf[2], kt[2][4];
#define RT_LD4(s_, b_) do { vf[b_] = join4(tr_read(vb + (16 * (s_)) * VP), tr_read(vb + (16 * (s_) + 4) * VP)); \
                _Pragma("unroll") for (int dkt = 0; dkt < 4; ++dkt) kt[b_][dkt] = join4(tr_read(kb + (16 * (s_)) * KP + 64 * dkt), tr_read(kb + (16 * (s_) + 4) * KP + 64 * dkt)); } while (0)
            RT_LD4(0, 0);
#pragma unroll
            for (int s = 0; s < 8; ++s) {
                if (s < 7) RT_LD4(s + 1, (s + 1) & 1);
#pragma unroll
                for (int dkt = 0; dkt < 4; ++dkt) state[dkt] = MFMA32(kt[s & 1][dkt], vf[s & 1], state[dkt]);
            }
#undef RT_LD4
        }
        __syncthreads();
        {
            const int grow0 = 16 * w + (lane >> 5), gch = lane & 31; const bf16_t* gb_ = prg + tokc * 1024 + h * 256;
#pragma unroll
            for (int i = 0; i < 8; ++i) { const int row = grow0 + 2 * i, ch = gch ^ (row & 31);
                __builtin_amdgcn_global_load_lds((const unsigned*)(gb_ + (unsigned)(row * 1024 + ch * 8)), (LAS unsigned*)(Qimg + (8 * w + i) * 1024), 16, 0, 0); }
        }
        float mean[4], rstd[4];
#pragma unroll
        for (int it = 0; it < 4; ++it) { float ps = 0.f, pq = 0.f;
#pragma unroll
            for (int r = 0; r < 16; ++r) { ps += o[it][r]; pq += o[it][r] * o[it][r]; }
            ps += __shfl_xor(ps, 32); pq += __shfl_xor(pq, 32); if (hh == 0) { st[w * 128 + 32 * it + q] = ps; st[1024 + w * 128 + 32 * it + q] = pq; } }
        asm volatile("s_waitcnt lgkmcnt(0)" ::: "memory"); __builtin_amdgcn_s_barrier(); asm volatile("" ::: "memory");
#pragma unroll
        for (int it = 0; it < 4; ++it) { float s8 = 0.f, q8 = 0.f;
#pragma unroll
            for (int ww = 0; ww < 8; ++ww) { s8 += st[ww * 128 + 32 * it + q]; q8 += st[1024 + ww * 128 + 32 * it + q]; }
            mean[it] = s8 * (1.0f / 256.0f); rstd[it] = rsqrtf(fmaxf(q8 * (1.0f / 256.0f) - mean[it] * mean[it], 0.f) + EPS); }
        asm volatile("" ::: "memory"); __builtin_amdgcn_s_waitcnt(0x0070); __builtin_amdgcn_s_barrier(); asm volatile("" ::: "memory");
#pragma unroll
        for (int it = 0; it < 4; ++it) {
            const int row = 32 * it + q; const unsigned rbase = (unsigned)row * 512u, rx = (unsigned)(row & 31);
#pragma unroll
            for (int g4 = 0; g4 < 4; ++g4) {
                const unsigned c8 = (unsigned)(8 * w + 2 * g4 + hh);
                const unsigned off = rbase + (((c8 >> 1) ^ rx) << 4) + ((c8 & 1u) << 3);
                const u32x2 rw = *(const LAS u32x2*)(Qimg + off); const float ms = rstd[it];
                const float rg0 = __uint_as_float(rw.x << 16), rg1 = __uint_as_float(rw.x & 0xffff0000u), rg2 = __uint_as_float(rw.y << 16), rg3 = __uint_as_float(rw.y & 0xffff0000u);
                const float y0 = (o[it][4 * g4 + 0] - mean[it]) * ms * rg0, y1 = (o[it][4 * g4 + 1] - mean[it]) * ms * rg1;
                const float y2 = (o[it][4 * g4 + 2] - mean[it]) * ms * rg2, y3 = (o[it][4 * g4 + 3] - mean[it]) * ms * rg3;
                u32x2 ov; ov.x = cvtpk(y0, y1); ov.y = cvtpk(y2, y3); *(LAS u32x2*)(Vimg + off) = ov;
            }
        }
        asm volatile("s_waitcnt lgkmcnt(0)" ::: "memory"); __builtin_amdgcn_s_barrier(); asm volatile("" ::: "memory");
        {
            u32x4 yv[8]; bf16_t* ob_ = rout + tokc * 1024 + h * 256;
#pragma unroll
            for (int i = 0; i < 8; ++i) { const int cc = tid + 512 * i, row = cc >> 5, ch = cc & 31; yv[i] = *(const LAS u32x4*)(Vimg + row * 512 + ((ch ^ (row & 31)) << 4)); }
#pragma unroll
            for (int i = 0; i < 8; ++i) { const int cc = tid + 512 * i, row = cc >> 5, ch = cc & 31; st16_wt(ob_ + (unsigned)(row * 1024 + ch * 8), yv[i]); }
        }
        __syncthreads();
    }
#undef RT_OFFS
#undef RT_LOAD_K
#undef RT_LOAD_Q
#undef RT_LOAD_V
#undef RT_STORE_KD
#undef RT_STORE_Q
#undef RT_STORE_V
}
}

__device__ __forceinline__ int tid_from_wave(int wave) { unsigned z = 0u; asm volatile("" : "+v"(z));
    return wave * 64 + (int)__builtin_amdgcn_mbcnt_hi(~0u, __builtin_amdgcn_mbcnt_lo(~0u, z)); }
struct Args;
template <int WHAT  >
__device__ __forceinline__ void mixer_phase_impl(LAS unsigned char* lds, unsigned char* ws, const float* sinks, const float* gain, int bx, int G, bf16_t* aout, bf16_t* rout, int wave, bool consec) {
    const bf16_t* patt = (const bf16_t*)(ws + WS_PATT); const bf16_t* pret = (const bf16_t*)(ws + WS_PRET); const bf16_t* prg = (const bf16_t*)(ws + WS_PRG);
    int tid_ = tid_from_wave(wave); asm volatile("" : "+v"(tid_));
    const int tid = tid_;
    const int vcu = (G % 8 == 0) ? (bx % 8) * (G / 8) + bx / 8 : bx;
    if constexpr ((WHAT & 2) != 0)
    for (int it = vcu; it < BATCH * RH * 4; it += G) {
        const int bh = it >> 2, seg = it & 3, c0 = seg == 0 ? 0 : (seg == 1 ? 5 : (seg == 2 ? 9 : 13)), c1 = seg == 0 ? 5 : (seg == 1 ? 9 : (seg == 2 ? 13 : 16));
        mx::ret_item(lds, pret, prg, rout, gain, bh >> 2, bh & 3, c0, c1, tid);
    }
    if constexpr ((WHAT & 1) != 0)
    {
        if (tid < AH) ((LAS float*)(lds + mx::AT_SINK_OFF))[tid] = sinks[tid];
        const int NIT = BATCH * 16 * 2, npc = NIT / G, first = consec ? vcu * npc : vcu, step = consec ? 1 : G, last = consec ? first + npc : NIT;
        mx::AttnStage S; if (first < last) mx::attn_load(S, patt, first, tid);
        int prev = -1;
        for (int it = first; it < last; it += step) { mx::attn_item(lds, patt, aout, it, (it + step < last) ? it + step : -1, prev, S, tid); prev = it; }
        if (prev >= 0) mx::attn_flush(lds, aout, prev, tid);
    }
}


namespace pg8 {
typedef short bf16x8 __attribute__((ext_vector_type(8)));
constexpr int BM = 256, BK = 64, HALF = 128, HTB = HALF * BK * 2  , STAGE_BYTES = 8 * HTB, NXCD = 8;
#ifndef PG8_WGM
#define PG8_WGM 4
#endif
constexpr int WGM = PG8_WGM;
__host__ __device__ __forceinline__ int lds_byte(int r, int c) { const int st = (r >> 4) * 2 + (c >> 5), rr = r & 15, cc = c & 31, ob = rr * 64 + cc * 2; return st * 1024 + (ob ^ (((ob >> 9) & 1) << 5)); }
__host__ __device__ __forceinline__ void stage_rc(int b, int& R, int& C) { const int st = b / 1024, sb = b % 1024, swz = sb ^ (((sb >> 9) & 1) << 5); R = (st >> 1) * 16 + swz / 64; C = (st & 1) * 32 + (swz % 64) / 2; }
__host__ __device__ __forceinline__ int perm32(int rho) { const int n = rho >> 4, i = rho & 15; return 8 * (i >> 2) + 4 * n + (i & 3); }
struct Unit { int pm, pn; };
struct Gemm { const bf16_t* A; const bf16_t* Bt; int lda, ldb, M, N, K; };
struct StaticOrder {
    int nM, nN, nwg, G, c;
    __host__ __device__ void init(int M, int N, int G_, int c_) { nM = M / BM; nN = N / BM; nwg = nM * nN; G = G_; c = c_; }
    __host__ __device__ bool next(int i, Unit& u) const {
        const long L = (long)i * G + c; if (L >= nwg) return false;
        int wgid = (int)L; { const int q = nwg / NXCD, r = nwg % NXCD, xcd = wgid % NXCD, off = wgid / NXCD; wgid = (xcd < r ? xcd * (q + 1) : r * (q + 1) + (xcd - r) * q) + off; }
        const int nig = WGM * nN, gid = wgid / nig, fm = gid * WGM, gsz = (nM - fm) < WGM ? (nM - fm) : WGM;
        u.pm = fm + ((wgid % nig) % gsz); u.pn = (wgid % nig) / gsz; return true;
    }
};
struct NoPre { __device__ __forceinline__ void operator()() const {} };
template <class Epi, class Sched, bool ALIGN_EPI, class Pre = NoPre>
__device__ __forceinline__ void gemm_phase(LAS unsigned char* lds, const Gemm g, const Sched& S, const Epi& E, int wave, const Pre& pre = Pre()) {
    int tid_ = tid_from_wave(wave); asm volatile("" : "+v"(tid_));
    int wid_ = wave; asm volatile("" : "+s"(wid_));
    const int tid = tid_, wid = wid_, lane = tid & 63, wr = wid >> 2, wc = wid & 3, fr = lane & 15, fq = lane >> 4;
    const int nt = g.K / BK;
#define KT(t) ((size_t)(t))
    unsigned voffA[2], voffB[2];
#pragma unroll
    for (int i = 0; i < 2; ++i) { int R, C; stage_rc(tid * 16 + i * 8192, R, C); const int Rb = 64 * (R >> 5) + perm32(R & 31);
        voffA[i] = (unsigned)(R * g.lda + C) * 2u; voffB[i] = (unsigned)(Rb * g.ldb + C) * 2u; }
    const size_t kstep = (size_t)(BK * 2);
    const size_t hstepA = (size_t)HALF * g.lda * 2, hstepB = (size_t)32 * g.ldb * 2, tstepA = 2 * hstepA, tstepB = (size_t)BM * g.ldb * 2;
    const unsigned ldsw = (unsigned)wid * 1024u;
    const int aoff = lds_byte(wr * 64 + fr, fq * 8), boff = lds_byte(wc * 32 + fr, fq * 8);
#define PG8_SA(b, h) (((b) * 2 + (h)) * HTB)
#define PG8_SB(b, h) ((4 + (b) * 2 + (h)) * HTB)
#define PG8_STAGE(bufoff, gbase, voff) do { _Pragma("unroll") for (int _i = 0; _i < 2; ++_i) \
        __builtin_amdgcn_global_load_lds((const unsigned*)((const char*)(gbase) + (voff)[_i]), (LAS unsigned*)(lds + (bufoff) + ldsw + _i * 8192), 16, 0, 0); } while (0)
#define PG8_LDA(dst, b, h) do { _Pragma("unroll") for (int m = 0; m < 4; ++m) _Pragma("unroll") for (int k = 0; k < 2; ++k) dst[m][k] = *(const LAS bf16x8*)(lds + PG8_SA(b, h) + aoff + m * 2048 + k * 1024); } while (0)
#define PG8_LDB(dst, b, h) do { _Pragma("unroll") for (int n = 0; n < 2; ++n) _Pragma("unroll") for (int k = 0; k < 2; ++k) dst[n][k] = *(const LAS bf16x8*)(lds + PG8_SB(b, h) + boff + n * 2048 + k * 1024); } while (0)
#define PG8_MMA(ai, bj, At, Bt) do { __builtin_amdgcn_s_setprio(1); _Pragma("unroll") for (int m = 0; m < 4; ++m) _Pragma("unroll") for (int n = 0; n < 2; ++n) _Pragma("unroll") for (int k = 0; k < 2; ++k) \
        acc[ai][bj][m][n] = __builtin_amdgcn_mfma_f32_16x16x32_bf16(Bt[n][k], At[m][k], acc[ai][bj][m][n], 0, 0, 0); __builtin_amdgcn_s_setprio(0); } while (0)
#define PG8_WAIT_V(n) asm volatile("s_waitcnt vmcnt(" #n ")" ::: "memory")
#define PG8_WAIT_L(n) asm volatile("s_waitcnt lgkmcnt(" #n ")" ::: "memory")
#define PG8_BAR __builtin_amdgcn_s_barrier()
#define PG8_SCHED __builtin_amdgcn_sched_barrier(0)
    Unit cur, nxt; int ui = 0;
    if (!S.next(0, cur)) return;
    f32x4 acc[2][2][4][2];
#pragma unroll
    for (int a = 0; a < 2; ++a)
#pragma unroll
        for (int b = 0; b < 2; ++b)
#pragma unroll
            for (int m = 0; m < 4; ++m)
#pragma unroll
                for (int n = 0; n < 2; ++n) acc[a][b][m][n] = (f32x4){0.f, 0.f, 0.f, 0.f};
    bf16x8 At[4][2], B0[2][2], B1[2][2];
    const char* cA = (const char*)g.A + (size_t)cur.pm * tstepA; const char* cB = (const char*)g.Bt + (size_t)cur.pn * tstepB;
    PG8_STAGE(PG8_SB(0, 0), cB, voffB); PG8_STAGE(PG8_SB(0, 1), cB + hstepB, voffB); PG8_STAGE(PG8_SA(0, 0), cA, voffA); PG8_STAGE(PG8_SA(0, 1), cA + hstepA, voffA);
    pre();
    if (wr == 1) PG8_BAR;
    PG8_WAIT_V(2); PG8_BAR;
    PG8_STAGE(PG8_SB(1, 0), cB + kstep, voffB); PG8_STAGE(PG8_SA(1, 0), cA + kstep, voffA); PG8_STAGE(PG8_SB(1, 1), cB + hstepB + kstep, voffB);
    PG8_WAIT_V(6); PG8_BAR;
    for (;;) {
        const bool has_next = S.next(ui + 1, nxt);
        const char* nA = has_next ? (const char*)g.A + (size_t)nxt.pm * tstepA : cA; const char* nB = has_next ? (const char*)g.Bt + (size_t)nxt.pn * tstepB : cB;
        for (int t = 0; t < nt; t += 2) {
            const bool last = (t == nt - 2);
            const char* a1 = cA + KT(t + 1) * kstep;
            const char* a2 = last ? nA : cA + KT(t + 2) * kstep; const char* b2 = last ? nB : cB + KT(t + 2) * kstep;
            const char* a3 = last ? nA + kstep : cA + KT(t + 3) * kstep; const char* b3 = last ? nB + kstep : cB + KT(t + 3) * kstep;
            PG8_LDB(B0, 0, 0); PG8_LDB(B1, 0, 1); PG8_SCHED; PG8_LDA(At, 0, 0); PG8_STAGE(PG8_SA(1, 1), a1 + hstepA, voffA);
            PG8_WAIT_V(8); PG8_WAIT_L(0); PG8_BAR; PG8_MMA(0, 0, At, B0); PG8_MMA(0, 1, At, B1); PG8_BAR; PG8_SCHED;
            PG8_LDA(At, 0, 1); PG8_STAGE(PG8_SB(0, 0), b2, voffB); PG8_STAGE(PG8_SB(0, 1), b2 + hstepB, voffB); PG8_STAGE(PG8_SA(0, 0), a2, voffA);
            PG8_WAIT_V(8); PG8_WAIT_L(0); PG8_BAR; PG8_MMA(1, 0, At, B0); PG8_MMA(1, 1, At, B1); PG8_BAR; PG8_SCHED;
            PG8_LDB(B0, 1, 0); PG8_LDB(B1, 1, 1); PG8_SCHED; PG8_LDA(At, 1, 0); PG8_STAGE(PG8_SA(0, 1), a2 + hstepA, voffA);
            PG8_WAIT_V(8); PG8_WAIT_L(0); PG8_BAR; PG8_MMA(0, 0, At, B0); PG8_MMA(0, 1, At, B1); PG8_BAR; PG8_SCHED;
            PG8_LDA(At, 1, 1); PG8_STAGE(PG8_SB(1, 0), b3, voffB); PG8_STAGE(PG8_SB(1, 1), b3 + hstepB, voffB); PG8_STAGE(PG8_SA(1, 0), a3, voffA);
            PG8_WAIT_V(8); PG8_WAIT_L(0); PG8_BAR; PG8_MMA(1, 0, At, B0); PG8_MMA(1, 1, At, B1); PG8_BAR; PG8_SCHED;
        }
        if constexpr (ALIGN_EPI) { if (wr == 0) PG8_BAR; }
        E(acc, cur, wr, wc, fr, fq);
        if (!has_next) break;
#pragma unroll
        for (int a = 0; a < 2; ++a)
#pragma unroll
            for (int b = 0; b < 2; ++b)
#pragma unroll
                for (int m = 0; m < 4; ++m)
#pragma unroll
                    for (int n = 0; n < 2; ++n) acc[a][b][m][n] = (f32x4){0.f, 0.f, 0.f, 0.f};
        cur = nxt; cA = nA; cB = nB; ++ui;
        if constexpr (ALIGN_EPI) { if (wr == 1) PG8_BAR; }
    }
    PG8_WAIT_V(0);
    if constexpr (!ALIGN_EPI) { if (wr == 0) PG8_BAR; }
    PG8_BAR;
#undef KT
#undef PG8_SA
#undef PG8_SB
#undef PG8_STAGE
#undef PG8_LDA
#undef PG8_LDB
#undef PG8_MMA
#undef PG8_WAIT_V
#undef PG8_WAIT_L
#undef PG8_BAR
#undef PG8_SCHED
}
}

struct RsLds { const LAS float* tab; const LAS int* pml;
    __device__ __forceinline__ const LAS float* panel(int pm) const { const int p0 = pml[0], p1 = pml[1], p2 = pml[2]; const int slot = pm == p0 ? 0 : (pm == p1 ? 1 : (pm == p2 ? 2 : 3)); return tab + slot * 256; } };

template <int ACT  > __device__ __forceinline__ u32x4 proj_pack(const f32x4 a, const f32x4 b, float s) {
    const float v[8] = {a.x, a.y, a.z, a.w, b.x, b.y, b.z, b.w};
    if constexpr (ACT == 0) return pack8(v, s);
    else { const float s2 = s * -1.4426950408889634f; float e[8], o[8];
#pragma unroll
        for (int j = 0; j < 8; ++j) e[j] = __builtin_amdgcn_exp2f(v[j] * s2);
#pragma unroll
        for (int j = 0; j < 8; ++j) e[j] = __builtin_amdgcn_rcpf(1.0f + e[j]);
#pragma unroll
        for (int j = 0; j < 8; ++j) o[j] = ACT == 1 ? (v[j] * s) * e[j] : e[j];
        return pack8(o, 1.0f); }
}
template <int ACT> __device__ __forceinline__ void proj_rows(const f32x4 (&acc)[2][2][4][2], const LAS float* rt, LAS unsigned char* s, unsigned w0, unsigned w1, unsigned rd, bf16_t* tb, int ld, int r8, int c8) {
#pragma unroll
    for (int ai = 0; ai < 2; ++ai) {
        float sc[4];
#pragma unroll
        for (int m = 0; m < 4; ++m) sc[m] = rt[ai * 128 + m * 16];
#pragma unroll
        for (int mh = 0; mh < 2; ++mh) {
            u32x4 q[2][2];
#pragma unroll
            for (int mm = 0; mm < 2; ++mm) { const int m = 2 * mh + mm;
                *(LAS u32x4*)(s + w0) = proj_pack<ACT>(acc[ai][0][m][0], acc[ai][0][m][1], sc[m]);
                *(LAS u32x4*)(s + w1) = proj_pack<ACT>(acc[ai][1][m][0], acc[ai][1][m][1], sc[m]);
                q[mm][0] = *(const LAS u32x4*)(s + rd); q[mm][1] = *(const LAS u32x4*)(s + 1024 + rd); }
#pragma unroll
            for (int mm = 0; mm < 2; ++mm) { bf16_t* p = tb + (size_t)(ai * 128 + (2 * mh + mm) * 16 + r8) * ld + 8 * c8;
                st16_wt(p, q[mm][0]); st16_wt(p + (size_t)8 * ld, q[mm][1]); }
        }
    }
}
struct EpiProjT {
    static constexpr bool REPEATABLE = false;
    RsLds rs; bf16_t *patt, *pret, *prg, *pga, *pgr; LAS unsigned char* scr;
    __device__ __forceinline__ void operator()(const f32x4 (&acc)[2][2][4][2], const pg8::Unit& u, int wr, int wc, int fr, int fq) const {
        int lane_ = fq * 16 + fr; asm volatile("" : "+v"(lane_));
        const int wid = wr * 4 + wc, lane = lane_, r8 = lane >> 3, c8 = lane & 7; fr = lane & 15; fq = lane >> 4;
        LAS unsigned char* s = scr + wid * 2048;
        const int colw = u.pn * 256 + wc * 64; const size_t rowg = (size_t)u.pm * 256 + wr * 64;
        const unsigned w0 = (unsigned)fr * 128u + (((unsigned)fq ^ ((unsigned)fr & 7u)) << 4), w1 = (unsigned)fr * 128u + (((unsigned)(4 + fq) ^ ((unsigned)fr & 7u)) << 4);
        const unsigned rd = (unsigned)r8 * 128u + (((unsigned)c8 ^ (unsigned)r8) << 4);
        const LAS float* rt = rs.panel(u.pm) + wr * 64 + fr;
        if (colw < 768) proj_rows<0>(acc, rt, s, w0, w1, rd, patt + rowg * 768 + colw, 768, r8, c8);
        else if (colw < 2816) proj_rows<0>(acc, rt, s, w0, w1, rd, pret + rowg * 2048 + (colw - 768), 2048, r8, c8);
        else if (colw < 3840) proj_rows<1>(acc, rt, s, w0, w1, rd, prg + rowg * 1024 + (colw - 2816), 1024, r8, c8);
        else proj_rows<2>(acc, rt, s, w0, w1, rd, (colw < 4864 ? pga + (colw - 3840) : pgr + (colw - 4864)) + rowg * 1024, 1024, r8, c8);
    }
};
template <class Ap> struct Epi8Dual {
    static constexpr bool REPEATABLE = false; Ap ap;
    __device__ __forceinline__ void operator()(const f32x4 (&acc)[2][2][4][2], const pg8::Unit& u, int wr, int wc, int fr, int fq) const {
        const int row0 = u.pm * 256 + wr * 64 + fr, col0 = u.pn * 128 + wc * 32 + 8 * fq;
        const LAS float* rt = ap.rs.panel(u.pm); float sc[2][4];
#pragma unroll
        for (int ai = 0; ai < 2; ++ai)
#pragma unroll
            for (int m = 0; m < 4; ++m) sc[ai][m] = rt[ai * 128 + wr * 64 + m * 16 + fr];
#pragma unroll
        for (int ai = 0; ai < 2; ++ai)
#pragma unroll
            for (int m = 0; m < 4; ++m) { const f32x4 a = acc[ai][0][m][0], b = acc[ai][0][m][1], c = acc[ai][1][m][0], d = acc[ai][1][m][1];
                const float gv[8] = {a.x, a.y, a.z, a.w, b.x, b.y, b.z, b.w}, uv[8] = {c.x, c.y, c.z, c.w, d.x, d.y, d.z, d.w};
                ap.apply8(row0 + ai * 128 + m * 16, col0, sc[ai][m], gv, uv); }
    }
};
struct WaveTile {
    LAS unsigned char* s; unsigned w0, w1, rd; int r8, c8, fr, fq;
    __device__ __forceinline__ void init(LAS unsigned char* scr, int wr, int wc, int fr_, int fq_) {
        int lane_ = fq_ * 16 + fr_; asm volatile("" : "+v"(lane_));
        fr = lane_ & 15; fq = lane_ >> 4; r8 = lane_ >> 3; c8 = lane_ & 7; s = scr + (wr * 4 + wc) * 2048;
        w0 = (unsigned)fr * 128u + (((unsigned)fq ^ ((unsigned)fr & 7u)) << 4); w1 = (unsigned)fr * 128u + (((unsigned)(4 + fq) ^ ((unsigned)fr & 7u)) << 4);
        rd = (unsigned)r8 * 128u + (((unsigned)c8 ^ (unsigned)r8) << 4);
    }
    __device__ __forceinline__ void lines_to_acc(u32x4 l0, u32x4 l1, u32x4& a0, u32x4& a1) const { *(LAS u32x4*)(s + rd) = l0; *(LAS u32x4*)(s + 1024 + rd) = l1; a0 = *(const LAS u32x4*)(s + w0); a1 = *(const LAS u32x4*)(s + w1); }
    __device__ __forceinline__ void acc_to_lines(u32x4 a0, u32x4 a1, u32x4& l0, u32x4& l1) const { *(LAS u32x4*)(s + w0) = a0; *(LAS u32x4*)(s + w1) = a1; l0 = *(const LAS u32x4*)(s + rd); l1 = *(const LAS u32x4*)(s + 1024 + rd); }
};
struct EpiM1F {
    static constexpr bool REPEATABLE = false;
    const bf16_t* ga; bf16_t* m1; LAS unsigned char* scr;
    __device__ __forceinline__ void operator()(const f32x4 (&acc)[2][2][4][2], const pg8::Unit& u, int wr, int wc, int fr, int fq) const {
        WaveTile W; W.init(scr, wr, wc, fr, fq);
        const size_t base = ((size_t)u.pm * 256 + wr * 64 + W.r8) * 1024 + (u.pn * 256 + wc * 64) + 8 * W.c8;
#pragma unroll
        for (int ai = 0; ai < 2; ++ai)
#pragma unroll
            for (int mh = 0; mh < 2; ++mh) {
                u32x4 L[2][2];
#pragma unroll
                for (int mm = 0; mm < 2; ++mm) { const size_t o = base + (size_t)(ai * 128 + (2 * mh + mm) * 16) * 1024; L[mm][0] = *(const u32x4*)(ga + o); L[mm][1] = *(const u32x4*)(ga + o + 8 * 1024); }
#pragma unroll
                for (int mm = 0; mm < 2; ++mm) { const int m = 2 * mh + mm; u32x4 g0, g1, q0, q1; W.lines_to_acc(L[mm][0], L[mm][1], g0, g1);
                    float gv[8], o[8];
                    { unpack8(g0, gv); const f32x4 a = acc[ai][0][m][0], b = acc[ai][0][m][1]; const float v[8] = {a.x, a.y, a.z, a.w, b.x, b.y, b.z, b.w};
#pragma unroll
                      for (int j = 0; j < 8; ++j) o[j] = gv[j] * v[j];
                      g0 = pack8(o, 1.0f); }
                    { unpack8(g1, gv); const f32x4 a = acc[ai][1][m][0], b = acc[ai][1][m][1]; const float v[8] = {a.x, a.y, a.z, a.w, b.x, b.y, b.z, b.w};
#pragma unroll
                      for (int j = 0; j < 8; ++j) o[j] = gv[j] * v[j];
                      g1 = pack8(o, 1.0f); }
                    W.acc_to_lines(g0, g1, q0, q1);
                    const size_t oo = base + (size_t)(ai * 128 + m * 16) * 1024; *(u32x4*)(m1 + oo) = q0; *(u32x4*)(m1 + oo + 8 * 1024) = q1; }
            }
    }
};
struct EpiMrgF {
    static constexpr bool REPEATABLE = false;
    const bf16_t* gr; bf16_t* m1; LAS unsigned char* scr;
    __device__ __forceinline__ void operator()(const f32x4 (&acc)[2][2][4][2], const pg8::Unit& u, int wr, int wc, int fr, int fq) const {
        WaveTile W; W.init(scr, wr, wc, fr, fq);
        const size_t base = ((size_t)u.pm * 256 + wr * 64 + W.r8) * 1024 + (u.pn * 256 + wc * 64) + 8 * W.c8;
#pragma unroll
        for (int ai = 0; ai < 2; ++ai)
#pragma unroll
            for (int mh = 0; mh < 2; ++mh) {
                u32x4 L[2][2], M[2][2];
#pragma unroll
                for (int mm = 0; mm < 2; ++mm) { const size_t o = base + (size_t)(ai * 128 + (2 * mh + mm) * 16) * 1024;
                    L[mm][0] = *(const u32x4*)(gr + o); L[mm][1] = *(const u32x4*)(gr + o + 8 * 1024); M[mm][0] = *(const u32x4*)(m1 + o); M[mm][1] = *(const u32x4*)(m1 + o + 8 * 1024); }
#pragma unroll
                for (int mm = 0; mm < 2; ++mm) { const int m = 2 * mh + mm; u32x4 g0, g1, p0, p1, q0, q1; W.lines_to_acc(L[mm][0], L[mm][1], g0, g1); W.lines_to_acc(M[mm][0], M[mm][1], p0, p1);
                    float gv[8], mv[8], o[8];
                    { unpack8(g0, gv); unpack8(p0, mv); const f32x4 a = acc[ai][0][m][0], b = acc[ai][0][m][1]; const float v[8] = {a.x, a.y, a.z, a.w, b.x, b.y, b.z, b.w};
#pragma unroll
                      for (int j = 0; j < 8; ++j) o[j] = mv[j] + gv[j] * v[j];
                      g0 = pack8(o, 1.0f); }
                    { unpack8(g1, gv); unpack8(p1, mv); const f32x4 a = acc[ai][1][m][0], b = acc[ai][1][m][1]; const float v[8] = {a.x, a.y, a.z, a.w, b.x, b.y, b.z, b.w};
#pragma unroll
                      for (int j = 0; j < 8; ++j) o[j] = mv[j] + gv[j] * v[j];
                      g1 = pack8(o, 1.0f); }
                    W.acc_to_lines(g0, g1, q0, q1);
                    const size_t oo = base + (size_t)(ai * 128 + m * 16) * 1024; st16_wt(m1 + oo, q0); st16_wt(m1 + oo + 8 * 1024, q1); }
            }
    }
};
struct EpiResF {
    static constexpr bool REPEATABLE = false;
    bf16_t* xb; float* ssp; LAS unsigned char* scr;
    __device__ __forceinline__ void operator()(const f32x4 (&acc)[2][2][4][2], const pg8::Unit& u, int wr, int wc, int fr, int fq) const {
        WaveTile W; W.init(scr, wr, wc, fr, fq);
        const size_t base = ((size_t)u.pm * 256 + wr * 64 + W.r8) * D + (u.pn * 256 + wc * 64) + 8 * W.c8;
#pragma unroll
        for (int ai = 0; ai < 2; ++ai) {
            float ssm[4];
#pragma unroll
            for (int mh = 0; mh < 2; ++mh) {
                u32x4 L[2][2];
#pragma unroll
                for (int mm = 0; mm < 2; ++mm) { const size_t o = base + (size_t)(ai * 128 + (2 * mh + mm) * 16) * D; L[mm][0] = *(const u32x4*)(xb + o); L[mm][1] = *(const u32x4*)(xb + o + 8 * D); }
#pragma unroll
                for (int mm = 0; mm < 2; ++mm) { const int m = 2 * mh + mm; u32x4 b0, b1, q0, q1; W.lines_to_acc(L[mm][0], L[mm][1], b0, b1); float ss = 0.f;
                    { float x[8]; unpack8(b0, x); const f32x4 a = acc[ai][0][m][0], b = acc[ai][0][m][1];
                      x[0] += a.x; x[1] += a.y; x[2] += a.z; x[3] += a.w; x[4] += b.x; x[5] += b.y; x[6] += b.z; x[7] += b.w; b0 = pack8(x, 1.0f);
                      ss += (x[0] * x[0] + x[1] * x[1]) + (x[2] * x[2] + x[3] * x[3]) + (x[4] * x[4] + x[5] * x[5]) + (x[6] * x[6] + x[7] * x[7]); }
                    { float x[8]; unpack8(b1, x); const f32x4 a = acc[ai][1][m][0], b = acc[ai][1][m][1];
                      x[0] += a.x; x[1] += a.y; x[2] += a.z; x[3] += a.w; x[4] += b.x; x[5] += b.y; x[6] += b.z; x[7] += b.w; b1 = pack8(x, 1.0f);
                      ss += (x[0] * x[0] + x[1] * x[1]) + (x[2] * x[2] + x[3] * x[3]) + (x[4] * x[4] + x[5] * x[5]) + (x[6] * x[6] + x[7] * x[7]); }
                    ss += __shfl_xor(ss, 16); ss += __shfl_xor(ss, 32); ssm[m] = ss;
                    W.acc_to_lines(b0, b1, q0, q1);
                    const size_t oo = base + (size_t)(ai * 128 + m * 16) * D; st16_wt(xb + oo, q0); st16_wt(xb + oo + 8 * D, q1); }
            }
            { const float sel = W.fq == 0 ? ssm[0] : (W.fq == 1 ? ssm[1] : (W.fq == 2 ? ssm[2] : ssm[3]));
              ssp[((size_t)u.pm * 256 + wr * 64 + ai * 128 + W.fq * 16 + W.fr) * 16 + u.pn * 4 + wc] = sel; }
        }
    }
};

constexpr int NWAVES = 8;
constexpr int RING_OFF = 0, RING_BYTES = 131072;
constexpr int RS_OFF = RING_BYTES;
constexpr int EPI_OFF = RS_OFF + 4096;
constexpr int LDSCTL_OFF = 157696;   static_assert(LDSCTL_OFF >= mx::RT_END, "LDS map");
constexpr int LDS_BYTES = 158720;
constexpr size_t CTL_ZERO_BYTES = 131072;
constexpr int CW_BAR = 4096;
#define XB_TMO      128
#define XB_XCNT(j)  (256  + 64 * (j))
#define XB_XSUB(j)  (1280 + 64 * (j))
#define XB_XGEN(j)  (2304 + 64 * (j))
#define XB_TOP      3328
#define XB_TOPGEN   3392
#define XCD_BAR_WORDS 3456
#define XB_SPIN_CAP (1u << 22)
__device__ __forceinline__ unsigned xb_ld(unsigned* p)              { return __hip_atomic_load(p, __ATOMIC_RELAXED, __HIP_MEMORY_SCOPE_AGENT); }
__device__ __forceinline__ unsigned xb_add(unsigned* p, unsigned v) { return __hip_atomic_fetch_add(p, v, __ATOMIC_RELAXED, __HIP_MEMORY_SCOPE_AGENT); }
__device__ __forceinline__ unsigned xb_xcc_id() { return (unsigned)__builtin_amdgcn_s_getreg((3 << 11) | 20) & 0xFu; }
#define XB_SPIN(cond, bar) do { unsigned _sp = 0; while (cond) { __builtin_amdgcn_s_sleep(1); \
    if ((++_sp & 255u) == 0u) { if (xb_ld(&(bar)[XB_TMO])) break; if (_sp > XB_SPIN_CAP) { atomicAdd(&(bar)[XB_TMO], 1u); break; } } } } while (0)
struct XcdBarrier { unsigned* bar; unsigned x; volatile LAS unsigned* st; };
__device__ __forceinline__ XcdBarrier xcd_barrier_post(unsigned* bar, volatile LAS unsigned* st) {
    XcdBarrier b; b.bar = bar; b.x = xb_xcc_id(); b.st = st;
    if (threadIdx.x == 0) st[3] = xb_add(&bar[XB_XCNT(b.x)], 1u);
    return b;
}
__device__ __forceinline__ void xcd_barrier_complete(unsigned* bar, unsigned x, unsigned& nloc, unsigned& nx, unsigned& regular) {
    const unsigned G = gridDim.x * gridDim.y * gridDim.z;
    unsigned sum, cnt, mine, reg, sp = 0u;
    for (;;) {
        sum = 0u; cnt = 0u; mine = 0u; reg = (G % 8u == 0u) ? 1u : 0u;
#pragma unroll
        for (unsigned j = 0; j < 16; ++j) { const unsigned c = xb_ld(&bar[XB_XCNT(j)]); sum += c; cnt += (c > 0u) ? 1u : 0u; mine = (j == x) ? c : mine; reg = (c == (j < 8u ? G / 8u : 0u)) ? reg : 0u; }
        if (sum == G) break;
        __builtin_amdgcn_s_sleep(1);
        if ((++sp & 255u) == 0u) { if (xb_ld(&bar[XB_TMO])) break; if (sp > XB_SPIN_CAP) { atomicAdd(&bar[XB_TMO], 1u); break; } }
    }
    nloc = mine > 0u ? mine : 1u; nx = cnt > 0u ? cnt : 1u; regular = reg;
}
__device__ __forceinline__ void xcd_barrier(const XcdBarrier& b, int wave, bool local = false) {
    asm volatile("s_waitcnt vmcnt(0)" ::: "memory");
    __syncthreads();
    if (tid_from_wave(wave) == 0) {
        unsigned* bar = b.bar;
        __builtin_amdgcn_s_waitcnt(0);
        unsigned nloc = b.st[0], nx = b.st[1];
        if (nloc == 0u) { unsigned reg; xcd_barrier_complete(bar, b.x, nloc, nx, reg); b.st[0] = nloc; b.st[1] = nx; b.st[2] = reg; }
        const unsigned old = xb_add(&bar[XB_XSUB(b.x)], 1u);
        const unsigned gen = old / nloc;
        if (old + 1u == (gen + 1u) * nloc) {
            if (!local) { __builtin_amdgcn_fence(__ATOMIC_RELEASE, "agent"); asm volatile("s_waitcnt vmcnt(0)" ::: "memory"); }
            if (!local) {
                const unsigned og = xb_add(&bar[XB_TOP], 1u);
                const unsigned tg = og / nx;
                __builtin_amdgcn_fence(__ATOMIC_ACQUIRE, "agent");
                if (og + 1u == (tg + 1u) * nx) xb_add(&bar[XB_TOPGEN], 1u);
                else XB_SPIN(xb_ld(&bar[XB_TOPGEN]) == tg, bar);
            } else __builtin_amdgcn_fence(__ATOMIC_ACQUIRE, "agent");
            xb_add(&bar[XB_XGEN(b.x)], 1u);
            asm volatile("s_waitcnt vmcnt(0)" ::: "memory");
        } else {
            __builtin_amdgcn_fence(__ATOMIC_ACQUIRE, "agent");
            XB_SPIN(xb_ld(&bar[XB_XGEN(b.x)]) == gen, bar);
            asm volatile("s_waitcnt vmcnt(0)" ::: "memory");
        }
    }
    __syncthreads();
}

template <class Sched>
__device__ __forceinline__ void build_rstd_table(LAS unsigned char* lds, const Sched& S, const float* ssp, int wave) {
    LAS float* tab = (LAS float*)(lds + RS_OFF); volatile LAS int* pml = (volatile LAS int*)(lds + LDSCTL_OFF);
    int p0 = -1, p1 = -1, p2 = -1, p3 = -1; pg8::Unit u;
    for (int i = 0; S.next(i, u); ++i) { const int pm = u.pm; if (pm == p0 || pm == p1 || pm == p2 || pm == p3) continue;
        if (p0 < 0) p0 = pm; else if (p1 < 0) p1 = pm; else if (p2 < 0) p2 = pm; else if (p3 < 0) p3 = pm; }
    int t0_ = tid_from_wave(wave); asm volatile("" : "+v"(t0_));
    if (t0_ == 0) { pml[0] = p0; pml[1] = p1; pml[2] = p2; pml[3] = p3; }
    for (int idx = t0_; idx < 1024; idx += NWAVES * 64) { const int slot = idx >> 8; const int pm = slot == 0 ? p0 : (slot == 1 ? p1 : (slot == 2 ? p2 : p3));
        if (pm >= 0) { const f32x4* q = (const f32x4*)(ssp + (size_t)(pm * 256 + (idx & 255)) * 16); const f32x4 a = q[0], b = q[1], c = q[2], d = q[3];
            const float s = ((a.x + a.y) + (a.z + a.w)) + ((b.x + b.y) + (b.z + b.w)) + ((c.x + c.y) + (c.z + c.w)) + ((d.x + d.y) + (d.z + d.w));
            tab[idx] = rsqrtf(s * (1.0f / D) + EPS); } }
    __syncthreads();
}

__device__ __forceinline__ void st4_wt(void* p, float v) { asm volatile("global_store_dword %0, %1, off sc0 sc1\n\ts_nop 1" :: "v"(p), "v"(v) : "memory"); }
__device__ __forceinline__ void ld16x8_sys(f32x4 (&v)[8], const float* const (&p)[8]) {
    asm volatile("global_load_dwordx4 %0, %8, off sc0 sc1\n\tglobal_load_dwordx4 %1, %9, off sc0 sc1\n\tglobal_load_dwordx4 %2, %10, off sc0 sc1\n\tglobal_load_dwordx4 %3, %11, off sc0 sc1\n\t"
                 "global_load_dwordx4 %4, %12, off sc0 sc1\n\tglobal_load_dwordx4 %5, %13, off sc0 sc1\n\tglobal_load_dwordx4 %6, %14, off sc0 sc1\n\tglobal_load_dwordx4 %7, %15, off sc0 sc1\n\t"
                 "s_waitcnt vmcnt(0)"
                 : "=&v"(v[0]), "=&v"(v[1]), "=&v"(v[2]), "=&v"(v[3]), "=&v"(v[4]), "=&v"(v[5]), "=&v"(v[6]), "=&v"(v[7])
                 : "v"(p[0]), "v"(p[1]), "v"(p[2]), "v"(p[3]), "v"(p[4]), "v"(p[5]), "v"(p[6]), "v"(p[7]) : "memory"); }
constexpr int CW_FIN = 16384;
struct EpiFinal {
    static constexpr bool REPEATABLE = false;
    const bf16_t* xb; float* ssp; const float* gfin; float* out; unsigned* cnt; LAS unsigned char* scr;
    __device__ __forceinline__ void operator()(f32x4 (&acc)[2][2][4][2], const pg8::Unit& u, int wr, int wc, int fr_, int fq_) const {
        WaveTile W; W.init(scr, wr, wc, fr_, fq_);
        const int fr = W.fr, fq = W.fq;
        const size_t rowb = (size_t)u.pm * 256 + wr * 64; const int colb = u.pn * 256 + wc * 64;
        const size_t base = (rowb + W.r8) * D + colb + 8 * W.c8;
#pragma unroll
        for (int ai = 0; ai < 2; ++ai) {
            float ssm[4];
#pragma unroll
            for (int mh = 0; mh < 2; ++mh) {
                u32x4 L[2][2];
#pragma unroll
                for (int mm = 0; mm < 2; ++mm) { const size_t o = base + (size_t)(ai * 128 + (2 * mh + mm) * 16) * D; L[mm][0] = *(const u32x4*)(xb + o); L[mm][1] = *(const u32x4*)(xb + o + 8 * D); }
#pragma unroll
                for (int mm = 0; mm < 2; ++mm) { const int m = 2 * mh + mm; u32x4 b0, b1; W.lines_to_acc(L[mm][0], L[mm][1], b0, b1); float ss = 0.f;
#pragma unroll
                    for (int bj = 0; bj < 2; ++bj) { float x[8]; unpack8(bj == 0 ? b0 : b1, x); f32x4& a = acc[ai][bj][m][0]; f32x4& b = acc[ai][bj][m][1];
                        a.x += x[0]; a.y += x[1]; a.z += x[2]; a.w += x[3]; b.x += x[4]; b.y += x[5]; b.z += x[6]; b.w += x[7];
                        ss += (a.x * a.x + a.y * a.y) + (a.z * a.z + a.w * a.w) + (b.x * b.x + b.y * b.y) + (b.z * b.z + b.w * b.w); }
                    ss += __shfl_xor(ss, 16); ss += __shfl_xor(ss, 32); ssm[m] = ss; }
            }
            const float sel = fq == 0 ? ssm[0] : (fq == 1 ? ssm[1] : (fq == 2 ? ssm[2] : ssm[3]));
            st4_wt(ssp + (rowb + ai * 128 + fq * 16 + fr) * 16 + u.pn * 4 + wc, sel);
        }
        asm volatile("s_waitcnt vmcnt(0)" ::: "memory");
        unsigned* c = cnt + u.pm * 16;
        if (fr_ == 0 && fq_ == 0) (void)xb_add(c, 1u);
        { unsigned sp = 0; while (xb_ld(c) < 32u) { __builtin_amdgcn_s_sleep(1); if (++sp > XB_SPIN_CAP) break; } }
        float rs[2][4]; f32x4 pp[8]; const float* pa[8];
#pragma unroll
        for (int i = 0; i < 8; ++i) pa[i] = ssp + (rowb + (i >> 2) * 128 + (i & 3) * 16 + fr) * 16 + 4 * fq;
        ld16x8_sys(pp, pa);
#pragma unroll
        for (int i = 0; i < 8; ++i) { const f32x4 p = pp[i]; float t = (p.x + p.y) + (p.z + p.w); t += __shfl_xor(t, 16); t += __shfl_xor(t, 32); rs[i >> 2][i & 3] = rsqrtf(t * (1.0f / D) + EPS); }
        const unsigned v0 = (unsigned)fr * 128u + ((((unsigned)(2 * fq)) ^ ((unsigned)fr & 7u)) << 4), v1 = (unsigned)fr * 128u + ((((unsigned)(2 * fq + 1)) ^ ((unsigned)fr & 7u)) << 4);
#pragma unroll
        for (int bj = 0; bj < 2; ++bj) {
            const f32x4 g0 = *(const f32x4*)(gfin + colb + 32 * bj + 8 * fq), g1 = *(const f32x4*)(gfin + colb + 32 * bj + 8 * fq + 4);
            float* ob = out + (rowb + W.r8) * D + colb + 32 * bj + 4 * W.c8;
#pragma unroll
            for (int ai = 0; ai < 2; ++ai)
#pragma unroll
                for (int m = 0; m < 4; ++m) { const float r = rs[ai][m]; const f32x4 a = acc[ai][bj][m][0], b = acc[ai][bj][m][1];
                    *(LAS f32x4*)(W.s + v0) = (f32x4){a.x * r * g0.x, a.y * r * g0.y, a.z * r * g0.z, a.w * r * g0.w};
                    *(LAS f32x4*)(W.s + v1) = (f32x4){b.x * r * g1.x, b.y * r * g1.y, b.z * r * g1.z, b.w * r * g1.w};
                    const f32x4 q0 = *(const LAS f32x4*)(W.s + W.rd), q1 = *(const LAS f32x4*)(W.s + 1024 + W.rd);
                    float* o = ob + (size_t)(ai * 128 + m * 16) * D; *(f32x4*)o = q0; *(f32x4*)(o + (size_t)8 * D) = q1; }
        }
    }
};

struct RstdPre { LAS unsigned char* lds; const pg8::StaticOrder* S; const float* ssp; int wave;
    __device__ __forceinline__ void operator()() const { build_rstd_table(lds, *S, ssp, wave); } };
constexpr int PH_PRO = 0, PH_FIN = 1 + 6 * DEPTH, NPH = PH_FIN + 1;
struct Args { const float* in[13]; float* out; unsigned char* ws; int ph_lo, ph_hi, li, pad; };
__global__ void __launch_bounds__(NWAVES * 64, 2) mega(Args args) {
    extern __shared__ __attribute__((aligned(16))) unsigned char lds_raw[];
    LAS unsigned char* lds = (LAS unsigned char*)lds_raw;
    const int tid = threadIdx.x, wave = __builtin_amdgcn_readfirstlane(tid >> 6);
    const int G = gridDim.x, bx = blockIdx.x, vcu = (G % 8 == 0) ? (bx % 8) * (G / 8) + bx / 8 : bx;
    unsigned char* ws = args.ws;
    for (int u = tid; u < 512 / 4; u += NWAVES * 64) ((LAS unsigned*)(lds + LDSCTL_OFF))[u] = 0u;
    __syncthreads();
    XcdBarrier bar = xcd_barrier_post((unsigned*)(ws + WS_CTL) + CW_BAR + args.li * XCD_BAR_WORDS, (volatile LAS unsigned*)(lds + LDSCTL_OFF) + 8);
    float* xf = args.out; bf16_t* xb = (bf16_t*)(ws + WS_XB); float* ssp = (float*)(ws + WS_SSP);
    bf16_t* patt = (bf16_t*)(ws + WS_PATT); bf16_t* pret = (bf16_t*)(ws + WS_PRET); bf16_t* prg = (bf16_t*)(ws + WS_PRG);
    bf16_t* pga = (bf16_t*)(ws + WS_PGA); bf16_t* pgr = (bf16_t*)(ws + WS_PGR); bf16_t* m1 = pga  ; bf16_t* act = (bf16_t*)(ws + WS_ACT);
    const int gw = vcu * NWAVES + wave, ngw = G * NWAVES;
    const RsLds rs{(const LAS float*)(lds + RS_OFF), (const LAS int*)(lds + LDSCTL_OFF)};

    const int lo = args.ph_lo, hi = args.ph_hi;
    const bool fuse_fin = (G % 128 == 0) && lo == 0 && hi == NPH;
#define IN(k) (lo <= (k) && (k) < hi)
#define SEAM(k) do { if (IN(k) && IN((k) + 1)) xcd_barrier(bar, wave); } while (0)
#define SEAM_L(k) do { if (IN(k) && IN((k) + 1)) xcd_barrier(bar, wave, xl); } while (0)
    if (IN(PH_PRO)) {
        int tl_ = tid_from_wave(wave); asm volatile("" : "+v"(tl_)); const int lane = tl_ & 63;
        WPtrs P{args.in[1], args.in[2], args.in[5], args.in[6], args.in[7], args.in[8], args.in[9], args.in[10], args.in[11], args.in[4]};
        prologue_weights(P, ws, (float*)(lds_raw + wave * 16384), gw, ngw, lane, 0, PRO_I_IN0);
        const float* x = args.in[0];
        for (int t0 = gw * 4; t0 < T; t0 += ngw * 4) {
            f32x4 v[4][4];
#pragma unroll
            for (int rr = 0; rr < 4; ++rr) { const f32x4* xr = (const f32x4*)(x + (size_t)(t0 + rr) * D) + lane;
#pragma unroll
                for (int j = 0; j < 4; ++j) v[rr][j] = xr[64 * j]; }
#pragma unroll
            for (int rr = 0; rr < 4; ++rr) { const int t = t0 + rr; float s = 0.f;
#pragma unroll
                for (int j = 0; j < 4; ++j) s += (v[rr][j].x * v[rr][j].x + v[rr][j].y * v[rr][j].y) + (v[rr][j].z * v[rr][j].z + v[rr][j].w * v[rr][j].w);
                s = wave_sum(s);
                unsigned long long* o8 = (unsigned long long*)(xb + (size_t)t * D) + lane;
#pragma unroll
                for (int j = 0; j < 4; ++j) o8[64 * j] = (unsigned long long)pk2(v[rr][j].x, v[rr][j].y) | ((unsigned long long)pk2(v[rr][j].z, v[rr][j].w) << 32);
                if (lane < 16) ssp[(size_t)t * 16 + lane] = lane == 0 ? s : 0.f; }
        }
    }
    SEAM(PH_PRO);
    const bool xl = (G == 256) && (((volatile LAS unsigned*)(lds + LDSCTL_OFF))[10] != 0u);
    const int vb = xl ? (int)(((volatile LAS unsigned*)(lds + LDSCTL_OFF))[11] * 8u + bar.x) : bx;
    for (int l = 0; l < DEPTH; ++l) {
        const int pb = 1 + 6 * l;
        const unsigned char* wl = ws + WS_W + (size_t)l * W_LAYER;
        if (IN(pb + 0)) {
            pg8::StaticOrder S; S.init(T, DIN, G, vb);
            const pg8::Gemm g{xb, (const bf16_t*)(wl + W_IN), D, D, T, DIN, D};
            const EpiProjT E{rs, patt, pret, prg, pga, pgr, lds + EPI_OFF};
            pg8::gemm_phase<EpiProjT, pg8::StaticOrder, true>(lds + RING_OFF, g, S, E, wave, RstdPre{lds, &S, ssp, wave});
            if (2 * vb >= G) {
                int tl_ = tid_from_wave(wave); asm volatile("" : "+v"(tl_));
                WPtrs P{args.in[1], args.in[2], args.in[5], args.in[6], args.in[7], args.in[8], args.in[9], args.in[10], args.in[11], args.in[4]};
                prologue_weights(P, ws, (float*)(lds_raw + wave * 16384), (vb - G / 2) * NWAVES + wave, (G - G / 2) * NWAVES, tl_ & 63,
                                 l == 0 ? PRO_I_IN0 : PRO_PER_LAYER + PRO_I_IN0, l == 0 ? PRO_PER_LAYER + PRO_I_IN0 : 2 * PRO_PER_LAYER);
            }
        }
        SEAM(pb + 0);
        if (IN(pb + 1)) mixer_phase_impl<3>(lds, ws, args.in[3] + l * AH, args.in[4] + l * RH * RDV, vb, G, patt, prg, wave, xl);
        SEAM_L(pb + 1);
        if (IN(pb + 2)) {
            pg8::StaticOrder S; S.init(T, D, G, vb);
            { const pg8::Gemm g{patt, (const bf16_t*)(wl + W_AO), 768, 512, T, D, 512}; const EpiM1F E{pga, m1, lds + EPI_OFF};
              pg8::gemm_phase<EpiM1F, pg8::StaticOrder, true>(lds + RING_OFF, g, S, E, wave); }
            { const pg8::Gemm g{prg, (const bf16_t*)(wl + W_RO), D, D, T, D, D}; const EpiMrgF E{pgr, m1, lds + EPI_OFF};
              pg8::gemm_phase<EpiMrgF, pg8::StaticOrder, true>(lds + RING_OFF, g, S, E, wave); }
        }
        SEAM_L(pb + 2);
        if (IN(pb + 3)) {
            pg8::StaticOrder S; S.init(T, D, G, vb);
            const pg8::Gemm g{m1, (const bf16_t*)(wl + W_OUT), D, D, T, D, D}; const EpiResF E{xb, ssp, lds + EPI_OFF};
            pg8::gemm_phase<EpiResF, pg8::StaticOrder, true>(lds + RING_OFF, g, S, E, wave);
        }
        SEAM(pb + 3);
        if (IN(pb + 4)) {
            pg8::StaticOrder S; S.init(T, 2 * DFF, G, vb);
            const pg8::Gemm g{xb, (const bf16_t*)(wl + W_GU), D, D, T, 2 * DFF, D}; const Epi8Dual<EpiAct<RsLds>> E{{rs, act}};
            pg8::gemm_phase<Epi8Dual<EpiAct<RsLds>>, pg8::StaticOrder, true>(lds + RING_OFF, g, S, E, wave, RstdPre{lds, &S, ssp, wave});
        }
        SEAM_L(pb + 4);
        if (IN(pb + 5)) {
            pg8::StaticOrder S; S.init(T, D, G, vb);
            const pg8::Gemm g{act, (const bf16_t*)(wl + W_DN), DFF, DFF, T, D, DFF};
            if (l == DEPTH - 1 && fuse_fin) { const EpiFinal E{xb, (float*)(ws + WS_SSP2), args.in[12], xf, (unsigned*)(ws + WS_CTL) + CW_FIN, lds + EPI_OFF};
                pg8::gemm_phase<EpiFinal, pg8::StaticOrder, true>(lds + RING_OFF, g, S, E, wave); }
            else { const EpiResF E{xb, ssp, lds + EPI_OFF};
                pg8::gemm_phase<EpiResF, pg8::StaticOrder, true>(lds + RING_OFF, g, S, E, wave); }
        }
        if (!(l == DEPTH - 1 && fuse_fin)) SEAM(pb + 5);
    }
    if (IN(PH_FIN) && !fuse_fin) {
        int tl_ = tid_from_wave(wave); asm volatile("" : "+v"(tl_)); const int lane = tl_ & 63;
        const float* g = args.in[12];
        for (int t = gw; t < T; t += ngw) {
            const u32x4* xr = (const u32x4*)(xb + (size_t)t * D) + lane; u32x4 w[2]; float v[2][8]; float s = 0.f;
#pragma unroll
            for (int j = 0; j < 2; ++j) { w[j] = xr[64 * j]; unpack8(w[j], v[j]);
#pragma unroll
                for (int e = 0; e < 8; ++e) s += v[j][e] * v[j][e]; }
            s = wave_sum(s); const float r = rsqrtf(s * (1.0f / D) + EPS);
#pragma unroll
            for (int j = 0; j < 2; ++j) { const f32x4* gr = (const f32x4*)(g + 512 * j + 8 * lane); f32x4* o = (f32x4*)(xf + (size_t)t * D + 512 * j + 8 * lane); const f32x4 g0 = gr[0], g1 = gr[1];
                o[0] = (f32x4){v[j][0] * r * g0.x, v[j][1] * r * g0.y, v[j][2] * r * g0.z, v[j][3] * r * g0.w};
                o[1] = (f32x4){v[j][4] * r * g1.x, v[j][5] * r * g1.y, v[j][6] * r * g1.z, v[j][7] * r * g1.w}; }
        }
    }
#undef IN
#undef SEAM
#undef SEAM_L
}
extern "C" void kernel_launch(void* const* d_in, const int* in_sizes, int n_in, void* d_out, int out_size, void* d_ws, size_t ws_size, hipStream_t stream) {
    static int grid = 0;
    if (grid == 0) {
        if (n_in != 13 || in_sizes[0] != T * D || out_size != T * D || ws_size < WS_END) { fprintf(stderr, "kernel_launch: bad arguments (n_in %d, out %d, ws %zu)\n", n_in, out_size, ws_size); grid = -1; return; }
        int dev = 0, cus = 0, per_cu = 0;
        if (hipGetDevice(&dev) != hipSuccess || hipDeviceGetAttribute(&cus, hipDeviceAttributeMultiprocessorCount, dev) != hipSuccess) { grid = -1; return; }
        if (hipFuncSetAttribute((const void*)mega, hipFuncAttributeMaxDynamicSharedMemorySize, LDS_BYTES) != hipSuccess) { fprintf(stderr, "kernel_launch: hipFuncSetAttribute failed\n"); grid = -1; return; }
        if (hipOccupancyMaxActiveBlocksPerMultiprocessor(&per_cu, (const void*)mega, NWAVES * 64, LDS_BYTES) != hipSuccess || per_cu < 1) { fprintf(stderr, "kernel_launch: occupancy query says %d\n", per_cu); grid = -1; (void)hipGetLastError(); return; }
        grid = cus;
    }
    if (grid < 0) return;
    (void)hipMemsetAsync((char*)d_ws + WS_CTL, 0, CTL_ZERO_BYTES, stream);
    Args a{};
    for (int i = 0; i < 13; ++i) a.in[i] = (const float*)d_in[i];
    a.out = (float*)d_out; a.ws = (unsigned char*)d_ws; a.ph_lo = 0; a.ph_hi = NPH; a.li = 0;
    hipLaunchKernelGGL(mega, dim3(grid), dim3(NWAVES * 64), LDS_BYTES, stream, a);
}
```

```cpp
#include <hip/hip_runtime.h>
#include <cstdio>
#include <cstdint>

constexpr int D = 1024, BATCH = 16, SEQ = 2048, DEPTH = 2, T = BATCH * SEQ;
constexpr int AH = 8, AHD = 64;
constexpr int RH = 4, RDK = 128, RDV = 256;
constexpr int DFF = 2816, DIN = 5888;
constexpr float EPS = 1e-6f;

typedef unsigned short bf16_t;
typedef unsigned u32x4 __attribute__((ext_vector_type(4)));
typedef float f32x4 __attribute__((ext_vector_type(4)));

constexpr size_t MiB = 1u << 20;
constexpr size_t WS_CTL = 0;
constexpr size_t WS_W = 2 * MiB;
constexpr size_t W_IN = 0, W_AO = W_IN + (size_t)DIN * D * 2, W_RO = W_AO + (size_t)D * 512 * 2, W_OUT = W_RO + (size_t)D * D * 2,
                 W_GU = W_OUT + (size_t)D * D * 2, W_DN = W_GU + (size_t)2 * DFF * D * 2, W_LAYER = W_DN + (size_t)D * DFF * 2;
static_assert(W_LAYER == 33 * MiB, "weights per layer");
constexpr size_t WS_XB = 68 * MiB;
constexpr size_t WS_SSP = 132 * MiB;
constexpr size_t WS_PATT = 134 * MiB;
constexpr size_t WS_PRET = 182 * MiB;
constexpr size_t WS_PRG = 310 * MiB;
constexpr size_t WS_PGA = 374 * MiB;
constexpr size_t WS_PGR = 438 * MiB;
constexpr size_t WS_SSP2 = 502 * MiB;
constexpr size_t WS_END = 504 * MiB;
constexpr size_t WS_ACT = WS_PRET;
constexpr size_t ACT_PANEL = (size_t)256 * DFF * 2;
static_assert(11 * ACT_PANEL <= 16 * MiB && 5 * ACT_PANEL <= 8 * MiB && WS_PRG == WS_PRET + 128 * MiB, "act panels");
__host__ __device__ __forceinline__ size_t act_panel_off(int pm) {
    const int x = pm >> 4, j = pm & 15;
    return j < 11 ? (size_t)x * (16 * MiB) + (size_t)j * ACT_PANEL : (WS_PRG - WS_PRET) + (size_t)x * (8 * MiB) + (size_t)(j - 11) * ACT_PANEL; }

__device__ __forceinline__ void st16_wt(void* p, u32x4 v) { asm volatile("global_store_dwordx4 %0, %1, off sc1\n\ts_nop 1" :: "v"(p), "v"(v) : "memory"); }
__device__ __forceinline__ float bf2f(bf16_t b) { return __uint_as_float(((unsigned)b) << 16); }
__device__ __forceinline__ unsigned f2bf(float f) { unsigned u = __float_as_uint(f); return (u + 0x7fffu + ((u >> 16) & 1u)) >> 16; }
typedef float f32x2_hw __attribute__((ext_vector_type(2)));
typedef __bf16 bf16x2_hw __attribute__((ext_vector_type(2)));
__device__ __forceinline__ unsigned pk2(float lo, float hi) { f32x2_hw v = {lo, hi}; bf16x2_hw b = __builtin_convertvector(v, bf16x2_hw); return __builtin_bit_cast(unsigned, b); }
__device__ __forceinline__ float sigmoidf_(float x) { return __builtin_amdgcn_rcpf(1.0f + __builtin_amdgcn_exp2f(x * -1.4426950408889634f)); }
__device__ __forceinline__ float wave_sum(float v) {
#pragma unroll
    for (int o = 1; o < 64; o <<= 1) v += __shfl_xor(v, o);
    return v;
}
__device__ __forceinline__ float wave_max(float v) {
#pragma unroll
    for (int o = 1; o < 64; o <<= 1) v = fmaxf(v, __shfl_xor(v, o));
    return v;
}
__device__ __forceinline__ u32x4 pack8(const float* v, float s) {
    u32x4 w; w.x = pk2(v[0] * s, v[1] * s); w.y = pk2(v[2] * s, v[3] * s); w.z = pk2(v[4] * s, v[5] * s); w.w = pk2(v[6] * s, v[7] * s); return w;
}
__device__ __forceinline__ void unpack8(u32x4 w, float* v) {
    v[0] = __uint_as_float(w.x << 16); v[1] = __uint_as_float(w.x & 0xffff0000u); v[2] = __uint_as_float(w.y << 16); v[3] = __uint_as_float(w.y & 0xffff0000u);
    v[4] = __uint_as_float(w.z << 16); v[5] = __uint_as_float(w.z & 0xffff0000u); v[6] = __uint_as_float(w.w << 16); v[7] = __uint_as_float(w.w & 0xffff0000u);
}

__device__ __forceinline__ void transpose_item(const float* W, int K, int N, const float* g, bf16_t* WT, float* scr, int k0, int n0, int orow0, int lane) {
    float v[32];
    const float* src = W + (size_t)(k0 + (lane >> 5)) * N + n0 + (lane & 31);
#pragma unroll
    for (int i = 0; i < 32; ++i) v[i] = src[(size_t)(2 * i) * N];
    if (g) {
#pragma unroll
        for (int i = 0; i < 32; ++i) v[i] *= g[k0 + 2 * i + (lane >> 5)];
    }
#pragma unroll
    for (int i = 0; i < 32; ++i) scr[(2 * i + (lane >> 5)) * 33 + (lane & 31)] = v[i];
    asm volatile("s_waitcnt lgkmcnt(0)" ::: "memory");
    const int c = lane & 7;
#pragma unroll
    for (int j = 0; j < 4; ++j) { const int n = (lane >> 3) + 8 * j; const float* s = scr + (8 * c) * 33 + n;
        u32x4 o; o.x = pk2(s[0 * 33], s[1 * 33]); o.y = pk2(s[2 * 33], s[3 * 33]); o.z = pk2(s[4 * 33], s[5 * 33]); o.w = pk2(s[6 * 33], s[7 * 33]);
        st16_wt(WT + (size_t)(orow0 + n) * K + k0 + 8 * c, o); }
    asm volatile("s_waitcnt lgkmcnt(0)" ::: "memory");
}
struct WPtrs { const float *norm_mix, *w_in, *w_ao, *w_ro, *w_out, *norm_ffn, *w_gate, *w_up, *w_dn, *gn_gain; };
constexpr int PRO_I_IN0 = (D / 64) * (DIN / 32);
constexpr int PRO_PER_LAYER = (D / 64) * (DIN / 32) + (512 / 64) * (D / 32) + 2 * (D / 64) * (D / 32) + 2 * (D / 64) * (DFF / 32) + (DFF / 64) * (D / 32);
__device__ __forceinline__ void prologue_weights(const WPtrs& P, unsigned char* ws, float* scr, int gw, int ngw, int lane, int it_lo = 0, int it_hi = 1 << 30) {
    constexpr int I_IN = (D / 64) * (DIN / 32), I_AO = (512 / 64) * (D / 32), I_SQ = (D / 64) * (D / 32), I_GU = (D / 64) * (DFF / 32), I_DN = (DFF / 64) * (D / 32);
    constexpr int PER_LAYER = I_IN + I_AO + 2 * I_SQ + 2 * I_GU + I_DN; static_assert(PER_LAYER == PRO_PER_LAYER, "item list");
    const int it_end = it_hi < DEPTH * PER_LAYER ? it_hi : DEPTH * PER_LAYER;
    for (int it = it_lo + gw; it < it_end; it += ngw) {
        const int l = it / PER_LAYER; int r = it % PER_LAYER;
        unsigned char* wl = ws + WS_W + (size_t)l * W_LAYER;
        if (r < I_IN) { const int nb = DIN / 32, kb = r / nb, n0 = 32 * (r % nb); transpose_item(P.w_in + (size_t)l * D * DIN, D, DIN, P.norm_mix + l * D, (bf16_t*)(wl + W_IN), scr, 64 * kb, n0, n0, lane); continue; } r -= I_IN;
        if (r < I_AO) { const int nb = D / 32, kb = r / nb, n0 = 32 * (r % nb); transpose_item(P.w_ao + (size_t)l * 512 * D, 512, D, nullptr, (bf16_t*)(wl + W_AO), scr, 64 * kb, n0, n0, lane); continue; } r -= I_AO;
        if (r < I_SQ) { const int nb = D / 32, kb = r / nb, n0 = 32 * (r % nb); transpose_item(P.w_ro + (size_t)l * D * D, D, D, P.gn_gain + l * D, (bf16_t*)(wl + W_RO), scr, 64 * kb, n0, n0, lane); continue; } r -= I_SQ;
        if (r < I_SQ) { const int nb = D / 32, kb = r / nb, n0 = 32 * (r % nb); transpose_item(P.w_out + (size_t)l * D * D, D, D, nullptr, (bf16_t*)(wl + W_OUT), scr, 64 * kb, n0, n0, lane); continue; } r -= I_SQ;
        if (r < I_GU) { const int nb = DFF / 32, kb = r / nb, n0 = 32 * (r % nb); transpose_item(P.w_gate + (size_t)l * D * DFF, D, DFF, P.norm_ffn + l * D, (bf16_t*)(wl + W_GU), scr, 64 * kb, n0, 256 * (n0 / 128) + 64 * ((n0 % 128) / 32), lane); continue; } r -= I_GU;
        if (r < I_GU) { const int nb = DFF / 32, kb = r / nb, n0 = 32 * (r % nb); transpose_item(P.w_up + (size_t)l * D * DFF, D, DFF, P.norm_ffn + l * D, (bf16_t*)(wl + W_GU), scr, 64 * kb, n0, 256 * (n0 / 128) + 64 * ((n0 % 128) / 32) + 32, lane); continue; } r -= I_GU;
        { const int nb = D / 32, kb = r / nb, n0 = 32 * (r % nb); transpose_item(P.w_dn + (size_t)l * DFF * D, DFF, D, nullptr, (bf16_t*)(wl + W_DN), scr, 64 * kb, n0, n0, lane); }
    }
}
typedef float f32x2p __attribute__((ext_vector_type(2)));
template <class RS> struct EpiAct {
    RS rs; bf16_t* act;
    __device__ __forceinline__ void apply8(int row, int col0, float s, const float* g, const float* u) const {
        const float s2 = s * -1.4426950408889634f, ss = s * s; u32x4 w; float e[8], o[8];
#pragma unroll
        for (int j = 0; j < 8; ++j) e[j] = __builtin_amdgcn_exp2f(g[j] * s2);
#pragma unroll
        for (int j = 0; j < 8; ++j) o[j] = (g[j] * u[j]) * ss;
#pragma unroll
        for (int j = 0; j < 8; ++j) e[j] = __builtin_amdgcn_rcpf(1.0f + e[j]);
#pragma unroll
        for (int j = 0; j < 8; ++j) o[j] *= e[j];
        w.x = pk2(o[0], o[1]); w.y = pk2(o[2], o[3]); w.z = pk2(o[4], o[5]); w.w = pk2(o[6], o[7]);
        st16_wt((bf16_t*)((unsigned char*)act + act_panel_off(row >> 8)) + (size_t)(row & 255) * DFF + col0, w);
    }
};
#define LAS __attribute__((address_space(3)))
#define GAS __attribute__((address_space(1)))
namespace mx {
typedef short bf16x8 __attribute__((ext_vector_type(8)));
typedef short s16x4 __attribute__((ext_vector_type(4)));
typedef float f32x16 __attribute__((ext_vector_type(16)));
typedef unsigned u32x2 __attribute__((ext_vector_type(2)));
typedef float f32x2_t __attribute__((ext_vector_type(2)));
typedef __bf16 bf16x2_t __attribute__((ext_vector_type(2)));
typedef short v4i16_t __attribute__((ext_vector_type(4)));
constexpr float LOG2E = 1.4426950408889634f;
#define MFMA32(a, b, c) __builtin_amdgcn_mfma_f32_32x32x16_bf16((a), (b), (c), 0, 0, 0)
__device__ __forceinline__ unsigned cvtpk(float lo, float hi) { f32x2_t v = {lo, hi}; bf16x2_t b = __builtin_convertvector(v, bf16x2_t); return __builtin_bit_cast(unsigned, b); }
template <int S> __device__ __forceinline__ bf16x8 pack_step(const f32x16& x) {
    u32x4 p; p.x = cvtpk(x[8 * S + 0], x[8 * S + 1]); p.y = cvtpk(x[8 * S + 2], x[8 * S + 3]); p.z = cvtpk(x[8 * S + 4], x[8 * S + 5]); p.w = cvtpk(x[8 * S + 6], x[8 * S + 7]);
    return __builtin_bit_cast(bf16x8, p);
}
__device__ __forceinline__ bf16x8 join4(s16x4 a, s16x4 b) { bf16x8 r; r[0] = a[0]; r[1] = a[1]; r[2] = a[2]; r[3] = a[3]; r[4] = b[0]; r[5] = b[1]; r[6] = b[2]; r[7] = b[3]; return r; }
__device__ __forceinline__ s16x4 tr_read(const LAS unsigned char* p) { return __builtin_bit_cast(s16x4, __builtin_amdgcn_ds_read_tr16_b64_v4i16((LAS v4i16_t*)p)); }
__device__ __forceinline__ f32x16 zero16() { f32x16 z;
#pragma unroll
    for (int i = 0; i < 16; ++i) z[i] = 0.f; return z; }
__device__ __forceinline__ constexpr int cr(int r) { return (r & 3) + 8 * (r >> 2); }

constexpr int AT_KP = 144, AT_VP = 192;
constexpr int AT_VOFF = 256 * AT_KP;
struct AttnStage { u32x4 kv[4], vv[4]; bf16x8 qn[2][4]; };
__device__ __forceinline__ void attn_load(AttnStage& S, const bf16_t* patt, int item, int tid) {
    const int kvh = item & 1, nb = (item >> 1) & 15, b = item >> 5;
    const int lane = tid & 63, w = __builtin_amdgcn_readfirstlane(tid >> 6), q = lane & 31, hh = lane >> 5, g = w & 3, qh = w >> 2;
    const bf16_t* tb = patt + ((size_t)b * SEQ + (size_t)nb * 128) * 768;
    const bf16_t* base = tb + 512 + kvh * 64;
    const int radd = nb == 0 ? 128 : 0;
#pragma unroll
    for (int i = 0; i < 4; ++i) { const int c = tid + 512 * i, row = c >> 3, ch = c & 7, re = row < 128 ? row + radd : row;
        const bf16_t* src = base + (re - 128) * 768 + ch * 8; S.kv[i] = *(const u32x4*)src; S.vv[i] = *(const u32x4*)(src + 128); }
#pragma unroll
    for (int sb = 0; sb < 2; ++sb)
#pragma unroll
        for (int ks = 0; ks < 4; ++ks) S.qn[sb][ks] = *(const bf16x8*)(tb + (unsigned)((64 * qh + 32 * sb + q) * 768 + kvh * 256 + (8 * g + 2 * ks + hh) * 8));
}
constexpr int AT_QOFF = AT_VOFF + 256 * AT_VP;
constexpr int AT_SINK_OFF = AT_QOFF + 65536;
__device__ __forceinline__ void attn_flush(LAS unsigned char* lds, bf16_t* aout, int item, int tid) {
    const int lane = tid & 63, w = __builtin_amdgcn_readfirstlane(tid >> 6), g = w & 3, qh = w >> 2;
    const int kvh = item & 1, nb = (item >> 1) & 15, b = item >> 5;
    const LAS unsigned char* Ob = lds + AT_QOFF + w * 8192;
    bf16_t* ob_ = aout + ((size_t)b * SEQ + (size_t)nb * 128 + 64 * qh) * 768 + kvh * 256 + g * 64;
    u32x4 yv[8]; const int r8 = lane >> 3, c8 = lane & 7;
#pragma unroll
    for (int i = 0; i < 8; ++i) { const int row = 8 * i + r8; yv[i] = *(const LAS u32x4*)(Ob + row * 128 + ((c8 ^ (row & 7)) << 4)); }
#pragma unroll
    for (int i = 0; i < 8; ++i) { const int row = 8 * i + r8; st16_wt(ob_ + (unsigned)(row * 768 + c8 * 8), yv[i]); }
}
__device__ __forceinline__ void attn_item(LAS unsigned char* lds, const bf16_t* patt, bf16_t* aout, int item, int next_item, int prev_item, AttnStage& S, int tid) {
    asm volatile("" : "+v"(tid));
    const int lane = tid & 63, w = __builtin_amdgcn_readfirstlane(tid >> 6), q = lane & 31, hh = lane >> 5;
    const int kvh = item & 1, nb = (item >> 1) & 15, b = item >> 5;
    const int g = w & 3, qh = w >> 2, h = kvh * 4 + g;
    const size_t tok0 = (size_t)b * SEQ + (size_t)nb * 128;
    LAS unsigned char* Kimg = lds; LAS unsigned char* Vimg = lds + AT_VOFF; LAS unsigned char* Ob = lds + AT_QOFF + w * 8192;
    bf16x8 qc[2][4];
#pragma unroll
    for (int sb = 0; sb < 2; ++sb)
#pragma unroll
        for (int ks = 0; ks < 4; ++ks) qc[sb][ks] = S.qn[sb][ks];
#pragma unroll
    for (int i = 0; i < 4; ++i) { const int c = tid + 512 * i, row = c >> 3, ch = c & 7;
        *(LAS u32x4*)(Kimg + row * AT_KP + ch * 16) = S.kv[i]; *(LAS u32x4*)(Vimg + row * AT_VP + ch * 16) = S.vv[i]; }
    asm volatile("s_waitcnt lgkmcnt(0)" ::: "memory"); __builtin_amdgcn_s_barrier(); asm volatile("" ::: "memory");
    attn_load(S, patt, next_item >= 0 ? next_item : item, tid);
    if (prev_item >= 0) attn_flush(lds, aout, prev_item, tid);
    const float c0s = 0.125f * LOG2E, slr = exp2f(-(float)(h + 1)) * 8.0f  , sink2 = ((const LAS float*)(lds + AT_SINK_OFF))[h] * LOG2E;
    const int q4 = (lane & 15) >> 2, p4 = lane & 3, blk = (lane >> 4) & 1;
#pragma unroll
    for (int sb = 0; sb < 2; ++sb) {
        const int jt0 = 2 * qh + sb;
        const unsigned orb = (unsigned)(32 * sb + q) * 128u, orx = (unsigned)(q & 7);
        int qm = q - 4 * hh; asm volatile("" : "+v"(qm));
        f32x16 sa[5];
#pragma unroll
        for (int u = 0; u < 5; ++u) {
            if (nb > 0 || jt0 + u >= 4) {
                const float offu = -slr * (float)(128 - 32 * u + qm);
#pragma unroll
                for (int r = 0; r < 16; ++r) sa[u][r] = offu + slr * (float)cr(r);
#pragma unroll
                for (int ks = 0; ks < 4; ++ks) { const bf16x8 kf = *(const LAS bf16x8*)(Kimg + (32 * (jt0 + u) + q) * AT_KP + (2 * ks + hh) * 16); sa[u] = MFMA32(kf, qc[sb][ks], sa[u]); }
            } else {
#pragma unroll
                for (int r = 0; r < 16; ++r) sa[u][r] = -INFINITY;
            }
        }
#pragma unroll
        for (int r = 0; r < 16; ++r) { sa[0][r] = (cr(r) > qm) ? sa[0][r] : -INFINITY; sa[4][r] = (cr(r) <= qm) ? sa[4][r] : -INFINITY; }
        float m = -INFINITY;
#pragma unroll
        for (int u = 0; u < 5; ++u)
#pragma unroll
            for (int r = 0; r < 16; ++r) m = fmaxf(m, sa[u][r]);
        m = fmaxf(m, __shfl_xor(m, 32)); const float mc = fmaxf(m * c0s, sink2);
        float l = 0.f;
#pragma unroll
        for (int u = 0; u < 5; ++u)
#pragma unroll
            for (int r = 0; r < 16; ++r) { const float p = __builtin_amdgcn_exp2f(__builtin_fmaf(sa[u][r], c0s, -mc)); sa[u][r] = p; l += p; }
        l += __shfl_xor(l, 32); l += __builtin_amdgcn_exp2f(sink2 - mc);
        f32x16 oa[2]; oa[0] = zero16(); oa[1] = zero16();
#pragma unroll
        for (int u = 0; u < 5; ++u) {
            if (nb > 0 || jt0 + u >= 4) {
                const bf16x8 pf0 = pack_step<0>(sa[u]), pf1 = pack_step<1>(sa[u]);
#pragma unroll
                for (int s2 = 0; s2 < 2; ++s2)
#pragma unroll
                    for (int dt = 0; dt < 2; ++dt) {
                        const LAS unsigned char* vp = Vimg + (32 * (jt0 + u) + 16 * s2 + 4 * hh + q4) * AT_VP + (32 * dt + 16 * blk + 4 * p4) * 2;
                        const bf16x8 vf = join4(tr_read(vp), tr_read(vp + 8 * AT_VP));
                        oa[dt] = MFMA32(vf, s2 == 0 ? pf0 : pf1, oa[dt]);
                    }
            }
        }
        const float inv = __builtin_amdgcn_rcpf(l);
#pragma unroll
        for (int dt = 0; dt < 2; ++dt)
#pragma unroll
            for (int g4 = 0; g4 < 4; ++g4) { u32x2 o; o.x = cvtpk(oa[dt][4 * g4] * inv, oa[dt][4 * g4 + 1] * inv); o.y = cvtpk(oa[dt][4 * g4 + 2] * inv, oa[dt][4 * g4 + 3] * inv);
                *(LAS u32x2*)(Ob + orb + ((((unsigned)(4 * dt + g4)) ^ orx) << 4) + 8 * hh) = o; }
    }
    asm volatile("s_waitcnt lgkmcnt(0)" ::: "memory"); __builtin_amdgcn_s_barrier(); asm volatile("" ::: "memory");
}

constexpr int QP = 272, KP = 320, VP = 512;
constexpr int RT_Q = 0, RT_KD = RT_Q + 128 * QP, RT_V = RT_KD + 128 * KP, RT_ST = RT_V + 128 * VP, RT_END = RT_ST + 8192;
__device__ __forceinline__ void ret_item(LAS unsigned char* lds, const bf16_t* pret, const bf16_t* prg, bf16_t* rout, const float* gain, int b, int h, int c0, int c1, int tid) {
    const int w = __builtin_amdgcn_readfirstlane(tid >> 6);
    LAS unsigned char* Qimg = lds + RT_Q; LAS unsigned char* KDimg = lds + RT_KD; LAS unsigned char* Vimg = lds + RT_V; LAS float* st = (LAS float*)(lds + RT_ST);
    const float lg = log2f(1.0f - exp2f(-5.0f - (float)h));
    const float g128 = exp2f(128.0f * lg), kbase = 0.08838834764831845f;
    const bf16_t* pb = pret + (size_t)b * SEQ * 2048 + h * 128;
    f32x16 state[4];
#pragma unroll
    for (int d = 0; d < 4; ++d) state[d] = zero16();
    u32x4 kr[4], qr[4];
#define RT_OFFS() const unsigned kqoff = (unsigned)(tid >> 4) * 2048u + (unsigned)(tid & 15) * 8u, voff = (unsigned)(tid >> 5) * 2048u + (unsigned)(tid & 31) * 8u
#define RT_LOAD_K(c) do { const bf16_t* cb_ = pb + (size_t)(c) * (128 * 2048) + 512; _Pragma("unroll") for (int i = 0; i < 4; ++i) kr[i] = *(const u32x4*)(cb_ + (size_t)i * (32 * 2048) + kqoff); } while (0)
#define RT_LOAD_Q(c) do { const bf16_t* cb_ = pb + (size_t)(c) * (128 * 2048); _Pragma("unroll") for (int i = 0; i < 4; ++i) qr[i] = *(const u32x4*)(cb_ + (size_t)i * (32 * 2048) + kqoff); } while (0)
#define RT_LOAD_V(c) do { const bf16_t* cb_ = pb + (size_t)(c) * (128 * 2048) + 1024 + h * 128; _Pragma("unroll") for (int i = 0; i < 8; ++i) vr[i] = *(const u32x4*)(cb_ + (size_t)i * (16 * 2048) + voff); } while (0)
#define RT_STORE_KD() do { _Pragma("unroll") for (int i = 0; i < 4; ++i) { const int cc = tid + 512 * i, row = cc >> 4, ch = cc & 15; float f[8]; unpack8(kr[i], f); const float sc = kbase * exp2f(lg * (float)(127 - row)); \
        u32x4 o_; o_.x = cvtpk(f[0] * sc, f[1] * sc); o_.y = cvtpk(f[2] * sc, f[3] * sc); o_.z = cvtpk(f[4] * sc, f[5] * sc); o_.w = cvtpk(f[6] * sc, f[7] * sc); *(LAS u32x4*)(KDimg + row * KP + ch * 16) = o_; } } while (0)
#define RT_STORE_Q() do { _Pragma("unroll") for (int i = 0; i < 4; ++i) { const int cc = tid + 512 * i, row = cc >> 4, ch = cc & 15; *(LAS u32x4*)(Qimg + row * QP + ch * 16) = qr[i]; } } while (0)
#define RT_STORE_V() do { _Pragma("unroll") for (int i = 0; i < 8; ++i) { const int cc = tid + 512 * i, row = cc >> 5, ch = cc & 31; *(LAS u32x4*)(Vimg + row * VP + ((ch ^ ((row & 3) << 2)) * 16)) = vr[i]; } } while (0)
    if (c0 > 0) {
    u32x4 vr[8];
    { asm volatile("" : "+v"(tid)); RT_OFFS(); RT_LOAD_K(0); RT_LOAD_V(0); }
    for (int c = 0; c < c0; ++c) {
        asm volatile("" : "+v"(tid));
        const int lane = tid & 63, hh = lane >> 5, q4 = (lane & 15) >> 2, p4 = lane & 3, blk = (lane >> 4) & 1;
        RT_STORE_KD(); RT_STORE_V();
        { const int cn = (c + 1 < c0) ? c + 1 : c; RT_OFFS(); RT_LOAD_K(cn); RT_LOAD_V(cn); }
        __syncthreads();
#pragma unroll
        for (int d = 0; d < 4; ++d)
#pragma unroll
            for (int r = 0; r < 16; ++r) state[d][r] *= g128;
        {
            const LAS unsigned char* vb = Vimg + (8 * hh + q4) * VP + ((4 * (w ^ q4) + 2 * blk) * 16 + 8 * p4);
            const LAS unsigned char* kb = KDimg + (8 * hh + q4) * KP + (16 * blk + 4 * p4) * 2;
            bf16x8 vf[2], kt[2][4];
#define RT_LDW(s_, b_) do { vf[b_] = join4(tr_read(vb + (16 * (s_)) * VP), tr_read(vb + (16 * (s_) + 4) * VP)); \
                _Pragma("unroll") for (int dkt = 0; dkt < 4; ++dkt) kt[b_][dkt] = join4(tr_read(kb + (16 * (s_)) * KP + 64 * dkt), tr_read(kb + (16 * (s_) + 4) * KP + 64 * dkt)); } while (0)
            RT_LDW(0, 0);
#pragma unroll
            for (int s = 0; s < 8; ++s) {
                if (s < 7) RT_LDW(s + 1, (s + 1) & 1);
#pragma unroll
                for (int dkt = 0; dkt < 4; ++dkt) state[dkt] = MFMA32(kt[s & 1][dkt], vf[s & 1], state[dkt]);
            }
#undef RT_LDW
        }
        __syncthreads();
    }
    }
    { asm volatile("" : "+v"(tid)); RT_OFFS(); RT_LOAD_K(c0); RT_LOAD_Q(c0); }
    __builtin_amdgcn_s_waitcnt(0x0070);
    for (int c = c0; c < c1; ++c) {
        const size_t tokc = (size_t)b * SEQ + (size_t)c * 128;
        asm volatile("" : "+v"(tid));
        const int lane = tid & 63, q = lane & 31, hh = lane >> 5, q4 = (lane & 15) >> 2, p4 = lane & 3, blk = (lane >> 4) & 1;
        RT_STORE_KD(); RT_STORE_Q();
        {
            const int vrow = 16 * w + (lane >> 5), vch = (lane & 31); const bf16_t* cb_ = pb + (size_t)c * (128 * 2048) + 1024 + h * 128;
#pragma unroll
            for (int i = 0; i < 8; ++i) { const int row = vrow + 2 * i, ch = vch ^ ((row & 3) << 2);
                __builtin_amdgcn_global_load_lds((const unsigned*)(cb_ + (unsigned)(row * 2048 + ch * 8)), (LAS unsigned*)(Vimg + (8 * w + i) * 1024), 16, 0, 0); }
        }
        asm volatile("s_waitcnt lgkmcnt(0)" ::: "memory"); __builtin_amdgcn_s_barrier(); asm volatile("" ::: "memory");
        f32x16 o[4];
        unsigned sp[2][8];
#pragma unroll
        for (int sl = 0; sl < 2; ++sl) {
            const int n = w + 8 * sl;
            if (n < 10) {
                const int it = n >= 6 ? 3 : (n >= 3 ? 2 : (n >= 1 ? 1 : 0)), jt = n - (it * (it + 1)) / 2;
                f32x16 a = zero16();
                {
                    const LAS unsigned char* kp1 = KDimg + (32 * jt + q) * KP + hh * 16; const LAS unsigned char* qp1 = Qimg + (32 * it + q) * QP + hh * 16;
                    bf16x8 kf[2], qq[2]; kf[0] = *(const LAS bf16x8*)kp1; qq[0] = *(const LAS bf16x8*)qp1;
#pragma unroll
                    for (int ks = 0; ks < 8; ++ks) { if (ks < 7) { kf[(ks + 1) & 1] = *(const LAS bf16x8*)(kp1 + 32 * (ks + 1)); qq[(ks + 1) & 1] = *(const LAS bf16x8*)(qp1 + 32 * (ks + 1)); }
                        a = MFMA32(kf[ks & 1], qq[ks & 1], a); }
                }
                const float fi = exp2f(lg * (float)(32 * it + q - 127));
#pragma unroll
                for (int r = 0; r < 16; ++r) { float v = a[r] * fi; if (it == jt && (cr(r) + 4 * hh > q)) v = 0.f; a[r] = v; }
#pragma unroll
                for (int g4 = 0; g4 < 4; ++g4) { sp[sl][2 * g4] = cvtpk(a[4 * g4], a[4 * g4 + 1]); sp[sl][2 * g4 + 1] = cvtpk(a[4 * g4 + 2], a[4 * g4 + 3]); }
            }
        }
#pragma unroll
        for (int it = 0; it < 4; ++it) o[it] = zero16();
        {
            const LAS unsigned char* qb3 = Qimg + q * QP + 8 * hh;
            bf16x8 bq[2][4];
#define RT_LD3(g_, b_) do { _Pragma("unroll") for (int it = 0; it < 4; ++it) bq[b_][it] = join4(*(const LAS s16x4*)(qb3 + (32 * it) * QP + 32 * (g_)), *(const LAS s16x4*)(qb3 + (32 * it) * QP + 32 * (g_) + 16)); } while (0)
            RT_LD3(0, 0);
#pragma unroll
            for (int g = 0; g < 8; ++g) {
                if (g < 7) RT_LD3(g + 1, (g + 1) & 1);
                const bf16x8 af = (g & 1) ? pack_step<1>(state[g >> 1]) : pack_step<0>(state[g >> 1]);
#pragma unroll
                for (int it = 0; it < 4; ++it) o[it] = MFMA32(af, bq[g & 1][it], o[it]);
            }
#undef RT_LD3
        }
        asm volatile("" ::: "memory"); __builtin_amdgcn_s_waitcnt(0x0070); __builtin_amdgcn_s_barrier(); asm volatile("" ::: "memory");
#pragma unroll
        for (int sl = 0; sl < 2; ++sl) {
            const int n = w + 8 * sl;
            if (n < 10) {
                const int it = n >= 6 ? 3 : (n >= 3 ? 2 : (n >= 1 ? 1 : 0)), jt = n - (it * (it + 1)) / 2;
#pragma unroll
                for (int g4 = 0; g4 < 4; ++g4) { u32x2 v; v.x = sp[sl][2 * g4]; v.y = sp[sl][2 * g4 + 1]; *(LAS u32x2*)(Qimg + (32 * it + q) * QP + (4 * jt + g4) * 16 + 8 * hh) = v; }
            }
        }
        __syncthreads();
        { const int cn = (c + 1 < c1) ? c + 1 : c; RT_OFFS(); RT_LOAD_K(cn); RT_LOAD_Q(cn); }
#pragma unroll
        for (int it = 0; it < 4; ++it) { const float gi = exp2f(lg * (float)(32 * it + q + 1));
#pragma unroll
            for (int r = 0; r < 16; ++r) o[it][r] *= gi; }
#pragma unroll
        for (int d = 0; d < 4; ++d)
#pragma unroll
            for (int r = 0; r < 16; ++r) state[d][r] *= g128;
        {
            const LAS unsigned char* vb = Vimg + (8 * hh + q4) * VP + ((4 * (w ^ q4) + 2 * blk) * 16 + 8 * p4);
            const LAS unsigned char* sb2 = Qimg + q * QP + hh * 16;
            bf16x8 vf[2], sf[2][4];
#define RT_LD2(s_, b_) do { vf[b_] = join4(tr_read(vb + (16 * (s_)) * VP), tr_read(vb + (16 * (s_) + 4) * VP)); \
                _Pragma("unroll") for (int it = 0; it < 4; ++it) if (2 * it + 1 >= (s_)) sf[b_][it] = *(const LAS bf16x8*)(sb2 + (32 * it) * QP + 32 * (s_)); } while (0)
            RT_LD2(0, 0);
#pragma unroll
            for (int s = 0; s < 8; ++s) {
                if (s < 7) RT_LD2(s + 1, (s + 1) & 1);
#pragma unroll
                for (int it = 0; it < 4; ++it) if (2 * it + 1 >= s) o[it] = MFMA32(vf[s & 1], sf[s & 1][it], o[it]);
            }
#undef RT_LD2
        }
        if (c < 15) {
            const LAS unsigned char* vb = Vimg + (8 * hh + q4) * VP + ((4 * (w ^ q4) + 2 * blk) * 16 + 8 * p4);
            const LAS unsigned char* kb = KDimg + (8 * hh + q4) * KP + (16 * blk + 4 * p4) * 2;
            bf16x8 vf[2], kt[2][4];
#define RT_LD4(s_, b_) do { vf[b_] = join4(tr_read(vb + (16 * (s_)) * VP), tr_read(vb + (16 * (s_) + 4) * VP)); \
                _Pragma("unroll") for (int dkt = 0; dkt < 4; ++dkt) kt[b_][dkt] = join4(tr_read(kb + (16 * (s_)) * KP + 64 * dkt), tr_read(kb + (16 * (s_) + 4) * KP + 64 * dkt)); } while (0)
            RT_LD4(0, 0);
#pragma unroll
            for (int s = 0; s < 8; ++s) {
                if (s < 7) RT_LD4(s + 1, (s + 1) & 1);
#pragma unroll
                for (int dkt = 0; dkt < 4; ++dkt) state[dkt] = MFMA32(kt[s & 1][dkt], vf[s & 1], state[dkt]);
            }
#undef RT_LD4
        }
        __syncthreads();
        {
            const int grow0 = 16 * w + (lane >> 5), gch = lane & 31; const bf16_t* gb_ = prg + tokc * 1024 + h * 256;
#pragma unroll
            for (int i = 0; i < 8; ++i) { const int row = grow0 + 2 * i, ch = gch ^ (row & 31);
                __builtin_amdgcn_global_load_lds((const unsigned*)(gb_ + (unsigned)(row * 1024 + ch * 8)), (LAS unsigned*)(Qimg + (8 * w + i) * 1024), 16, 0, 0); }
        }
        float mean[4], rstd[4];
#pragma unroll
        for (int it = 0; it < 4; ++it) { float ps = 0.f, pq = 0.f;
#pragma unroll
            for (int r = 0; r < 16; ++r) { ps += o[it][r]; pq += o[it][r] * o[it][r]; }
            ps += __shfl_xor(ps, 32); pq += __shfl_xor(pq, 32); if (hh == 0) { st[w * 128 + 32 * it + q] = ps; st[1024 + w * 128 + 32 * it + q] = pq; } }
        asm volatile("s_waitcnt lgkmcnt(0)" ::: "memory"); __builtin_amdgcn_s_barrier(); asm volatile("" ::: "memory");
#pragma unroll
        for (int it = 0; it < 4; ++it) { float s8 = 0.f, q8 = 0.f;
#pragma unroll
            for (int ww = 0; ww < 8; ++ww) { s8 += st[ww * 128 + 32 * it + q]; q8 += st[1024 + ww * 128 + 32 * it + q]; }
            mean[it] = s8 * (1.0f / 256.0f); rstd[it] = rsqrtf(fmaxf(q8 * (1.0f / 256.0f) - mean[it] * mean[it], 0.f) + EPS); }
        asm volatile("" ::: "memory"); __builtin_amdgcn_s_waitcnt(0x0070); __builtin_amdgcn_s_barrier(); asm volatile("" ::: "memory");
#pragma unroll
        for (int it = 0; it < 4; ++it) {
            const int row = 32 * it + q; const unsigned rbase = (unsigned)row * 512u, rx = (unsigned)(row & 31);
#pragma unroll
            for (int g4 = 0; g4 < 4; ++g4) {
                const unsigned c8 = (unsigned)(8 * w + 2 * g4 + hh);
                const unsigned off = rbase + (((c8 >> 1) ^ rx) << 4) + ((c8 & 1u) << 3);
                const u32x2 rw = *(const LAS u32x2*)(Qimg + off); const float ms = rstd[it];
                const float rg0 = __uint_as_float(rw.x << 16), rg1 = __uint_as_float(rw.x & 0xffff0000u), rg2 = __uint_as_float(rw.y << 16), rg3 = __uint_as_float(rw.y & 0xffff0000u);
                const float y0 = (o[it][4 * g4 + 0] - mean[it]) * ms * rg0, y1 = (o[it][4 * g4 + 1] - mean[it]) * ms * rg1;
                const float y2 = (o[it][4 * g4 + 2] - mean[it]) * ms * rg2, y3 = (o[it][4 * g4 + 3] - mean[it]) * ms * rg3;
                u32x2 ov; ov.x = cvtpk(y0, y1); ov.y = cvtpk(y2, y3); *(LAS u32x2*)(Vimg + off) = ov;
            }
        }
        asm volatile("s_waitcnt lgkmcnt(0)" ::: "memory"); __builtin_amdgcn_s_barrier(); asm volatile("" ::: "memory");
        {
            u32x4 yv[8]; bf16_t* ob_ = rout + tokc * 1024 + h * 256;
#pragma unroll
            for (int i = 0; i < 8; ++i) { const int cc = tid + 512 * i, row = cc >> 5, ch = cc & 31; yv[i] = *(const LAS u32x4*)(Vimg + row * 512 + ((ch ^ (row & 31)) << 4)); }
#pragma unroll
            for (int i = 0; i < 8; ++i) { const int cc = tid + 512 * i, row = cc >> 5, ch = cc & 31; st16_wt(ob_ + (unsigned)(row * 1024 + ch * 8), yv[i]); }
        }
        __syncthreads();
    }
#undef RT_OFFS
#undef RT_LOAD_K
#undef RT_LOAD_Q
#undef RT_LOAD_V
#undef RT_STORE_KD
#undef RT_STORE_Q
#undef RT_STORE_V
}
}

__device__ __forceinline__ int tid_from_wave(int wave) { unsigned z = 0u; asm volatile("" : "+v"(z));
    return wave * 64 + (int)__builtin_amdgcn_mbcnt_hi(~0u, __builtin_amdgcn_mbcnt_lo(~0u, z)); }
struct Args;
template <int WHAT  >
__device__ __forceinline__ void mixer_phase_impl(LAS unsigned char* lds, unsigned char* ws, const float* sinks, const float* gain, int bx, int G, bf16_t* aout, bf16_t* rout, int wave, bool consec) {
    const bf16_t* patt = (const bf16_t*)(ws + WS_PATT); const bf16_t* pret = (const bf16_t*)(ws + WS_PRET); const bf16_t* prg = (const bf16_t*)(ws + WS_PRG);
    int tid_ = tid_from_wave(wave); asm volatile("" : "+v"(tid_));
    const int tid = tid_;
    const int vcu = (G % 8 == 0) ? (bx % 8) * (G / 8) + bx / 8 : bx;
    if constexpr ((WHAT & 2) != 0)
    for (int it = vcu; it < BATCH * RH * 4; it += G) {
        const int bh = it >> 2, seg = it & 3, c0 = seg == 0 ? 0 : (seg == 1 ? 5 : (seg == 2 ? 9 : 13)), c1 = seg == 0 ? 5 : (seg == 1 ? 9 : (seg == 2 ? 13 : 16));
        mx::ret_item(lds, pret, prg, rout, gain, bh >> 2, bh & 3, c0, c1, tid);
    }
    if constexpr ((WHAT & 1) != 0)
    {
        if (tid < AH) ((LAS float*)(lds + mx::AT_SINK_OFF))[tid] = sinks[tid];
        const int NIT = BATCH * 16 * 2, npc = NIT / G, first = consec ? vcu * npc : vcu, step = consec ? 1 : G, last = consec ? first + npc : NIT;
        mx::AttnStage S; if (first < last) mx::attn_load(S, patt, first, tid);
        int prev = -1;
        for (int it = first; it < last; it += step) { mx::attn_item(lds, patt, aout, it, (it + step < last) ? it + step : -1, prev, S, tid); prev = it; }
        if (prev >= 0) mx::attn_flush(lds, aout, prev, tid);
    }
}


namespace pg8 {
typedef short bf16x8 __attribute__((ext_vector_type(8)));
constexpr int BM = 256, BK = 64, HALF = 128, HTB = HALF * BK * 2  , STAGE_BYTES = 8 * HTB, NXCD = 8;
#ifndef PG8_WGM
#define PG8_WGM 4
#endif
constexpr int WGM = PG8_WGM;
__host__ __device__ __forceinline__ int lds_byte(int r, int c) { const int st = (r >> 4) * 2 + (c >> 5), rr = r & 15, cc = c & 31, ob = rr * 64 + cc * 2; return st * 1024 + (ob ^ (((ob >> 9) & 1) << 5)); }
__host__ __device__ __forceinline__ void stage_rc(int b, int& R, int& C) { const int st = b / 1024, sb = b % 1024, swz = sb ^ (((sb >> 9) & 1) << 5); R = (st >> 1) * 16 + swz / 64; C = (st & 1) * 32 + (swz % 64) / 2; }
__host__ __device__ __forceinline__ int perm32(int rho) { const int n = rho >> 4, i = rho & 15; return 8 * (i >> 2) + 4 * n + (i & 3); }
struct Unit { int pm, pn; };
struct Gemm { const bf16_t* A; const bf16_t* Bt; int lda, ldb, M, N, K; bool apan = false; };
__device__ __forceinline__ const char* panelA(const Gemm& g, int pm, size_t tstepA) { return (const char*)g.A + (g.apan ? act_panel_off(pm) : (size_t)pm * tstepA); }
struct StaticOrder {
    int nM, nN, nwg, G, c;
    __host__ __device__ void init(int M, int N, int G_, int c_) { nM = M / BM; nN = N / BM; nwg = nM * nN; G = G_; c = c_; }
    __host__ __device__ bool next(int i, Unit& u) const {
        const long L = (long)i * G + c; if (L >= nwg) return false;
        int wgid = (int)L; { const int q = nwg / NXCD, r = nwg % NXCD, xcd = wgid % NXCD, off = wgid / NXCD; wgid = (xcd < r ? xcd * (q + 1) : r * (q + 1) + (xcd - r) * q) + off; }
        const int nig = WGM * nN, gid = wgid / nig, fm = gid * WGM, gsz = (nM - fm) < WGM ? (nM - fm) : WGM;
        u.pm = fm + ((wgid % nig) % gsz); u.pn = (wgid % nig) / gsz; return true;
    }
};
struct NoPre { __device__ __forceinline__ void operator()() const {} };
template <class Epi, class Sched, bool ALIGN_EPI, class Pre = NoPre>
__device__ __forceinline__ void gemm_phase(LAS unsigned char* lds, const Gemm g, const Sched& S, const Epi& E, int wave, const Pre& pre = Pre()) {
    int tid_ = tid_from_wave(wave); asm volatile("" : "+v"(tid_));
    int wid_ = wave; asm volatile("" : "+s"(wid_));
    const int tid = tid_, wid = wid_, lane = tid & 63, wr = wid >> 2, wc = wid & 3, fr = lane & 15, fq = lane >> 4;
    const int nt = g.K / BK;
#define KT(t) ((size_t)(t))
    unsigned voffA[2], voffB[2];
#pragma unroll
    for (int i = 0; i < 2; ++i) { int R, C; stage_rc(tid * 16 + i * 8192, R, C); const int Rb = 64 * (R >> 5) + perm32(R & 31);
        voffA[i] = (unsigned)(R * g.lda + C) * 2u; voffB[i] = (unsigned)(Rb * g.ldb + C) * 2u; }
    const size_t kstep = (size_t)(BK * 2);
    const size_t hstepA = (size_t)HALF * g.lda * 2, hstepB = (size_t)32 * g.ldb * 2, tstepA = 2 * hstepA, tstepB = (size_t)BM * g.ldb * 2;
    const unsigned ldsw = (unsigned)wid * 1024u;
    const int aoff = lds_byte(wr * 64 + fr, fq * 8), boff = lds_byte(wc * 32 + fr, fq * 8);
#define PG8_SA(b, h) (((b) * 2 + (h)) * HTB)
#define PG8_SB(b, h) ((4 + (b) * 2 + (h)) * HTB)
#define PG8_STAGE(bufoff, gbase, voff) do { _Pragma("unroll") for (int _i = 0; _i < 2; ++_i) \
        __builtin_amdgcn_global_load_lds((const unsigned*)((const char*)(gbase) + (voff)[_i]), (LAS unsigned*)(lds + (bufoff) + ldsw + _i * 8192), 16, 0, 0); } while (0)
#define PG8_LDA(dst, b, h) do { _Pragma("unroll") for (int m = 0; m < 4; ++m) _Pragma("unroll") for (int k = 0; k < 2; ++k) dst[m][k] = *(const LAS bf16x8*)(lds + PG8_SA(b, h) + aoff + m * 2048 + k * 1024); } while (0)
#define PG8_LDB(dst, b, h) do { _Pragma("unroll") for (int n = 0; n < 2; ++n) _Pragma("unroll") for (int k = 0; k < 2; ++k) dst[n][k] = *(const LAS bf16x8*)(lds + PG8_SB(b, h) + boff + n * 2048 + k * 1024); } while (0)
#define PG8_MMA(ai, bj, At, Bt) do { __builtin_amdgcn_s_setprio(1); _Pragma("unroll") for (int m = 0; m < 4; ++m) _Pragma("unroll") for (int n = 0; n < 2; ++n) _Pragma("unroll") for (int k = 0; k < 2; ++k) \
        acc[ai][bj][m][n] = __builtin_amdgcn_mfma_f32_16x16x32_bf16(Bt[n][k], At[m][k], acc[ai][bj][m][n], 0, 0, 0); __builtin_amdgcn_s_setprio(0); } while (0)
#define PG8_WAIT_V(n) asm volatile("s_waitcnt vmcnt(" #n ")" ::: "memory")
#define PG8_WAIT_L(n) asm volatile("s_waitcnt lgkmcnt(" #n ")" ::: "memory")
#define PG8_BAR __builtin_amdgcn_s_barrier()
#define PG8_SCHED __builtin_amdgcn_sched_barrier(0)
    Unit cur, nxt; int ui = 0;
    if (!S.next(0, cur)) return;
    f32x4 acc[2][2][4][2];
#pragma unroll
    for (int a = 0; a < 2; ++a)
#pragma unroll
        for (int b = 0; b < 2; ++b)
#pragma unroll
            for (int m = 0; m < 4; ++m)
#pragma unroll
                for (int n = 0; n < 2; ++n) acc[a][b][m][n] = (f32x4){0.f, 0.f, 0.f, 0.f};
    bf16x8 At[4][2], B0[2][2], B1[2][2];
    const char* cA = panelA(g, cur.pm, tstepA); const char* cB = (const char*)g.Bt + (size_t)cur.pn * tstepB;
    PG8_STAGE(PG8_SB(0, 0), cB, voffB); PG8_STAGE(PG8_SB(0, 1), cB + hstepB, voffB); PG8_STAGE(PG8_SA(0, 0), cA, voffA); PG8_STAGE(PG8_SA(0, 1), cA + hstepA, voffA);
    pre();
    if (wr == 1) PG8_BAR;
    PG8_WAIT_V(2); PG8_BAR;
    PG8_STAGE(PG8_SB(1, 0), cB + kstep, voffB); PG8_STAGE(PG8_SA(1, 0), cA + kstep, voffA); PG8_STAGE(PG8_SB(1, 1), cB + hstepB + kstep, voffB);
    PG8_WAIT_V(6); PG8_BAR;
    for (;;) {
        const bool has_next = S.next(ui + 1, nxt);
        const char* nA = has_next ? panelA(g, nxt.pm, tstepA) : cA; const char* nB = has_next ? (const char*)g.Bt + (size_t)nxt.pn * tstepB : cB;
        for (int t = 0; t < nt; t += 2) {
            const bool last = (t == nt - 2);
            const char* a1 = cA + KT(t + 1) * kstep;
            const char* a2 = last ? nA : cA + KT(t + 2) * kstep; const char* b2 = last ? nB : cB + KT(t + 2) * kstep;
            const char* a3 = last ? nA + kstep : cA + KT(t + 3) * kstep; const char* b3 = last ? nB + kstep : cB + KT(t + 3) * kstep;
            PG8_LDB(B0, 0, 0); PG8_LDB(B1, 0, 1); PG8_SCHED; PG8_LDA(At, 0, 0); PG8_STAGE(PG8_SA(1, 1), a1 + hstepA, voffA);
            PG8_WAIT_V(8); PG8_WAIT_L(0); PG8_BAR; PG8_MMA(0, 0, At, B0); PG8_MMA(0, 1, At, B1); PG8_BAR; PG8_SCHED;
            PG8_LDA(At, 0, 1); PG8_STAGE(PG8_SB(0, 0), b2, voffB); PG8_STAGE(PG8_SB(0, 1), b2 + hstepB, voffB); PG8_STAGE(PG8_SA(0, 0), a2, voffA);
            PG8_WAIT_V(8); PG8_WAIT_L(0); PG8_BAR; PG8_MMA(1, 0, At, B0); PG8_MMA(1, 1, At, B1); PG8_BAR; PG8_SCHED;
            PG8_LDB(B0, 1, 0); PG8_LDB(B1, 1, 1); PG8_SCHED; PG8_LDA(At, 1, 0); PG8_STAGE(PG8_SA(0, 1), a2 + hstepA, voffA);
            PG8_WAIT_V(8); PG8_WAIT_L(0); PG8_BAR; PG8_MMA(0, 0, At, B0); PG8_MMA(0, 1, At, B1); PG8_BAR; PG8_SCHED;
            PG8_LDA(At, 1, 1); PG8_STAGE(PG8_SB(1, 0), b3, voffB); PG8_STAGE(PG8_SB(1, 1), b3 + hstepB, voffB); PG8_STAGE(PG8_SA(1, 0), a3, voffA);
            PG8_WAIT_V(8); PG8_WAIT_L(0); PG8_BAR; PG8_MMA(1, 0, At, B0); PG8_MMA(1, 1, At, B1); PG8_BAR; PG8_SCHED;
        }
        if constexpr (ALIGN_EPI) { if (wr == 0) PG8_BAR; }
        E(acc, cur, wr, wc, fr, fq);
        if (!has_next) break;
#pragma unroll
        for (int a = 0; a < 2; ++a)
#pragma unroll
            for (int b = 0; b < 2; ++b)
#pragma unroll
                for (int m = 0; m < 4; ++m)
#pragma unroll
                    for (int n = 0; n < 2; ++n) acc[a][b][m][n] = (f32x4){0.f, 0.f, 0.f, 0.f};
        cur = nxt; cA = nA; cB = nB; ++ui;
        if constexpr (ALIGN_EPI) { if (wr == 1) PG8_BAR; }
    }
    PG8_WAIT_V(0);
    if constexpr (!ALIGN_EPI) { if (wr == 0) PG8_BAR; }
    PG8_BAR;
#undef KT
#undef PG8_SA
#undef PG8_SB
#undef PG8_STAGE
#undef PG8_LDA
#undef PG8_LDB
#undef PG8_MMA
#undef PG8_WAIT_V
#undef PG8_WAIT_L
#undef PG8_BAR
#undef PG8_SCHED
}
}

struct RsLds { const LAS float* tab; const LAS int* pml;
    __device__ __forceinline__ const LAS float* panel(int pm) const { const int p0 = pml[0], p1 = pml[1], p2 = pml[2]; const int slot = pm == p0 ? 0 : (pm == p1 ? 1 : (pm == p2 ? 2 : 3)); return tab + slot * 256; } };

template <int ACT  > __device__ __forceinline__ u32x4 proj_pack(const f32x4 a, const f32x4 b, float s) {
    const float v[8] = {a.x, a.y, a.z, a.w, b.x, b.y, b.z, b.w};
    if constexpr (ACT == 0) return pack8(v, s);
    else { const float s2 = s * -1.4426950408889634f; float e[8], o[8];
#pragma unroll
        for (int j = 0; j < 8; ++j) e[j] = __builtin_amdgcn_exp2f(v[j] * s2);
#pragma unroll
        for (int j = 0; j < 8; ++j) e[j] = __builtin_amdgcn_rcpf(1.0f + e[j]);
#pragma unroll
        for (int j = 0; j < 8; ++j) o[j] = ACT == 1 ? (v[j] * s) * e[j] : e[j];
        return pack8(o, 1.0f); }
}
template <int ACT> __device__ __forceinline__ void proj_rows(const f32x4 (&acc)[2][2][4][2], const LAS float* rt, LAS unsigned char* s, unsigned w0, unsigned w1, unsigned rd, bf16_t* tb, int ld, int r8, int c8) {
#pragma unroll
    for (int ai = 0; ai < 2; ++ai) {
        float sc[4];
#pragma unroll
        for (int m = 0; m < 4; ++m) sc[m] = rt[ai * 128 + m * 16];
#pragma unroll
        for (int mh = 0; mh < 2; ++mh) {
            u32x4 q[2][2];
#pragma unroll
            for (int mm = 0; mm < 2; ++mm) { const int m = 2 * mh + mm;
                *(LAS u32x4*)(s + w0) = proj_pack<ACT>(acc[ai][0][m][0], acc[ai][0][m][1], sc[m]);
                *(LAS u32x4*)(s + w1) = proj_pack<ACT>(acc[ai][1][m][0], acc[ai][1][m][1], sc[m]);
                q[mm][0] = *(const LAS u32x4*)(s + rd); q[mm][1] = *(const LAS u32x4*)(s + 1024 + rd); }
#pragma unroll
            for (int mm = 0; mm < 2; ++mm) { bf16_t* p = tb + (size_t)(ai * 128 + (2 * mh + mm) * 16 + r8) * ld + 8 * c8;
                st16_wt(p, q[mm][0]); st16_wt(p + (size_t)8 * ld, q[mm][1]); }
        }
    }
}
struct EpiProjT {
    static constexpr bool REPEATABLE = false;
    RsLds rs; bf16_t *patt, *pret, *prg, *pga, *pgr; LAS unsigned char* scr;
    __device__ __forceinline__ void operator()(const f32x4 (&acc)[2][2][4][2], const pg8::Unit& u, int wr, int wc, int fr, int fq) const {
        int lane_ = fq * 16 + fr; asm volatile("" : "+v"(lane_));
        const int wid = wr * 4 + wc, lane = lane_, r8 = lane >> 3, c8 = lane & 7; fr = lane & 15; fq = lane >> 4;
        LAS unsigned char* s = scr + wid * 2048;
        const int colw = u.pn * 256 + wc * 64; const size_t rowg = (size_t)u.pm * 256 + wr * 64;
        const unsigned w0 = (unsigned)fr * 128u + (((unsigned)fq ^ ((unsigned)fr & 7u)) << 4), w1 = (unsigned)fr * 128u + (((unsigned)(4 + fq) ^ ((unsigned)fr & 7u)) << 4);
        const unsigned rd = (unsigned)r8 * 128u + (((unsigned)c8 ^ (unsigned)r8) << 4);
        const LAS float* rt = rs.panel(u.pm) + wr * 64 + fr;
        if (colw < 768) proj_rows<0>(acc, rt, s, w0, w1, rd, patt + rowg * 768 + colw, 768, r8, c8);
        else if (colw < 2816) proj_rows<0>(acc, rt, s, w0, w1, rd, pret + rowg * 2048 + (colw - 768), 2048, r8, c8);
        else if (colw < 3840) proj_rows<1>(acc, rt, s, w0, w1, rd, prg + rowg * 1024 + (colw - 2816), 1024, r8, c8);
        else proj_rows<2>(acc, rt, s, w0, w1, rd, (colw < 4864 ? pga + (colw - 3840) : pgr + (colw - 4864)) + rowg * 1024, 1024, r8, c8);
    }
};
template <class Ap> struct Epi8Dual {
    static constexpr bool REPEATABLE = false; Ap ap;
    __device__ __forceinline__ void operator()(const f32x4 (&acc)[2][2][4][2], const pg8::Unit& u, int wr, int wc, int fr, int fq) const {
        const int row0 = u.pm * 256 + wr * 64 + fr, col0 = u.pn * 128 + wc * 32 + 8 * fq;
        const LAS float* rt = ap.rs.panel(u.pm); float sc[2][4];
#pragma unroll
        for (int ai = 0; ai < 2; ++ai)
#pragma unroll
            for (int m = 0; m < 4; ++m) sc[ai][m] = rt[ai * 128 + wr * 64 + m * 16 + fr];
#pragma unroll
        for (int ai = 0; ai < 2; ++ai)
#pragma unroll
            for (int m = 0; m < 4; ++m) { const f32x4 a = acc[ai][0][m][0], b = acc[ai][0][m][1], c = acc[ai][1][m][0], d = acc[ai][1][m][1];
                const float gv[8] = {a.x, a.y, a.z, a.w, b.x, b.y, b.z, b.w}, uv[8] = {c.x, c.y, c.z, c.w, d.x, d.y, d.z, d.w};
                ap.apply8(row0 + ai * 128 + m * 16, col0, sc[ai][m], gv, uv); }
    }
};
struct WaveTile {
    LAS unsigned char* s; unsigned w0, w1, rd; int r8, c8, fr, fq;
    __device__ __forceinline__ void init(LAS unsigned char* scr, int wr, int wc, int fr_, int fq_) {
        int lane_ = fq_ * 16 + fr_; asm volatile("" : "+v"(lane_));
        fr = lane_ & 15; fq = lane_ >> 4; r8 = lane_ >> 3; c8 = lane_ & 7; s = scr + (wr * 4 + wc) * 2048;
        w0 = (unsigned)fr * 128u + (((unsigned)fq ^ ((unsigned)fr & 7u)) << 4); w1 = (unsigned)fr * 128u + (((unsigned)(4 + fq) ^ ((unsigned)fr & 7u)) << 4);
        rd = (unsigned)r8 * 128u + (((unsigned)c8 ^ (unsigned)r8) << 4);
    }
    __device__ __forceinline__ void lines_to_acc(u32x4 l0, u32x4 l1, u32x4& a0, u32x4& a1) const { *(LAS u32x4*)(s + rd) = l0; *(LAS u32x4*)(s + 1024 + rd) = l1; a0 = *(const LAS u32x4*)(s + w0); a1 = *(const LAS u32x4*)(s + w1); }
    __device__ __forceinline__ void acc_to_lines(u32x4 a0, u32x4 a1, u32x4& l0, u32x4& l1) const { *(LAS u32x4*)(s + w0) = a0; *(LAS u32x4*)(s + w1) = a1; l0 = *(const LAS u32x4*)(s + rd); l1 = *(const LAS u32x4*)(s + 1024 + rd); }
};
struct EpiM1F {
    static constexpr bool REPEATABLE = false;
    const bf16_t* ga; bf16_t* m1; LAS unsigned char* scr;
    __device__ __forceinline__ void operator()(const f32x4 (&acc)[2][2][4][2], const pg8::Unit& u, int wr, int wc, int fr, int fq) const {
        WaveTile W; W.init(scr, wr, wc, fr, fq);
        const size_t base = ((size_t)u.pm * 256 + wr * 64 + W.r8) * 1024 + (u.pn * 256 + wc * 64) + 8 * W.c8;
#pragma unroll
        for (int ai = 0; ai < 2; ++ai)
#pragma unroll
            for (int mh = 0; mh < 2; ++mh) {
                u32x4 L[2][2];
#pragma unroll
                for (int mm = 0; mm < 2; ++mm) { const size_t o = base + (size_t)(ai * 128 + (2 * mh + mm) * 16) * 1024; L[mm][0] = *(const u32x4*)(ga + o); L[mm][1] = *(const u32x4*)(ga + o + 8 * 1024); }
#pragma unroll
                for (int mm = 0; mm < 2; ++mm) { const int m = 2 * mh + mm; u32x4 g0, g1, q0, q1; W.lines_to_acc(L[mm][0], L[mm][1], g0, g1);
                    float gv[8], o[8];
                    { unpack8(g0, gv); const f32x4 a = acc[ai][0][m][0], b = acc[ai][0][m][1]; const float v[8] = {a.x, a.y, a.z, a.w, b.x, b.y, b.z, b.w};
#pragma unroll
                      for (int j = 0; j < 8; ++j) o[j] = gv[j] * v[j];
                      g0 = pack8(o, 1.0f); }
                    { unpack8(g1, gv); const f32x4 a = acc[ai][1][m][0], b = acc[ai][1][m][1]; const float v[8] = {a.x, a.y, a.z, a.w, b.x, b.y, b.z, b.w};
#pragma unroll
                      for (int j = 0; j < 8; ++j) o[j] = gv[j] * v[j];
                      g1 = pack8(o, 1.0f); }
                    W.acc_to_lines(g0, g1, q0, q1);
                    const size_t oo = base + (size_t)(ai * 128 + m * 16) * 1024; *(u32x4*)(m1 + oo) = q0; *(u32x4*)(m1 + oo + 8 * 1024) = q1; }
            }
    }
};
struct EpiMrgF {
    static constexpr bool REPEATABLE = false;
    const bf16_t* gr; bf16_t* m1; LAS unsigned char* scr;
    __device__ __forceinline__ void operator()(const f32x4 (&acc)[2][2][4][2], const pg8::Unit& u, int wr, int wc, int fr, int fq) const {
        WaveTile W; W.init(scr, wr, wc, fr, fq);
        const size_t base = ((size_t)u.pm * 256 + wr * 64 + W.r8) * 1024 + (u.pn * 256 + wc * 64) + 8 * W.c8;
#pragma unroll
        for (int ai = 0; ai < 2; ++ai)
#pragma unroll
            for (int mh = 0; mh < 2; ++mh) {
                u32x4 L[2][2], M[2][2];
#pragma unroll
                for (int mm = 0; mm < 2; ++mm) { const size_t o = base + (size_t)(ai * 128 + (2 * mh + mm) * 16) * 1024;
                    L[mm][0] = *(const u32x4*)(gr + o); L[mm][1] = *(const u32x4*)(gr + o + 8 * 1024); M[mm][0] = *(const u32x4*)(m1 + o); M[mm][1] = *(const u32x4*)(m1 + o + 8 * 1024); }
#pragma unroll
                for (int mm = 0; mm < 2; ++mm) { const int m = 2 * mh + mm; u32x4 g0, g1, p0, p1, q0, q1; W.lines_to_acc(L[mm][0], L[mm][1], g0, g1); W.lines_to_acc(M[mm][0], M[mm][1], p0, p1);
                    float gv[8], mv[8], o[8];
                    { unpack8(g0, gv); unpack8(p0, mv); const f32x4 a = acc[ai][0][m][0], b = acc[ai][0][m][1]; const float v[8] = {a.x, a.y, a.z, a.w, b.x, b.y, b.z, b.w};
#pragma unroll
                      for (int j = 0; j < 8; ++j) o[j] = mv[j] + gv[j] * v[j];
                      g0 = pack8(o, 1.0f); }
                    { unpack8(g1, gv); unpack8(p1, mv); const f32x4 a = acc[ai][1][m][0], b = acc[ai][1][m][1]; const float v[8] = {a.x, a.y, a.z, a.w, b.x, b.y, b.z, b.w};
#pragma unroll
                      for (int j = 0; j < 8; ++j) o[j] = mv[j] + gv[j] * v[j];
                      g1 = pack8(o, 1.0f); }
                    W.acc_to_lines(g0, g1, q0, q1);
                    const size_t oo = base + (size_t)(ai * 128 + m * 16) * 1024; st16_wt(m1 + oo, q0); st16_wt(m1 + oo + 8 * 1024, q1); }
            }
    }
};
struct EpiResF {
    static constexpr bool REPEATABLE = false;
    bf16_t* xb; float* ssp; LAS unsigned char* scr;
    __device__ __forceinline__ void operator()(const f32x4 (&acc)[2][2][4][2], const pg8::Unit& u, int wr, int wc, int fr, int fq) const {
        WaveTile W; W.init(scr, wr, wc, fr, fq);
        const size_t base = ((size_t)u.pm * 256 + wr * 64 + W.r8) * D + (u.pn * 256 + wc * 64) + 8 * W.c8;
#pragma unroll
        for (int ai = 0; ai < 2; ++ai) {
            float ssm[4];
#pragma unroll
            for (int mh = 0; mh < 2; ++mh) {
                u32x4 L[2][2];
#pragma unroll
                for (int mm = 0; mm < 2; ++mm) { const size_t o = base + (size_t)(ai * 128 + (2 * mh + mm) * 16) * D; L[mm][0] = *(const u32x4*)(xb + o); L[mm][1] = *(const u32x4*)(xb + o + 8 * D); }
#pragma unroll
                for (int mm = 0; mm < 2; ++mm) { const int m = 2 * mh + mm; u32x4 b0, b1, q0, q1; W.lines_to_acc(L[mm][0], L[mm][1], b0, b1); float ss = 0.f;
                    { float x[8]; unpack8(b0, x); const f32x4 a = acc[ai][0][m][0], b = acc[ai][0][m][1];
                      x[0] += a.x; x[1] += a.y; x[2] += a.z; x[3] += a.w; x[4] += b.x; x[5] += b.y; x[6] += b.z; x[7] += b.w; b0 = pack8(x, 1.0f);
                      ss += (x[0] * x[0] + x[1] * x[1]) + (x[2] * x[2] + x[3] * x[3]) + (x[4] * x[4] + x[5] * x[5]) + (x[6] * x[6] + x[7] * x[7]); }
                    { float x[8]; unpack8(b1, x); const f32x4 a = acc[ai][1][m][0], b = acc[ai][1][m][1];
                      x[0] += a.x; x[1] += a.y; x[2] += a.z; x[3] += a.w; x[4] += b.x; x[5] += b.y; x[6] += b.z; x[7] += b.w; b1 = pack8(x, 1.0f);
                      ss += (x[0] * x[0] + x[1] * x[1]) + (x[2] * x[2] + x[3] * x[3]) + (x[4] * x[4] + x[5] * x[5]) + (x[6] * x[6] + x[7] * x[7]); }
                    ss += __shfl_xor(ss, 16); ss += __shfl_xor(ss, 32); ssm[m] = ss;
                    W.acc_to_lines(b0, b1, q0, q1);
                    const size_t oo = base + (size_t)(ai * 128 + m * 16) * D; st16_wt(xb + oo, q0); st16_wt(xb + oo + 8 * D, q1); }
            }
            { const float sel = W.fq == 0 ? ssm[0] : (W.fq == 1 ? ssm[1] : (W.fq == 2 ? ssm[2] : ssm[3]));
              ssp[((size_t)u.pm * 256 + wr * 64 + ai * 128 + W.fq * 16 + W.fr) * 16 + u.pn * 4 + wc] = sel; }
        }
    }
};

constexpr int NWAVES = 8;
constexpr int RING_OFF = 0, RING_BYTES = 131072;
constexpr int RS_OFF = RING_BYTES;
constexpr int EPI_OFF = RS_OFF + 4096;
constexpr int LDSCTL_OFF = 157696;   static_assert(LDSCTL_OFF >= mx::RT_END, "LDS map");
constexpr int LDS_BYTES = 158720;
constexpr size_t CTL_ZERO_BYTES = 131072;
constexpr int CW_BAR = 4096;
#define XB_TMO      128
#define XB_XCNT(j)  (256  + 64 * (j))
#define XB_XSUB(j)  (1280 + 64 * (j))
#define XB_XGEN(j)  (2304 + 64 * (j))
#define XB_TOP      3328
#define XB_TOPGEN   3392
#define XCD_BAR_WORDS 3456
#define XB_SPIN_CAP (1u << 22)
__device__ __forceinline__ unsigned xb_ld(unsigned* p)              { return __hip_atomic_load(p, __ATOMIC_RELAXED, __HIP_MEMORY_SCOPE_AGENT); }
__device__ __forceinline__ unsigned xb_add(unsigned* p, unsigned v) { return __hip_atomic_fetch_add(p, v, __ATOMIC_RELAXED, __HIP_MEMORY_SCOPE_AGENT); }
__device__ __forceinline__ unsigned xb_xcc_id() { return (unsigned)__builtin_amdgcn_s_getreg((3 << 11) | 20) & 0xFu; }
#define XB_SPIN(cond, bar) do { unsigned _sp = 0; while (cond) { __builtin_amdgcn_s_sleep(1); \
    if ((++_sp & 255u) == 0u) { if (xb_ld(&(bar)[XB_TMO])) break; if (_sp > XB_SPIN_CAP) { atomicAdd(&(bar)[XB_TMO], 1u); break; } } } } while (0)
struct XcdBarrier { unsigned* bar; unsigned x; volatile LAS unsigned* st; };
__device__ __forceinline__ XcdBarrier xcd_barrier_post(unsigned* bar, volatile LAS unsigned* st) {
    XcdBarrier b; b.bar = bar; b.x = xb_xcc_id(); b.st = st;
    if (threadIdx.x == 0) st[3] = xb_add(&bar[XB_XCNT(b.x)], 1u);
    return b;
}
__device__ __forceinline__ void xcd_barrier_complete(unsigned* bar, unsigned x, unsigned& nloc, unsigned& nx, unsigned& regular) {
    const unsigned G = gridDim.x * gridDim.y * gridDim.z;
    unsigned sum, cnt, mine, reg, sp = 0u;
    for (;;) {
        sum = 0u; cnt = 0u; mine = 0u; reg = (G % 8u == 0u) ? 1u : 0u;
#pragma unroll
        for (unsigned j = 0; j < 16; ++j) { const unsigned c = xb_ld(&bar[XB_XCNT(j)]); sum += c; cnt += (c > 0u) ? 1u : 0u; mine = (j == x) ? c : mine; reg = (c == (j < 8u ? G / 8u : 0u)) ? reg : 0u; }
        if (sum == G) break;
        __builtin_amdgcn_s_sleep(1);
        if ((++sp & 255u) == 0u) { if (xb_ld(&bar[XB_TMO])) break; if (sp > XB_SPIN_CAP) { atomicAdd(&bar[XB_TMO], 1u); break; } }
    }
    nloc = mine > 0u ? mine : 1u; nx = cnt > 0u ? cnt : 1u; regular = reg;
}
__device__ __forceinline__ void xcd_barrier(const XcdBarrier& b, int wave, bool local = false) {
    asm volatile("s_waitcnt vmcnt(0)" ::: "memory");
    __syncthreads();
    if (tid_from_wave(wave) == 0) {
        unsigned* bar = b.bar;
        __builtin_amdgcn_s_waitcnt(0);
        unsigned nloc = b.st[0], nx = b.st[1];
        if (nloc == 0u) { unsigned reg; xcd_barrier_complete(bar, b.x, nloc, nx, reg); b.st[0] = nloc; b.st[1] = nx; b.st[2] = reg; }
        const unsigned old = xb_add(&bar[XB_XSUB(b.x)], 1u);
        const unsigned gen = old / nloc;
        if (old + 1u == (gen + 1u) * nloc) {
            if (!local) { __builtin_amdgcn_fence(__ATOMIC_RELEASE, "agent"); asm volatile("s_waitcnt vmcnt(0)" ::: "memory"); }
            if (!local) {
                const unsigned og = xb_add(&bar[XB_TOP], 1u);
                const unsigned tg = og / nx;
                __builtin_amdgcn_fence(__ATOMIC_ACQUIRE, "agent");
                if (og + 1u == (tg + 1u) * nx) xb_add(&bar[XB_TOPGEN], 1u);
                else XB_SPIN(xb_ld(&bar[XB_TOPGEN]) == tg, bar);
            } else __builtin_amdgcn_fence(__ATOMIC_ACQUIRE, "agent");
            xb_add(&bar[XB_XGEN(b.x)], 1u);
            asm volatile("s_waitcnt vmcnt(0)" ::: "memory");
        } else {
            __builtin_amdgcn_fence(__ATOMIC_ACQUIRE, "agent");
            XB_SPIN(xb_ld(&bar[XB_XGEN(b.x)]) == gen, bar);
            asm volatile("s_waitcnt vmcnt(0)" ::: "memory");
        }
    }
    __syncthreads();
}

template <class Sched>
__device__ __forceinline__ void build_rstd_table(LAS unsigned char* lds, const Sched& S, const float* ssp, int wave) {
    LAS float* tab = (LAS float*)(lds + RS_OFF); volatile LAS int* pml = (volatile LAS int*)(lds + LDSCTL_OFF);
    int p0 = -1, p1 = -1, p2 = -1, p3 = -1; pg8::Unit u;
    for (int i = 0; S.next(i, u); ++i) { const int pm = u.pm; if (pm == p0 || pm == p1 || pm == p2 || pm == p3) continue;
        if (p0 < 0) p0 = pm; else if (p1 < 0) p1 = pm; else if (p2 < 0) p2 = pm; else if (p3 < 0) p3 = pm; }
    int t0_ = tid_from_wave(wave); asm volatile("" : "+v"(t0_));
    if (t0_ == 0) { pml[0] = p0; pml[1] = p1; pml[2] = p2; pml[3] = p3; }
    for (int idx = t0_; idx < 1024; idx += NWAVES * 64) { const int slot = idx >> 8; const int pm = slot == 0 ? p0 : (slot == 1 ? p1 : (slot == 2 ? p2 : p3));
        if (pm >= 0) { const f32x4* q = (const f32x4*)(ssp + (size_t)(pm * 256 + (idx & 255)) * 16); const f32x4 a = q[0], b = q[1], c = q[2], d = q[3];
            const float s = ((a.x + a.y) + (a.z + a.w)) + ((b.x + b.y) + (b.z + b.w)) + ((c.x + c.y) + (c.z + c.w)) + ((d.x + d.y) + (d.z + d.w));
            tab[idx] = rsqrtf(s * (1.0f / D) + EPS); } }
    __syncthreads();
}

__device__ __forceinline__ void st4_wt(void* p, float v) { asm volatile("global_store_dword %0, %1, off sc0 sc1\n\ts_nop 1" :: "v"(p), "v"(v) : "memory"); }
__device__ __forceinline__ void ld16x8_sys(f32x4 (&v)[8], const float* const (&p)[8]) {
    asm volatile("global_load_dwordx4 %0, %8, off sc0 sc1\n\tglobal_load_dwordx4 %1, %9, off sc0 sc1\n\tglobal_load_dwordx4 %2, %10, off sc0 sc1\n\tglobal_load_dwordx4 %3, %11, off sc0 sc1\n\t"
                 "global_load_dwordx4 %4, %12, off sc0 sc1\n\tglobal_load_dwordx4 %5, %13, off sc0 sc1\n\tglobal_load_dwordx4 %6, %14, off sc0 sc1\n\tglobal_load_dwordx4 %7, %15, off sc0 sc1\n\t"
                 "s_waitcnt vmcnt(0)"
                 : "=&v"(v[0]), "=&v"(v[1]), "=&v"(v[2]), "=&v"(v[3]), "=&v"(v[4]), "=&v"(v[5]), "=&v"(v[6]), "=&v"(v[7])
                 : "v"(p[0]), "v"(p[1]), "v"(p[2]), "v"(p[3]), "v"(p[4]), "v"(p[5]), "v"(p[6]), "v"(p[7]) : "memory"); }
constexpr int CW_FIN = 16384;
struct EpiFinal {
    static constexpr bool REPEATABLE = false;
    const bf16_t* xb; float* ssp; const float* gfin; float* out; unsigned* cnt; LAS unsigned char* scr;
    __device__ __forceinline__ void operator()(f32x4 (&acc)[2][2][4][2], const pg8::Unit& u, int wr, int wc, int fr_, int fq_) const {
        WaveTile W; W.init(scr, wr, wc, fr_, fq_);
        const int fr = W.fr, fq = W.fq;
        const size_t rowb = (size_t)u.pm * 256 + wr * 64; const int colb = u.pn * 256 + wc * 64;
        const size_t base = (rowb + W.r8) * D + colb + 8 * W.c8;
#pragma unroll
        for (int ai = 0; ai < 2; ++ai) {
            float ssm[4];
#pragma unroll
            for (int mh = 0; mh < 2; ++mh) {
                u32x4 L[2][2];
#pragma unroll
                for (int mm = 0; mm < 2; ++mm) { const size_t o = base + (size_t)(ai * 128 + (2 * mh + mm) * 16) * D; L[mm][0] = *(const u32x4*)(xb + o); L[mm][1] = *(const u32x4*)(xb + o + 8 * D); }
#pragma unroll
                for (int mm = 0; mm < 2; ++mm) { const int m = 2 * mh + mm; u32x4 b0, b1; W.lines_to_acc(L[mm][0], L[mm][1], b0, b1); float ss = 0.f;
#pragma unroll
                    for (int bj = 0; bj < 2; ++bj) { float x[8]; unpack8(bj == 0 ? b0 : b1, x); f32x4& a = acc[ai][bj][m][0]; f32x4& b = acc[ai][bj][m][1];
                        a.x += x[0]; a.y += x[1]; a.z += x[2]; a.w += x[3]; b.x += x[4]; b.y += x[5]; b.z += x[6]; b.w += x[7];
                        ss += (a.x * a.x + a.y * a.y) + (a.z * a.z + a.w * a.w) + (b.x * b.x + b.y * b.y) + (b.z * b.z + b.w * b.w); }
                    ss += __shfl_xor(ss, 16); ss += __shfl_xor(ss, 32); ssm[m] = ss; }
            }
            const float sel = fq == 0 ? ssm[0] : (fq == 1 ? ssm[1] : (fq == 2 ? ssm[2] : ssm[3]));
            st4_wt(ssp + (rowb + ai * 128 + fq * 16 + fr) * 16 + u.pn * 4 + wc, sel);
        }
        asm volatile("s_waitcnt vmcnt(0)" ::: "memory");
        unsigned* c = cnt + u.pm * 16;
        if (fr_ == 0 && fq_ == 0) (void)xb_add(c, 1u);
        { unsigned sp = 0; while (xb_ld(c) < 32u) { __builtin_amdgcn_s_sleep(1); if (++sp > XB_SPIN_CAP) break; } }
        float rs[2][4]; f32x4 pp[8]; const float* pa[8];
#pragma unroll
        for (int i = 0; i < 8; ++i) pa[i] = ssp + (rowb + (i >> 2) * 128 + (i & 3) * 16 + fr) * 16 + 4 * fq;
        ld16x8_sys(pp, pa);
#pragma unroll
        for (int i = 0; i < 8; ++i) { const f32x4 p = pp[i]; float t = (p.x + p.y) + (p.z + p.w); t += __shfl_xor(t, 16); t += __shfl_xor(t, 32); rs[i >> 2][i & 3] = rsqrtf(t * (1.0f / D) + EPS); }
        const unsigned v0 = (unsigned)fr * 128u + ((((unsigned)(2 * fq)) ^ ((unsigned)fr & 7u)) << 4), v1 = (unsigned)fr * 128u + ((((unsigned)(2 * fq + 1)) ^ ((unsigned)fr & 7u)) << 4);
#pragma unroll
        for (int bj = 0; bj < 2; ++bj) {
            const f32x4 g0 = *(const f32x4*)(gfin + colb + 32 * bj + 8 * fq), g1 = *(const f32x4*)(gfin + colb + 32 * bj + 8 * fq + 4);
            float* ob = out + (rowb + W.r8) * D + colb + 32 * bj + 4 * W.c8;
#pragma unroll
            for (int ai = 0; ai < 2; ++ai)
#pragma unroll
                for (int m = 0; m < 4; ++m) { const float r = rs[ai][m]; const f32x4 a = acc[ai][bj][m][0], b = acc[ai][bj][m][1];
                    *(LAS f32x4*)(W.s + v0) = (f32x4){a.x * r * g0.x, a.y * r * g0.y, a.z * r * g0.z, a.w * r * g0.w};
                    *(LAS f32x4*)(W.s + v1) = (f32x4){b.x * r * g1.x, b.y * r * g1.y, b.z * r * g1.z, b.w * r * g1.w};
                    const f32x4 q0 = *(const LAS f32x4*)(W.s + W.rd), q1 = *(const LAS f32x4*)(W.s + 1024 + W.rd);
                    float* o = ob + (size_t)(ai * 128 + m * 16) * D; *(f32x4*)o = q0; *(f32x4*)(o + (size_t)8 * D) = q1; }
        }
    }
};

struct RstdPre { LAS unsigned char* lds; const pg8::StaticOrder* S; const float* ssp; int wave;
    __device__ __forceinline__ void operator()() const { build_rstd_table(lds, *S, ssp, wave); } };
constexpr int PH_PRO = 0, PH_FIN = 1 + 6 * DEPTH, NPH = PH_FIN + 1;
struct Args { const float* in[13]; float* out; unsigned char* ws; int ph_lo, ph_hi, li, pad; };
__global__ void __launch_bounds__(NWAVES * 64, 2) mega(Args args) {
    extern __shared__ __attribute__((aligned(16))) unsigned char lds_raw[];
    LAS unsigned char* lds = (LAS unsigned char*)lds_raw;
    const int tid = threadIdx.x, wave = __builtin_amdgcn_readfirstlane(tid >> 6);
    const int G = gridDim.x, bx = blockIdx.x, vcu = (G % 8 == 0) ? (bx % 8) * (G / 8) + bx / 8 : bx;
    unsigned char* ws = args.ws;
    for (int u = tid; u < 512 / 4; u += NWAVES * 64) ((LAS unsigned*)(lds + LDSCTL_OFF))[u] = 0u;
    __syncthreads();
    XcdBarrier bar = xcd_barrier_post((unsigned*)(ws + WS_CTL) + CW_BAR + args.li * XCD_BAR_WORDS, (volatile LAS unsigned*)(lds + LDSCTL_OFF) + 8);
    float* xf = args.out; bf16_t* xb = (bf16_t*)(ws + WS_XB); float* ssp = (float*)(ws + WS_SSP);
    bf16_t* patt = (bf16_t*)(ws + WS_PATT); bf16_t* pret = (bf16_t*)(ws + WS_PRET); bf16_t* prg = (bf16_t*)(ws + WS_PRG);
    bf16_t* pga = (bf16_t*)(ws + WS_PGA); bf16_t* pgr = (bf16_t*)(ws + WS_PGR); bf16_t* m1 = pga  ; bf16_t* act = (bf16_t*)(ws + WS_ACT);
    const int gw = vcu * NWAVES + wave, ngw = G * NWAVES;
    const RsLds rs{(const LAS float*)(lds + RS_OFF), (const LAS int*)(lds + LDSCTL_OFF)};

    const int lo = args.ph_lo, hi = args.ph_hi;
    const bool fuse_fin = (G % 128 == 0) && lo == 0 && hi == NPH;
#define IN(k) (lo <= (k) && (k) < hi)
#define SEAM(k) do { if (IN(k) && IN((k) + 1)) xcd_barrier(bar, wave); } while (0)
#define SEAM_L(k) do { if (IN(k) && IN((k) + 1)) xcd_barrier(bar, wave, xl); } while (0)
    if (IN(PH_PRO)) {
        int tl_ = tid_from_wave(wave); asm volatile("" : "+v"(tl_)); const int lane = tl_ & 63;
        WPtrs P{args.in[1], args.in[2], args.in[5], args.in[6], args.in[7], args.in[8], args.in[9], args.in[10], args.in[11], args.in[4]};
        prologue_weights(P, ws, (float*)(lds_raw + wave * 16384), gw, ngw, lane, 0, PRO_I_IN0);
        const float* x = args.in[0];
        for (int t0 = gw * 4; t0 < T; t0 += ngw * 4) {
            f32x4 v[4][4];
#pragma unroll
            for (int rr = 0; rr < 4; ++rr) { const f32x4* xr = (const f32x4*)(x + (size_t)(t0 + rr) * D) + lane;
#pragma unroll
                for (int j = 0; j < 4; ++j) v[rr][j] = xr[64 * j]; }
#pragma unroll
            for (int rr = 0; rr < 4; ++rr) { const int t = t0 + rr; float s = 0.f;
#pragma unroll
                for (int j = 0; j < 4; ++j) s += (v[rr][j].x * v[rr][j].x + v[rr][j].y * v[rr][j].y) + (v[rr][j].z * v[rr][j].z + v[rr][j].w * v[rr][j].w);
                s = wave_sum(s);
                unsigned long long* o8 = (unsigned long long*)(xb + (size_t)t * D) + lane;
#pragma unroll
                for (int j = 0; j < 4; ++j) o8[64 * j] = (unsigned long long)pk2(v[rr][j].x, v[rr][j].y) | ((unsigned long long)pk2(v[rr][j].z, v[rr][j].w) << 32);
                if (lane < 16) ssp[(size_t)t * 16 + lane] = lane == 0 ? s : 0.f; }
        }
    }
    SEAM(PH_PRO);
    const bool xl = (G == 256) && (((volatile LAS unsigned*)(lds + LDSCTL_OFF))[10] != 0u);
    const int vb = xl ? (int)(((volatile LAS unsigned*)(lds + LDSCTL_OFF))[11] * 8u + bar.x) : bx;
    for (int l = 0; l < DEPTH; ++l) {
        const int pb = 1 + 6 * l;
        const unsigned char* wl = ws + WS_W + (size_t)l * W_LAYER;
        if (IN(pb + 0)) {
            pg8::StaticOrder S; S.init(T, DIN, G, vb);
            const pg8::Gemm g{xb, (const bf16_t*)(wl + W_IN), D, D, T, DIN, D};
            const EpiProjT E{rs, patt, pret, prg, pga, pgr, lds + EPI_OFF};
            pg8::gemm_phase<EpiProjT, pg8::StaticOrder, true>(lds + RING_OFF, g, S, E, wave, RstdPre{lds, &S, ssp, wave});
            if (2 * vb >= G) {
                int tl_ = tid_from_wave(wave); asm volatile("" : "+v"(tl_));
                WPtrs P{args.in[1], args.in[2], args.in[5], args.in[6], args.in[7], args.in[8], args.in[9], args.in[10], args.in[11], args.in[4]};
                prologue_weights(P, ws, (float*)(lds_raw + wave * 16384), (vb - G / 2) * NWAVES + wave, (G - G / 2) * NWAVES, tl_ & 63,
                                 l == 0 ? PRO_I_IN0 : PRO_PER_LAYER + PRO_I_IN0, l == 0 ? PRO_PER_LAYER + PRO_I_IN0 : 2 * PRO_PER_LAYER);
            }
        }
        SEAM(pb + 0);
        if (IN(pb + 1)) mixer_phase_impl<3>(lds, ws, args.in[3] + l * AH, args.in[4] + l * RH * RDV, vb, G, patt, prg, wave, xl);
        SEAM_L(pb + 1);
        if (IN(pb + 2)) {
            pg8::StaticOrder S; S.init(T, D, G, vb);
            { const pg8::Gemm g{patt, (const bf16_t*)(wl + W_AO), 768, 512, T, D, 512}; const EpiM1F E{pga, m1, lds + EPI_OFF};
              pg8::gemm_phase<EpiM1F, pg8::StaticOrder, true>(lds + RING_OFF, g, S, E, wave); }
            { const pg8::Gemm g{prg, (const bf16_t*)(wl + W_RO), D, D, T, D, D}; const EpiMrgF E{pgr, m1, lds + EPI_OFF};
              pg8::gemm_phase<EpiMrgF, pg8::StaticOrder, true>(lds + RING_OFF, g, S, E, wave); }
        }
        SEAM_L(pb + 2);
        if (IN(pb + 3)) {
            pg8::StaticOrder S; S.init(T, D, G, vb);
            const pg8::Gemm g{m1, (const bf16_t*)(wl + W_OUT), D, D, T, D, D}; const EpiResF E{xb, ssp, lds + EPI_OFF};
            pg8::gemm_phase<EpiResF, pg8::StaticOrder, true>(lds + RING_OFF, g, S, E, wave);
        }
        SEAM_L(pb + 3);
        if (IN(pb + 4)) {
            pg8::StaticOrder S; S.init(T, 2 * DFF, G, vb);
            const pg8::Gemm g{xb, (const bf16_t*)(wl + W_GU), D, D, T, 2 * DFF, D}; const Epi8Dual<EpiAct<RsLds>> E{{rs, act}};
            pg8::gemm_phase<Epi8Dual<EpiAct<RsLds>>, pg8::StaticOrder, true>(lds + RING_OFF, g, S, E, wave, RstdPre{lds, &S, ssp, wave});
        }
        SEAM_L(pb + 4);
        if (IN(pb + 5)) {
            pg8::StaticOrder S; S.init(T, D, G, vb);
            const pg8::Gemm g{act, (const bf16_t*)(wl + W_DN), DFF, DFF, T, D, DFF, true};
            if (l == DEPTH - 1 && fuse_fin) { const EpiFinal E{xb, (float*)(ws + WS_SSP2), args.in[12], xf, (unsigned*)(ws + WS_CTL) + CW_FIN, lds + EPI_OFF};
                pg8::gemm_phase<EpiFinal, pg8::StaticOrder, true>(lds + RING_OFF, g, S, E, wave); }
            else { const EpiResF E{xb, ssp, lds + EPI_OFF};
                pg8::gemm_phase<EpiResF, pg8::StaticOrder, true>(lds + RING_OFF, g, S, E, wave); }
        }
        if (l < DEPTH - 1) SEAM_L(pb + 5); else if (!fuse_fin) SEAM(pb + 5);
    }
    if (IN(PH_FIN) && !fuse_fin) {
        int tl_ = tid_from_wave(wave); asm volatile("" : "+v"(tl_)); const int lane = tl_ & 63;
        const float* g = args.in[12];
        for (int t = gw; t < T; t += ngw) {
            const u32x4* xr = (const u32x4*)(xb + (size_t)t * D) + lane; u32x4 w[2]; float v[2][8]; float s = 0.f;
#pragma unroll
            for (int j = 0; j < 2; ++j) { w[j] = xr[64 * j]; unpack8(w[j], v[j]);
#pragma unroll
                for (int e = 0; e < 8; ++e) s += v[j][e] * v[j][e]; }
            s = wave_sum(s); const float r = rsqrtf(s * (1.0f / D) + EPS);
#pragma unroll
            for (int j = 0; j < 2; ++j) { const f32x4* gr = (const f32x4*)(g + 512 * j + 8 * lane); f32x4* o = (f32x4*)(xf + (size_t)t * D + 512 * j + 8 * lane); const f32x4 g0 = gr[0], g1 = gr[1];
                o[0] = (f32x4){v[j][0] * r * g0.x, v[j][1] * r * g0.y, v[j][2] * r * g0.z, v[j][3] * r * g0.w};
                o[1] = (f32x4){v[j][4] * r * g1.x, v[j][5] * r * g1.y, v[j][6] * r * g1.z, v[j][7] * r * g1.w}; }
        }
    }
#undef IN
#undef SEAM
#undef SEAM_L
}
extern "C" void kernel_launch(void* const* d_in, const int* in_sizes, int n_in, void* d_out, int out_size, void* d_ws, size_t ws_size, hipStream_t stream) {
    static int grid = 0;
    if (grid == 0) {
        if (n_in != 13 || in_sizes[0] != T * D || out_size != T * D || ws_size < WS_END) { fprintf(stderr, "kernel_launch: bad arguments (n_in %d, out %d, ws %zu)\n", n_in, out_size, ws_size); grid = -1; return; }
        int dev = 0, cus = 0, per_cu = 0;
        if (hipGetDevice(&dev) != hipSuccess || hipDeviceGetAttribute(&cus, hipDeviceAttributeMultiprocessorCount, dev) != hipSuccess) { grid = -1; return; }
        if (hipFuncSetAttribute((const void*)mega, hipFuncAttributeMaxDynamicSharedMemorySize, LDS_BYTES) != hipSuccess) { fprintf(stderr, "kernel_launch: hipFuncSetAttribute failed\n"); grid = -1; return; }
        if (hipOccupancyMaxActiveBlocksPerMultiprocessor(&per_cu, (const void*)mega, NWAVES * 64, LDS_BYTES) != hipSuccess || per_cu < 1) { fprintf(stderr, "kernel_launch: occupancy query says %d\n", per_cu); grid = -1; (void)hipGetLastError(); return; }
        grid = cus;
    }
    if (grid < 0) return;
    (void)hipMemsetAsync((char*)d_ws + WS_CTL, 0, CTL_ZERO_BYTES, stream);
    Args a{};
    for (int i = 0; i < 13; ++i) a.in[i] = (const float*)d_in[i];
    a.out = (float*)d_out; a.ws = (unsigned char*)d_ws; a.ph_lo = 0; a.ph_hi = NPH; a.li = 0;
    hipLaunchKernelGGL(mega, dim3(grid), dim3(NWAVES * 64), LDS_BYTES, stream, a);
}
```

```cpp
#include <hip/hip_runtime.h>
#include <cstdio>
#include <cstdint>

constexpr int D = 1024, BATCH = 16, SEQ = 2048, DEPTH = 2, T = BATCH * SEQ;
constexpr int AH = 8, AHD = 64;
constexpr int RH = 4, RDK = 128, RDV = 256;
constexpr int DFF = 2816, DIN = 5888;
constexpr float EPS = 1e-6f;

typedef unsigned short bf16_t;
typedef unsigned u32x4 __attribute__((ext_vector_type(4)));
typedef float f32x4 __attribute__((ext_vector_type(4)));

constexpr size_t MiB = 1u << 20;
constexpr size_t WS_CTL = 0;
constexpr size_t WS_W = 2 * MiB;
constexpr size_t W_IN = 0, W_AO = W_IN + (size_t)DIN * D * 2, W_RO = W_AO + (size_t)D * 512 * 2, W_OUT = W_RO + (size_t)D * D * 2,
                 W_GU = W_OUT + (size_t)D * D * 2, W_DN = W_GU + (size_t)2 * DFF * D * 2, W_LAYER = W_DN + (size_t)D * DFF * 2;
static_assert(W_LAYER == 33 * MiB, "weights per layer");
constexpr size_t WS_XB = 68 * MiB;
constexpr size_t WS_SSP = 132 * MiB;
constexpr size_t WS_PATT = 134 * MiB;
constexpr size_t WS_PRET = 182 * MiB;
constexpr size_t WS_PRG = 310 * MiB;
constexpr size_t WS_PGA = 374 * MiB;
constexpr size_t WS_PGR = 438 * MiB;
constexpr size_t WS_SSP2 = 502 * MiB;
constexpr size_t WS_END = 504 * MiB;
constexpr size_t WS_ACT = WS_PRET;
constexpr size_t ACT_PANEL = (size_t)256 * DFF * 2;
static_assert(11 * ACT_PANEL <= 16 * MiB && 5 * ACT_PANEL <= 8 * MiB && WS_PRG == WS_PRET + 128 * MiB, "act panels");
__host__ __device__ __forceinline__ size_t act_panel_off(int pm) {
    const int x = pm >> 4, j = pm & 15;
    return j < 11 ? (size_t)x * (16 * MiB) + (size_t)j * ACT_PANEL : (WS_PRG - WS_PRET) + (size_t)x * (8 * MiB) + (size_t)(j - 11) * ACT_PANEL; }

__device__ __forceinline__ void st16_wt(void* p, u32x4 v) { asm volatile("global_store_dwordx4 %0, %1, off sc1\n\ts_nop 1" :: "v"(p), "v"(v) : "memory"); }
__device__ __forceinline__ float bf2f(bf16_t b) { return __uint_as_float(((unsigned)b) << 16); }
__device__ __forceinline__ unsigned f2bf(float f) { unsigned u = __float_as_uint(f); return (u + 0x7fffu + ((u >> 16) & 1u)) >> 16; }
typedef float f32x2_hw __attribute__((ext_vector_type(2)));
typedef __bf16 bf16x2_hw __attribute__((ext_vector_type(2)));
__device__ __forceinline__ unsigned pk2(float lo, float hi) { f32x2_hw v = {lo, hi}; bf16x2_hw b = __builtin_convertvector(v, bf16x2_hw); return __builtin_bit_cast(unsigned, b); }
__device__ __forceinline__ float sigmoidf_(float x) { return __builtin_amdgcn_rcpf(1.0f + __builtin_amdgcn_exp2f(x * -1.4426950408889634f)); }
__device__ __forceinline__ float wave_sum(float v) {
#pragma unroll
    for (int o = 1; o < 64; o <<= 1) v += __shfl_xor(v, o);
    return v;
}
__device__ __forceinline__ float wave_max(float v) {
#pragma unroll
    for (int o = 1; o < 64; o <<= 1) v = fmaxf(v, __shfl_xor(v, o));
    return v;
}
__device__ __forceinline__ u32x4 pack8(const float* v, float s) {
    u32x4 w; w.x = pk2(v[0] * s, v[1] * s); w.y = pk2(v[2] * s, v[3] * s); w.z = pk2(v[4] * s, v[5] * s); w.w = pk2(v[6] * s, v[7] * s); return w;
}
__device__ __forceinline__ void unpack8(u32x4 w, float* v) {
    v[0] = __uint_as_float(w.x << 16); v[1] = __uint_as_float(w.x & 0xffff0000u); v[2] = __uint_as_float(w.y << 16); v[3] = __uint_as_float(w.y & 0xffff0000u);
    v[4] = __uint_as_float(w.z << 16); v[5] = __uint_as_float(w.z & 0xffff0000u); v[6] = __uint_as_float(w.w << 16); v[7] = __uint_as_float(w.w & 0xffff0000u);
}

__device__ __forceinline__ void transpose_item(const float* W, int K, int N, const float* g, bf16_t* WT, float* scr, int k0, int n0, int orow0, int lane) {
    float v[32];
    const float* src = W + (size_t)(k0 + (lane >> 5)) * N + n0 + (lane & 31);
#pragma unroll
    for (int i = 0; i < 32; ++i) v[i] = src[(size_t)(2 * i) * N];
    if (g) {
#pragma unroll
        for (int i = 0; i < 32; ++i) v[i] *= g[k0 + 2 * i + (lane >> 5)];
    }
#pragma unroll
    for (int i = 0; i < 32; ++i) scr[(2 * i + (lane >> 5)) * 33 + (lane & 31)] = v[i];
    asm volatile("s_waitcnt lgkmcnt(0)" ::: "memory");
    const int c = lane & 7;
#pragma unroll
    for (int j = 0; j < 4; ++j) { const int n = (lane >> 3) + 8 * j; const float* s = scr + (8 * c) * 33 + n;
        u32x4 o; o.x = pk2(s[0 * 33], s[1 * 33]); o.y = pk2(s[2 * 33], s[3 * 33]); o.z = pk2(s[4 * 33], s[5 * 33]); o.w = pk2(s[6 * 33], s[7 * 33]);
        st16_wt(WT + (size_t)(orow0 + n) * K + k0 + 8 * c, o); }
    asm volatile("s_waitcnt lgkmcnt(0)" ::: "memory");
}
struct WPtrs { const float *norm_mix, *w_in, *w_ao, *w_ro, *w_out, *norm_ffn, *w_gate, *w_up, *w_dn, *gn_gain; };
constexpr int PRO_I_IN0 = (D / 64) * (DIN / 32);
constexpr int PRO_PER_LAYER = (D / 64) * (DIN / 32) + (512 / 64) * (D / 32) + 2 * (D / 64) * (D / 32) + 2 * (D / 64) * (DFF / 32) + (DFF / 64) * (D / 32);
__device__ __forceinline__ void prologue_weights(const WPtrs& P, unsigned char* ws, float* scr, int gw, int ngw, int lane, int it_lo = 0, int it_hi = 1 << 30) {
    constexpr int I_IN = (D / 64) * (DIN / 32), I_AO = (512 / 64) * (D / 32), I_SQ = (D / 64) * (D / 32), I_GU = (D / 64) * (DFF / 32), I_DN = (DFF / 64) * (D / 32);
    constexpr int PER_LAYER = I_IN + I_AO + 2 * I_SQ + 2 * I_GU + I_DN; static_assert(PER_LAYER == PRO_PER_LAYER, "item list");
    const int it_end = it_hi < DEPTH * PER_LAYER ? it_hi : DEPTH * PER_LAYER;
    for (int it = it_lo + gw; it < it_end; it += ngw) {
        const int l = it / PER_LAYER; int r = it % PER_LAYER;
        unsigned char* wl = ws + WS_W + (size_t)l * W_LAYER;
        if (r < I_IN) { const int nb = DIN / 32, kb = r / nb, n0 = 32 * (r % nb); transpose_item(P.w_in + (size_t)l * D * DIN, D, DIN, P.norm_mix + l * D, (bf16_t*)(wl + W_IN), scr, 64 * kb, n0, n0, lane); continue; } r -= I_IN;
        if (r < I_AO) { const int nb = D / 32, kb = r / nb, n0 = 32 * (r % nb); transpose_item(P.w_ao + (size_t)l * 512 * D, 512, D, nullptr, (bf16_t*)(wl + W_AO), scr, 64 * kb, n0, n0, lane); continue; } r -= I_AO;
        if (r < I_SQ) { const int nb = D / 32, kb = r / nb, n0 = 32 * (r % nb); transpose_item(P.w_ro + (size_t)l * D * D, D, D, P.gn_gain + l * D, (bf16_t*)(wl + W_RO), scr, 64 * kb, n0, n0, lane); continue; } r -= I_SQ;
        if (r < I_SQ) { const int nb = D / 32, kb = r / nb, n0 = 32 * (r % nb); transpose_item(P.w_out + (size_t)l * D * D, D, D, nullptr, (bf16_t*)(wl + W_OUT), scr, 64 * kb, n0, n0, lane); continue; } r -= I_SQ;
        if (r < I_GU) { const int nb = DFF / 32, kb = r / nb, n0 = 32 * (r % nb); transpose_item(P.w_gate + (size_t)l * D * DFF, D, DFF, P.norm_ffn + l * D, (bf16_t*)(wl + W_GU), scr, 64 * kb, n0, 256 * (n0 / 128) + 64 * ((n0 % 128) / 32), lane); continue; } r -= I_GU;
        if (r < I_GU) { const int nb = DFF / 32, kb = r / nb, n0 = 32 * (r % nb); transpose_item(P.w_up + (size_t)l * D * DFF, D, DFF, P.norm_ffn + l * D, (bf16_t*)(wl + W_GU), scr, 64 * kb, n0, 256 * (n0 / 128) + 64 * ((n0 % 128) / 32) + 32, lane); continue; } r -= I_GU;
        { const int nb = D / 32, kb = r / nb, n0 = 32 * (r % nb); transpose_item(P.w_dn + (size_t)l * DFF * D, DFF, D, nullptr, (bf16_t*)(wl + W_DN), scr, 64 * kb, n0, n0, lane); }
    }
}
typedef float f32x2p __attribute__((ext_vector_type(2)));
template <class RS> struct EpiAct {
    RS rs; bf16_t* act;
    __device__ __forceinline__ void apply8(int row, int col0, float s, const float* g, const float* u) const {
        const float s2 = s * -1.4426950408889634f, ss = s * s; u32x4 w; float e[8], o[8];
#pragma unroll
        for (int j = 0; j < 8; ++j) e[j] = __builtin_amdgcn_exp2f(g[j] * s2);
#pragma unroll
        for (int j = 0; j < 8; ++j) o[j] = (g[j] * u[j]) * ss;
#pragma unroll
        for (int j = 0; j < 8; ++j) e[j] = __builtin_amdgcn_rcpf(1.0f + e[j]);
#pragma unroll
        for (int j = 0; j < 8; ++j) o[j] *= e[j];
        w.x = pk2(o[0], o[1]); w.y = pk2(o[2], o[3]); w.z = pk2(o[4], o[5]); w.w = pk2(o[6], o[7]);
        st16_wt((bf16_t*)((unsigned char*)act + act_panel_off(row >> 8)) + (size_t)(row & 255) * DFF + col0, w);
    }
};
#define LAS __attribute__((address_space(3)))
#define GAS __attribute__((address_space(1)))
namespace mx {
typedef short bf16x8 __attribute__((ext_vector_type(8)));
typedef short s16x4 __attribute__((ext_vector_type(4)));
typedef float f32x16 __attribute__((ext_vector_type(16)));
typedef unsigned u32x2 __attribute__((ext_vector_type(2)));
typedef float f32x2_t __attribute__((ext_vector_type(2)));
typedef __bf16 bf16x2_t __attribute__((ext_vector_type(2)));
typedef short v4i16_t __attribute__((ext_vector_type(4)));
constexpr float LOG2E = 1.4426950408889634f;
#define MFMA32(a, b, c) __builtin_amdgcn_mfma_f32_32x32x16_bf16((a), (b), (c), 0, 0, 0)
__device__ __forceinline__ unsigned cvtpk(float lo, float hi) { f32x2_t v = {lo, hi}; bf16x2_t b = __builtin_convertvector(v, bf16x2_t); return __builtin_bit_cast(unsigned, b); }
template <int S> __device__ __forceinline__ bf16x8 pack_step(const f32x16& x) {
    u32x4 p; p.x = cvtpk(x[8 * S + 0], x[8 * S + 1]); p.y = cvtpk(x[8 * S + 2], x[8 * S + 3]); p.z = cvtpk(x[8 * S + 4], x[8 * S + 5]); p.w = cvtpk(x[8 * S + 6], x[8 * S + 7]);
    return __builtin_bit_cast(bf16x8, p);
}
__device__ __forceinline__ bf16x8 join4(s16x4 a, s16x4 b) { bf16x8 r; r[0] = a[0]; r[1] = a[1]; r[2] = a[2]; r[3] = a[3]; r[4] = b[0]; r[5] = b[1]; r[6] = b[2]; r[7] = b[3]; return r; }
__device__ __forceinline__ s16x4 tr_read(const LAS unsigned char* p) { return __builtin_bit_cast(s16x4, __builtin_amdgcn_ds_read_tr16_b64_v4i16((LAS v4i16_t*)p)); }
__device__ __forceinline__ f32x16 zero16() { f32x16 z;
#pragma unroll
    for (int i = 0; i < 16; ++i) z[i] = 0.f; return z; }
__device__ __forceinline__ constexpr int cr(int r) { return (r & 3) + 8 * (r >> 2); }

constexpr int AT_KP = 144, AT_VP = 192;
constexpr int AT_VOFF = 256 * AT_KP;
struct AttnStage { u32x4 kv[4], vv[4]; bf16x8 qn[2][4]; };
__device__ __forceinline__ void attn_load(AttnStage& S, const bf16_t* patt, int item, int tid) {
    const int kvh = item & 1, nb = (item >> 1) & 15, b = item >> 5;
    const int lane = tid & 63, w = __builtin_amdgcn_readfirstlane(tid >> 6), q = lane & 31, hh = lane >> 5, g = w & 3, qh = w >> 2;
    const bf16_t* tb = patt + ((size_t)b * SEQ + (size_t)nb * 128) * 768;
    const bf16_t* base = tb + 512 + kvh * 64;
    const int radd = nb == 0 ? 128 : 0;
#pragma unroll
    for (int i = 0; i < 4; ++i) { const int c = tid + 512 * i, row = c >> 3, ch = c & 7, re = row < 128 ? row + radd : row;
        const bf16_t* src = base + (re - 128) * 768 + ch * 8; S.kv[i] = *(const u32x4*)src; S.vv[i] = *(const u32x4*)(src + 128); }
#pragma unroll
    for (int sb = 0; sb < 2; ++sb)
#pragma unroll
        for (int ks = 0; ks < 4; ++ks) S.qn[sb][ks] = *(const bf16x8*)(tb + (unsigned)((64 * qh + 32 * sb + q) * 768 + kvh * 256 + (8 * g + 2 * ks + hh) * 8));
}
constexpr int AT_QOFF = AT_VOFF + 256 * AT_VP;
constexpr int AT_SINK_OFF = AT_QOFF + 65536;
__device__ __forceinline__ void attn_flush(LAS unsigned char* lds, bf16_t* aout, int item, int tid) {
    const int lane = tid & 63, w = __builtin_amdgcn_readfirstlane(tid >> 6), g = w & 3, qh = w >> 2;
    const int kvh = item & 1, nb = (item >> 1) & 15, b = item >> 5;
    const LAS unsigned char* Ob = lds + AT_QOFF + w * 8192;
    bf16_t* ob_ = aout + ((size_t)b * SEQ + (size_t)nb * 128 + 64 * qh) * 768 + kvh * 256 + g * 64;
    u32x4 yv[8]; const int r8 = lane >> 3, c8 = lane & 7;
#pragma unroll
    for (int i = 0; i < 8; ++i) { const int row = 8 * i + r8; yv[i] = *(const LAS u32x4*)(Ob + row * 128 + ((c8 ^ (row & 7)) << 4)); }
#pragma unroll
    for (int i = 0; i < 8; ++i) { const int row = 8 * i + r8; st16_wt(ob_ + (unsigned)(row * 768 + c8 * 8), yv[i]); }
}
__device__ __forceinline__ void attn_item(LAS unsigned char* lds, const bf16_t* patt, bf16_t* aout, int item, int next_item, int prev_item, AttnStage& S, int tid) {
    asm volatile("" : "+v"(tid));
    const int lane = tid & 63, w = __builtin_amdgcn_readfirstlane(tid >> 6), q = lane & 31, hh = lane >> 5;
    const int kvh = item & 1, nb = (item >> 1) & 15, b = item >> 5;
    const int g = w & 3, qh = w >> 2, h = kvh * 4 + g;
    const size_t tok0 = (size_t)b * SEQ + (size_t)nb * 128;
    LAS unsigned char* Kimg = lds; LAS unsigned char* Vimg = lds + AT_VOFF; LAS unsigned char* Ob = lds + AT_QOFF + w * 8192;
    bf16x8 qc[2][4];
#pragma unroll
    for (int sb = 0; sb < 2; ++sb)
#pragma unroll
        for (int ks = 0; ks < 4; ++ks) qc[sb][ks] = S.qn[sb][ks];
#pragma unroll
    for (int i = 0; i < 4; ++i) { const int c = tid + 512 * i, row = c >> 3, ch = c & 7;
        *(LAS u32x4*)(Kimg + row * AT_KP + ch * 16) = S.kv[i]; *(LAS u32x4*)(Vimg + row * AT_VP + ch * 16) = S.vv[i]; }
    asm volatile("s_waitcnt lgkmcnt(0)" ::: "memory"); __builtin_amdgcn_s_barrier(); asm volatile("" ::: "memory");
    attn_load(S, patt, next_item >= 0 ? next_item : item, tid);
    if (prev_item >= 0) attn_flush(lds, aout, prev_item, tid);
    const float c0s = 0.125f * LOG2E, slr = exp2f(-(float)(h + 1)) * 8.0f  , sink2 = ((const LAS float*)(lds + AT_SINK_OFF))[h] * LOG2E;
    const int q4 = (lane & 15) >> 2, p4 = lane & 3, blk = (lane >> 4) & 1;
#pragma unroll
    for (int sb = 0; sb < 2; ++sb) {
        const int jt0 = 2 * qh + sb;
        const unsigned orb = (unsigned)(32 * sb + q) * 128u, orx = (unsigned)(q & 7);
        int qm = q - 4 * hh; asm volatile("" : "+v"(qm));
        f32x16 sa[5];
#pragma unroll
        for (int u = 0; u < 5; ++u) {
            if (nb > 0 || jt0 + u >= 4) {
                const float offu = -slr * (float)(128 - 32 * u + qm);
#pragma unroll
                for (int r = 0; r < 16; ++r) sa[u][r] = offu + slr * (float)cr(r);
#pragma unroll
                for (int ks = 0; ks < 4; ++ks) { const bf16x8 kf = *(const LAS bf16x8*)(Kimg + (32 * (jt0 + u) + q) * AT_KP + (2 * ks + hh) * 16); sa[u] = MFMA32(kf, qc[sb][ks], sa[u]); }
            } else {
#pragma unroll
                for (int r = 0; r < 16; ++r) sa[u][r] = -INFINITY;
            }
        }
#pragma unroll
        for (int r = 0; r < 16; ++r) { sa[0][r] = (cr(r) > qm) ? sa[0][r] : -INFINITY; sa[4][r] = (cr(r) <= qm) ? sa[4][r] : -INFINITY; }
        float m = -INFINITY;
#pragma unroll
        for (int u = 0; u < 5; ++u)
#pragma unroll
            for (int r = 0; r < 16; ++r) m = fmaxf(m, sa[u][r]);
        m = fmaxf(m, __shfl_xor(m, 32)); const float mc = fmaxf(m * c0s, sink2);
        float l = 0.f;
#pragma unroll
        for (int u = 0; u < 5; ++u)
#pragma unroll
            for (int r = 0; r < 16; ++r) { const float p = __builtin_amdgcn_exp2f(__builtin_fmaf(sa[u][r], c0s, -mc)); sa[u][r] = p; l += p; }
        l += __shfl_xor(l, 32); l += __builtin_amdgcn_exp2f(sink2 - mc);
        f32x16 oa[2]; oa[0] = zero16(); oa[1] = zero16();
#pragma unroll
        for (int u = 0; u < 5; ++u) {
            if (nb > 0 || jt0 + u >= 4) {
                const bf16x8 pf0 = pack_step<0>(sa[u]), pf1 = pack_step<1>(sa[u]);
#pragma unroll
                for (int s2 = 0; s2 < 2; ++s2)
#pragma unroll
                    for (int dt = 0; dt < 2; ++dt) {
                        const LAS unsigned char* vp = Vimg + (32 * (jt0 + u) + 16 * s2 + 4 * hh + q4) * AT_VP + (32 * dt + 16 * blk + 4 * p4) * 2;
                        const bf16x8 vf = join4(tr_read(vp), tr_read(vp + 8 * AT_VP));
                        oa[dt] = MFMA32(vf, s2 == 0 ? pf0 : pf1, oa[dt]);
                    }
            }
        }
        const float inv = __builtin_amdgcn_rcpf(l);
#pragma unroll
        for (int dt = 0; dt < 2; ++dt)
#pragma unroll
            for (int g4 = 0; g4 < 4; ++g4) { u32x2 o; o.x = cvtpk(oa[dt][4 * g4] * inv, oa[dt][4 * g4 + 1] * inv); o.y = cvtpk(oa[dt][4 * g4 + 2] * inv, oa[dt][4 * g4 + 3] * inv);
                *(LAS u32x2*)(Ob + orb + ((((unsigned)(4 * dt + g4)) ^ orx) << 4) + 8 * hh) = o; }
    }
    asm volatile("s_waitcnt lgkmcnt(0)" ::: "memory"); __builtin_amdgcn_s_barrier(); asm volatile("" ::: "memory");
}

constexpr int QP = 272, KP = 320, VP = 512;
constexpr int RT_Q = 0, RT_KD = RT_Q + 128 * QP, RT_V = RT_KD + 128 * KP, RT_ST = RT_V + 128 * VP, RT_END = RT_ST + 8192;
__device__ __forceinline__ void ret_item(LAS unsigned char* lds, const bf16_t* pret, const bf16_t* prg, bf16_t* rout, const float* gain, int b, int h, int c0, int c1, int tid) {
    const int w = __builtin_amdgcn_readfirstlane(tid >> 6);
    LAS unsigned char* Qimg = lds + RT_Q; LAS unsigned char* KDimg = lds + RT_KD; LAS unsigned char* Vimg = lds + RT_V; LAS float* st = (LAS float*)(lds + RT_ST);
    const float lg = log2f(1.0f - exp2f(-5.0f - (float)h));
    const float g128 = exp2f(128.0f * lg), kbase = 0.08838834764831845f;
    const bf16_t* pb = pret + (size_t)b * SEQ * 2048 + h * 128;
    f32x16 state[4];
#pragma unroll
    for (int d = 0; d < 4; ++d) state[d] = zero16();
    u32x4 kr[4], qr[4];
#define RT_OFFS() const unsigned kqoff = (unsigned)(tid >> 4) * 2048u + (unsigned)(tid & 15) * 8u, voff = (unsigned)(tid >> 5) * 2048u + (unsigned)(tid & 31) * 8u
#define RT_LOAD_K(c) do { const bf16_t* cb_ = pb + (size_t)(c) * (128 * 2048) + 512; _Pragma("unroll") for (int i = 0; i < 4; ++i) kr[i] = *(const u32x4*)(cb_ + (size_t)i * (32 * 2048) + kqoff); } while (0)
#define RT_LOAD_Q(c) do { const bf16_t* cb_ = pb + (size_t)(c) * (128 * 2048); _Pragma("unroll") for (int i = 0; i < 4; ++i) qr[i] = *(const u32x4*)(cb_ + (size_t)i * (32 * 2048) + kqoff); } while (0)
#define RT_LOAD_V(c) do { const bf16_t* cb_ = pb + (size_t)(c) * (128 * 2048) + 1024 + h * 128; _Pragma("unroll") for (int i = 0; i < 8; ++i) vr[i] = *(const u32x4*)(cb_ + (size_t)i * (16 * 2048) + voff); } while (0)
#define RT_STORE_KD() do { _Pragma("unroll") for (int i = 0; i < 4; ++i) { const int cc = tid + 512 * i, row = cc >> 4, ch = cc & 15; float f[8]; unpack8(kr[i], f); const float sc = kbase * exp2f(lg * (float)(127 - row)); \
        u32x4 o_; o_.x = cvtpk(f[0] * sc, f[1] * sc); o_.y = cvtpk(f[2] * sc, f[3] * sc); o_.z = cvtpk(f[4] * sc, f[5] * sc); o_.w = cvtpk(f[6] * sc, f[7] * sc); *(LAS u32x4*)(KDimg + row * KP + ch * 16) = o_; } } while (0)
#define RT_STORE_Q() do { _Pragma("unroll") for (int i = 0; i < 4; ++i) { const int cc = tid + 512 * i, row = cc >> 4, ch = cc & 15; *(LAS u32x4*)(Qimg + row * QP + ch * 16) = qr[i]; } } while (0)
#define RT_STORE_V() do { _Pragma("unroll") for (int i = 0; i < 8; ++i) { const int cc = tid + 512 * i, row = cc >> 5, ch = cc & 31; *(LAS u32x4*)(Vimg + row * VP + ((ch ^ ((row & 3) << 2)) * 16)) = vr[i]; } } while (0)
    if (c0 > 0) {
    u32x4 vr[8];
    { asm volatile("" : "+v"(tid)); RT_OFFS(); RT_LOAD_K(0); RT_LOAD_V(0); }
    for (int c = 0; c < c0; ++c) {
        asm volatile("" : "+v"(tid));
        const int lane = tid & 63, hh = lane >> 5, q4 = (lane & 15) >> 2, p4 = lane & 3, blk = (lane >> 4) & 1;
        RT_STORE_KD(); RT_STORE_V();
        { const int cn = (c + 1 < c0) ? c + 1 : c; RT_OFFS(); RT_LOAD_K(cn); RT_LOAD_V(cn); }
        __syncthreads();
#pragma unroll
        for (int d = 0; d < 4; ++d)
#pragma unroll
            for (int r = 0; r < 16; ++r) state[d][r] *= g128;
        {
            const LAS unsigned char* vb = Vimg + (8 * hh + q4) * VP + ((4 * (w ^ q4) + 2 * blk) * 16 + 8 * p4);
            const LAS unsigned char* kb = KDimg + (8 * hh + q4) * KP + (16 * blk + 4 * p4) * 2;
            bf16x8 vf[2], kt[2][4];
#define RT_LDW(s_, b_) do { vf[b_] = join4(tr_read(vb + (16 * (s_)) * VP), tr_read(vb + (16 * (s_) + 4) * VP)); \
                _Pragma("unroll") for (int dkt = 0; dkt < 4; ++dkt) kt[b_][dkt] = join4(tr_read(kb + (16 * (s_)) * KP + 64 * dkt), tr_read(kb + (16 * (s_) + 4) * KP + 64 * dkt)); } while (0)
            RT_LDW(0, 0);
#pragma unroll
            for (int s = 0; s < 8; ++s) {
                if (s < 7) RT_LDW(s + 1, (s + 1) & 1);
#pragma unroll
                for (int dkt = 0; dkt < 4; ++dkt) state[dkt] = MFMA32(kt[s & 1][dkt], vf[s & 1], state[dkt]);
            }
#undef RT_LDW
        }
        __syncthreads();
    }
    }
    { asm volatile("" : "+v"(tid)); RT_OFFS(); RT_LOAD_K(c0); RT_LOAD_Q(c0); }
    __builtin_amdgcn_s_waitcnt(0x0070);
    for (int c = c0; c < c1; ++c) {
        const size_t tokc = (size_t)b * SEQ + (size_t)c * 128;
        asm volatile("" : "+v"(tid));
        const int lane = tid & 63, q = lane & 31, hh = lane >> 5, q4 = (lane & 15) >> 2, p4 = lane & 3, blk = (lane >> 4) & 1;
        RT_STORE_KD(); RT_STORE_Q();
        {
            const int vrow = 16 * w + (lane >> 5), vch = (lane & 31); const bf16_t* cb_ = pb + (size_t)c * (128 * 2048) + 1024 + h * 128;
#pragma unroll
            for (int i = 0; i < 8; ++i) { const int row = vrow + 2 * i, ch = vch ^ ((row & 3) << 2);
                __builtin_amdgcn_global_load_lds((const unsigned*)(cb_ + (unsigned)(row * 2048 + ch * 8)), (LAS unsigned*)(Vimg + (8 * w + i) * 1024), 16, 0, 0); }
        }
        asm volatile("s_waitcnt lgkmcnt(0)" ::: "memory"); __builtin_amdgcn_s_barrier(); asm volatile("" ::: "memory");
        f32x16 o[4];
        unsigned sp[2][8];
#pragma unroll
        for (int sl = 0; sl < 2; ++sl) {
            const int n = w + 8 * sl;
            if (n < 10) {
                const int it = n >= 6 ? 3 : (n >= 3 ? 2 : (n >= 1 ? 1 : 0)), jt = n - (it * (it + 1)) / 2;
                f32x16 a = zero16();
                {
                    const LAS unsigned char* kp1 = KDimg + (32 * jt + q) * KP + hh * 16; const LAS unsigned char* qp1 = Qimg + (32 * it + q) * QP + hh * 16;
                    bf16x8 kf[2], qq[2]; kf[0] = *(const LAS bf16x8*)kp1; qq[0] = *(const LAS bf16x8*)qp1;
#pragma unroll
                    for (int ks = 0; ks < 8; ++ks) { if (ks < 7) { kf[(ks + 1) & 1] = *(const LAS bf16x8*)(kp1 + 32 * (ks + 1)); qq[(ks + 1) & 1] = *(const LAS bf16x8*)(qp1 + 32 * (ks + 1)); }
                        a = MFMA32(kf[ks & 1], qq[ks & 1], a); }
                }
                const float fi = exp2f(lg * (float)(32 * it + q - 127));
#pragma unroll
                for (int r = 0; r < 16; ++r) { float v = a[r] * fi; if (it == jt && (cr(r) + 4 * hh > q)) v = 0.f; a[r] = v; }
#pragma unroll
                for (int g4 = 0; g4 < 4; ++g4) { sp[sl][2 * g4] = cvtpk(a[4 * g4], a[4 * g4 + 1]); sp[sl][2 * g4 + 1] = cvtpk(a[4 * g4 + 2], a[4 * g4 + 3]); }
            }
        }
#pragma unroll
        for (int it = 0; it < 4; ++it) o[it] = zero16();
        {
            const LAS unsigned char* qb3 = Qimg + q * QP + 8 * hh;
            bf16x8 bq[2][4];
#define RT_LD3(g_, b_) do { _Pragma("unroll") for (int it = 0; it < 4; ++it) bq[b_][it] = join4(*(const LAS s16x4*)(qb3 + (32 * it) * QP + 32 * (g_)), *(const LAS s16x4*)(qb3 + (32 * it) * QP + 32 * (g_) + 16)); } while (0)
            RT_LD3(0, 0);
#pragma unroll
            for (int g = 0; g < 8; ++g) {
                if (g < 7) RT_LD3(g + 1, (g + 1) & 1);
                const bf16x8 af = (g & 1) ? pack_step<1>(state[g >> 1]) : pack_step<0>(state[g >> 1]);
#pragma unroll
                for (int it = 0; it < 4; ++it) o[it] = MFMA32(af, bq[g & 1][it], o[it]);
            }
#undef RT_LD3
        }
        asm volatile("" ::: "memory"); __builtin_amdgcn_s_waitcnt(0x0070); __builtin_amdgcn_s_barrier(); asm volatile("" ::: "memory");
#pragma unroll
        for (int sl = 0; sl < 2; ++sl) {
            const int n = w + 8 * sl;
            if (n < 10) {
                const int it = n >= 6 ? 3 : (n >= 3 ? 2 : (n >= 1 ? 1 : 0)), jt = n - (it * (it + 1)) / 2;
#pragma unroll
                for (int g4 = 0; g4 < 4; ++g4) { u32x2 v; v.x = sp[sl][2 * g4]; v.y = sp[sl][2 * g4 + 1]; *(LAS u32x2*)(Qimg + (32 * it + q) * QP + (4 * jt + g4) * 16 + 8 * hh) = v; }
            }
        }
        __syncthreads();
        { const int cn = (c + 1 < c1) ? c + 1 : c; RT_OFFS(); RT_LOAD_K(cn); RT_LOAD_Q(cn); }
#pragma unroll
        for (int it = 0; it < 4; ++it) { const float gi = exp2f(lg * (float)(32 * it + q + 1));
#pragma unroll
            for (int r = 0; r < 16; ++r) o[it][r] *= gi; }
#pragma unroll
        for (int d = 0; d < 4; ++d)
#pragma unroll
            for (int r = 0; r < 16; ++r) state[d][r] *= g128;
        {
            const LAS unsigned char* vb = Vimg + (8 * hh + q4) * VP + ((4 * (w ^ q4) + 2 * blk) * 16 + 8 * p4);
            const LAS unsigned char* sb2 = Qimg + q * QP + hh * 16;
            bf16x8 vf[2], sf[2][4];
#define RT_LD2(s_, b_) do { vf[b_] = join4(tr_read(vb + (16 * (s_)) * VP), tr_read(vb + (16 * (s_) + 4) * VP)); \
                _Pragma("unroll") for (int it = 0; it < 4; ++it) if (2 * it + 1 >= (s_)) sf[b_][it] = *(const LAS bf16x8*)(sb2 + (32 * it) * QP + 32 * (s_)); } while (0)
            RT_LD2(0, 0);
#pragma unroll
            for (int s = 0; s < 8; ++s) {
                if (s < 7) RT_LD2(s + 1, (s + 1) & 1);
#pragma unroll
                for (int it = 0; it < 4; ++it) if (2 * it + 1 >= s) o[it] = MFMA32(vf[s & 1], sf[s & 1][it], o[it]);
            }
#undef RT_LD2
        }
        if (c < 15) {
            const LAS unsigned char* vb = Vimg + (8 * hh + q4) * VP + ((4 * (w ^ q4) + 2 * blk) * 16 + 8 * p4);
            const LAS unsigned char* kb = KDimg + (8 * hh + q4) * KP + (16 * blk + 4 * p4) * 2;
            bf16x8 vf[2], kt[2][4];
#define RT_LD4(s_, b_) do { vf[b_] = join4(tr_read(vb + (16 * (s_)) * VP), tr_read(vb + (16 * (s_) + 4) * VP)); \
                _Pragma("unroll") for (int dkt = 0; dkt < 4; ++dkt) kt[b_][dkt] = join4(tr_read(kb + (16 * (s_)) * KP + 64 * dkt), tr_read(kb + (16 * (s_) + 4) * KP + 64 * dkt)); } while (0)
            RT_LD4(0, 0);
#pragma unroll
            for (int s = 0; s < 8; ++s) {
                if (s < 7) RT_LD4(s + 1, (s + 1) & 1);
#pragma unroll
                for (int dkt = 0; dkt < 4; ++dkt) state[dkt] = MFMA32(kt[s & 1][dkt], vf[s & 1], state[dkt]);
            }
#undef RT_LD4
        }
        __syncthreads();
        {
            const int grow0 = 16 * w + (lane >> 5), gch = lane & 31; const bf16_t* gb_ = prg + tokc * 1024 + h * 256;
#pragma unroll
            for (int i = 0; i < 8; ++i) { const int row = grow0 + 2 * i, ch = gch ^ (row & 31);
                __builtin_amdgcn_global_load_lds((const unsigned*)(gb_ + (unsigned)(row * 1024 + ch * 8)), (LAS unsigned*)(Qimg + (8 * w + i) * 1024), 16, 0, 0); }
        }
        float mean[4], rstd[4];
#pragma unroll
        for (int it = 0; it < 4; ++it) { float ps = 0.f, pq = 0.f;
#pragma unroll
            for (int r = 0; r < 16; ++r) { ps += o[it][r]; pq += o[it][r] * o[it][r]; }
            ps += __shfl_xor(ps, 32); pq += __shfl_xor(pq, 32); if (hh == 0) { st[w * 128 + 32 * it + q] = ps; st[1024 + w * 128 + 32 * it + q] = pq; } }
        asm volatile("s_waitcnt lgkmcnt(0)" ::: "memory"); __builtin_amdgcn_s_barrier(); asm volatile("" ::: "memory");
#pragma unroll
        for (int it = 0; it < 4; ++it) { float s8 = 0.f, q8 = 0.f;
#pragma unroll
            for (int ww = 0; ww < 8; ++ww) { s8 += st[ww * 128 + 32 * it + q]; q8 += st[1024 + ww * 128 + 32 * it + q]; }
            mean[it] = s8 * (1.0f / 256.0f); rstd[it] = rsqrtf(fmaxf(q8 * (1.0f / 256.0f) - mean[it] * mean[it], 0.f) + EPS); }
        asm volatile("" ::: "memory"); __builtin_amdgcn_s_waitcnt(0x0070); __builtin_amdgcn_s_barrier(); asm volatile("" ::: "memory");
#pragma unroll
        for (int it = 0; it < 4; ++it) {
            const int row = 32 * it + q; const unsigned rbase = (unsigned)row * 512u, rx = (unsigned)(row & 31);
#pragma unroll
            for (int g4 = 0; g4 < 4; ++g4) {
                const unsigned c8 = (unsigned)(8 * w + 2 * g4 + hh);
                const unsigned off = rbase + (((c8 >> 1) ^ rx) << 4) + ((c8 & 1u) << 3);
                const u32x2 rw = *(const LAS u32x2*)(Qimg + off); const float ms = rstd[it];
                const float rg0 = __uint_as_float(rw.x << 16), rg1 = __uint_as_float(rw.x & 0xffff0000u), rg2 = __uint_as_float(rw.y << 16), rg3 = __uint_as_float(rw.y & 0xffff0000u);
                const float y0 = (o[it][4 * g4 + 0] - mean[it]) * ms * rg0, y1 = (o[it][4 * g4 + 1] - mean[it]) * ms * rg1;
                const float y2 = (o[it][4 * g4 + 2] - mean[it]) * ms * rg2, y3 = (o[it][4 * g4 + 3] - mean[it]) * ms * rg3;
                u32x2 ov; ov.x = cvtpk(y0, y1); ov.y = cvtpk(y2, y3); *(LAS u32x2*)(Vimg + off) = ov;
            }
        }
        asm volatile("s_waitcnt lgkmcnt(0)" ::: "memory"); __builtin_amdgcn_s_barrier(); asm volatile("" ::: "memory");
        {
            u32x4 yv[8]; bf16_t* ob_ = rout + tokc * 1024 + h * 256;
#pragma unroll
            for (int i = 0; i < 8; ++i) { const int cc = tid + 512 * i, row = cc >> 5, ch = cc & 31; yv[i] = *(const LAS u32x4*)(Vimg + row * 512 + ((ch ^ (row & 31)) << 4)); }
#pragma unroll
            for (int i = 0; i < 8; ++i) { const int cc = tid + 512 * i, row = cc >> 5, ch = cc & 31; st16_wt(ob_ + (unsigned)(row * 1024 + ch * 8), yv[i]); }
        }
        __syncthreads();
    }
#undef RT_OFFS
#undef RT_LOAD_K
#undef RT_LOAD_Q
#undef RT_LOAD_V
#undef RT_STORE_KD
#undef RT_STORE_Q
#undef RT_STORE_V
}
}

__device__ __forceinline__ int tid_from_wave(int wave) { unsigned z = 0u; asm volatile("" : "+v"(z));
    return wave * 64 + (int)__builtin_amdgcn_mbcnt_hi(~0u, __builtin_amdgcn_mbcnt_lo(~0u, z)); }
struct Args;
template <int WHAT  >
__device__ __forceinline__ void mixer_phase_impl(LAS unsigned char* lds, unsigned char* ws, const float* sinks, const float* gain, int bx, int G, bf16_t* aout, bf16_t* rout, int wave, bool consec) {
    const bf16_t* patt = (const bf16_t*)(ws + WS_PATT); const bf16_t* pret = (const bf16_t*)(ws + WS_PRET); const bf16_t* prg = (const bf16_t*)(ws + WS_PRG);
    int tid_ = tid_from_wave(wave); asm volatile("" : "+v"(tid_));
    const int tid = tid_;
    const int vcu = (G % 8 == 0) ? (bx % 8) * (G / 8) + bx / 8 : bx;
    if constexpr ((WHAT & 2) != 0)
    for (int it = vcu; it < BATCH * RH * 4; it += G) {
        const int bh = it >> 2, seg = it & 3, c0 = seg == 0 ? 0 : (seg == 1 ? 5 : (seg == 2 ? 9 : 13)), c1 = seg == 0 ? 5 : (seg == 1 ? 9 : (seg == 2 ? 13 : 16));
        mx::ret_item(lds, pret, prg, rout, gain, bh >> 2, bh & 3, c0, c1, tid);
    }
    if constexpr ((WHAT & 1) != 0)
    {
        if (tid < AH) ((LAS float*)(lds + mx::AT_SINK_OFF))[tid] = sinks[tid];
        const int NIT = BATCH * 16 * 2, npc = NIT / G, first = consec ? vcu * npc : vcu, step = consec ? 1 : G, last = consec ? first + npc : NIT;
        mx::AttnStage S; if (first < last) mx::attn_load(S, patt, first, tid);
        int prev = -1;
        for (int it = first; it < last; it += step) { mx::attn_item(lds, patt, aout, it, (it + step < last) ? it + step : -1, prev, S, tid); prev = it; }
        if (prev >= 0) mx::attn_flush(lds, aout, prev, tid);
    }
}


namespace pg8 {
typedef short bf16x8 __attribute__((ext_vector_type(8)));
constexpr int BM = 256, BK = 64, HALF = 128, HTB = HALF * BK * 2  , STAGE_BYTES = 8 * HTB, NXCD = 8;
#ifndef PG8_WGM
#define PG8_WGM 4
#endif
constexpr int WGM = PG8_WGM;
__host__ __device__ __forceinline__ int lds_byte(int r, int c) { const int st = (r >> 4) * 2 + (c >> 5), rr = r & 15, cc = c & 31, ob = rr * 64 + cc * 2; return st * 1024 + (ob ^ (((ob >> 9) & 1) << 5)); }
__host__ __device__ __forceinline__ void stage_rc(int b, int& R, int& C) { const int st = b / 1024, sb = b % 1024, swz = sb ^ (((sb >> 9) & 1) << 5); R = (st >> 1) * 16 + swz / 64; C = (st & 1) * 32 + (swz % 64) / 2; }
__host__ __device__ __forceinline__ int perm32(int rho) { const int n = rho >> 4, i = rho & 15; return 8 * (i >> 2) + 4 * n + (i & 3); }
struct Unit { int pm, pn; };
struct Gemm { const bf16_t* A; const bf16_t* Bt; int lda, ldb, M, N, K; bool apan = false; };
__device__ __forceinline__ const char* panelA(const Gemm& g, int pm, size_t tstepA) { return (const char*)g.A + (g.apan ? act_panel_off(pm) : (size_t)pm * tstepA); }
struct StaticOrder {
    int nM, nN, nwg, G, c;
    __host__ __device__ void init(int M, int N, int G_, int c_) { nM = M / BM; nN = N / BM; nwg = nM * nN; G = G_; c = c_; }
    __host__ __device__ bool next(int i, Unit& u) const {
        const long L = (long)i * G + c; if (L >= nwg) return false;
        int wgid = (int)L; { const int q = nwg / NXCD, r = nwg % NXCD, xcd = wgid % NXCD, off = wgid / NXCD; wgid = (xcd < r ? xcd * (q + 1) : r * (q + 1) + (xcd - r) * q) + off; }
        const int nig = WGM * nN, gid = wgid / nig, fm = gid * WGM, gsz = (nM - fm) < WGM ? (nM - fm) : WGM;
        u.pm = fm + ((wgid % nig) % gsz); u.pn = (wgid % nig) / gsz; return true;
    }
};
struct NoPre { __device__ __forceinline__ void operator()() const {} };
template <class Epi, class Sched, bool ALIGN_EPI, class Pre = NoPre>
__device__ __forceinline__ void gemm_phase(LAS unsigned char* lds, const Gemm g, const Sched& S, const Epi& E, int wave, const Pre& pre = Pre()) {
    int tid_ = tid_from_wave(wave); asm volatile("" : "+v"(tid_));
    int wid_ = wave; asm volatile("" : "+s"(wid_));
    const int tid = tid_, wid = wid_, lane = tid & 63, wr = wid >> 2, wc = wid & 3, fr = lane & 15, fq = lane >> 4;
    const int nt = g.K / BK;
#define KT(t) ((size_t)(t))
    unsigned voffA[2], voffB[2];
#pragma unroll
    for (int i = 0; i < 2; ++i) { int R, C; stage_rc(tid * 16 + i * 8192, R, C); const int Rb = 64 * (R >> 5) + perm32(R & 31);
        voffA[i] = (unsigned)(R * g.lda + C) * 2u; voffB[i] = (unsigned)(Rb * g.ldb + C) * 2u; }
    const size_t kstep = (size_t)(BK * 2);
    const size_t hstepA = (size_t)HALF * g.lda * 2, hstepB = (size_t)32 * g.ldb * 2, tstepA = 2 * hstepA, tstepB = (size_t)BM * g.ldb * 2;
    const unsigned ldsw = (unsigned)wid * 1024u;
    const int aoff = lds_byte(wr * 64 + fr, fq * 8), boff = lds_byte(wc * 32 + fr, fq * 8);
#define PG8_SA(b, h) (((b) * 2 + (h)) * HTB)
#define PG8_SB(b, h) ((4 + (b) * 2 + (h)) * HTB)
#define PG8_STAGE(bufoff, gbase, voff) do { _Pragma("unroll") for (int _i = 0; _i < 2; ++_i) \
        __builtin_amdgcn_global_load_lds((const unsigned*)((const char*)(gbase) + (voff)[_i]), (LAS unsigned*)(lds + (bufoff) + ldsw + _i * 8192), 16, 0, 0); } while (0)
#define PG8_LDA(dst, b, h) do { _Pragma("unroll") for (int m = 0; m < 4; ++m) _Pragma("unroll") for (int k = 0; k < 2; ++k) dst[m][k] = *(const LAS bf16x8*)(lds + PG8_SA(b, h) + aoff + m * 2048 + k * 1024); } while (0)
#define PG8_LDB(dst, b, h) do { _Pragma("unroll") for (int n = 0; n < 2; ++n) _Pragma("unroll") for (int k = 0; k < 2; ++k) dst[n][k] = *(const LAS bf16x8*)(lds + PG8_SB(b, h) + boff + n * 2048 + k * 1024); } while (0)
#define PG8_MMA(ai, bj, At, Bt) do { __builtin_amdgcn_s_setprio(1); _Pragma("unroll") for (int m = 0; m < 4; ++m) _Pragma("unroll") for (int n = 0; n < 2; ++n) _Pragma("unroll") for (int k = 0; k < 2; ++k) \
        acc[ai][bj][m][n] = __builtin_amdgcn_mfma_f32_16x16x32_bf16(Bt[n][k], At[m][k], acc[ai][bj][m][n], 0, 0, 0); __builtin_amdgcn_s_setprio(0); } while (0)
#define PG8_WAIT_V(n) asm volatile("s_waitcnt vmcnt(" #n ")" ::: "memory")
#define PG8_WAIT_L(n) asm volatile("s_waitcnt lgkmcnt(" #n ")" ::: "memory")
#define PG8_BAR __builtin_amdgcn_s_barrier()
#define PG8_SCHED __builtin_amdgcn_sched_barrier(0)
    Unit cur, nxt; int ui = 0;
    if (!S.next(0, cur)) return;
    f32x4 acc[2][2][4][2];
#pragma unroll
    for (int a = 0; a < 2; ++a)
#pragma unroll
        for (int b = 0; b < 2; ++b)
#pragma unroll
            for (int m = 0; m < 4; ++m)
#pragma unroll
                for (int n = 0; n < 2; ++n) acc[a][b][m][n] = (f32x4){0.f, 0.f, 0.f, 0.f};
    bf16x8 At[4][2], B0[2][2], B1[2][2];
    const char* cA = panelA(g, cur.pm, tstepA); const char* cB = (const char*)g.Bt + (size_t)cur.pn * tstepB;
    PG8_STAGE(PG8_SB(0, 0), cB, voffB); PG8_STAGE(PG8_SB(0, 1), cB + hstepB, voffB); PG8_STAGE(PG8_SA(0, 0), cA, voffA); PG8_STAGE(PG8_SA(0, 1), cA + hstepA, voffA);
    pre();
    if (wr == 1) PG8_BAR;
    PG8_WAIT_V(2); PG8_BAR;
    PG8_STAGE(PG8_SB(1, 0), cB + kstep, voffB); PG8_STAGE(PG8_SA(1, 0), cA + kstep, voffA); PG8_STAGE(PG8_SB(1, 1), cB + hstepB + kstep, voffB);
    PG8_WAIT_V(6); PG8_BAR;
    for (;;) {
        const bool has_next = S.next(ui + 1, nxt);
        const char* nA = has_next ? panelA(g, nxt.pm, tstepA) : cA; const char* nB = has_next ? (const char*)g.Bt + (size_t)nxt.pn * tstepB : cB;
        for (int t = 0; t < nt; t += 2) {
            const bool last = (t == nt - 2);
            const char* a1 = cA + KT(t + 1) * kstep;
            const char* a2 = last ? nA : cA + KT(t + 2) * kstep; const char* b2 = last ? nB : cB + KT(t + 2) * kstep;
            const char* a3 = last ? nA + kstep : cA + KT(t + 3) * kstep; const char* b3 = last ? nB + kstep : cB + KT(t + 3) * kstep;
            PG8_LDB(B0, 0, 0); PG8_LDB(B1, 0, 1); PG8_SCHED; PG8_LDA(At, 0, 0); PG8_STAGE(PG8_SA(1, 1), a1 + hstepA, voffA);
            PG8_WAIT_V(8); PG8_WAIT_L(0); PG8_BAR; PG8_MMA(0, 0, At, B0); PG8_MMA(0, 1, At, B1); PG8_BAR; PG8_SCHED;
            PG8_LDA(At, 0, 1); PG8_STAGE(PG8_SB(0, 0), b2, voffB); PG8_STAGE(PG8_SB(0, 1), b2 + hstepB, voffB); PG8_STAGE(PG8_SA(0, 0), a2, voffA);
            PG8_WAIT_V(8); PG8_WAIT_L(0); PG8_BAR; PG8_MMA(1, 0, At, B0); PG8_MMA(1, 1, At, B1); PG8_BAR; PG8_SCHED;
            PG8_LDB(B0, 1, 0); PG8_LDB(B1, 1, 1); PG8_SCHED; PG8_LDA(At, 1, 0); PG8_STAGE(PG8_SA(0, 1), a2 + hstepA, voffA);
            PG8_WAIT_V(8); PG8_WAIT_L(0); PG8_BAR; PG8_MMA(0, 0, At, B0); PG8_MMA(0, 1, At, B1); PG8_BAR; PG8_SCHED;
            PG8_LDA(At, 1, 1); PG8_STAGE(PG8_SB(1, 0), b3, voffB); PG8_STAGE(PG8_SB(1, 1), b3 + hstepB, voffB); PG8_STAGE(PG8_SA(1, 0), a3, voffA);
            PG8_WAIT_V(8); PG8_WAIT_L(0); PG8_BAR; PG8_MMA(1, 0, At, B0); PG8_MMA(1, 1, At, B1); PG8_BAR; PG8_SCHED;
        }
        if constexpr (ALIGN_EPI) { if (wr == 0) PG8_BAR; }
        E(acc, cur, wr, wc, fr, fq);
        if (!has_next) break;
#pragma unroll
        for (int a = 0; a < 2; ++a)
#pragma unroll
            for (int b = 0; b < 2; ++b)
#pragma unroll
                for (int m = 0; m < 4; ++m)
#pragma unroll
                    for (int n = 0; n < 2; ++n) acc[a][b][m][n] = (f32x4){0.f, 0.f, 0.f, 0.f};
        cur = nxt; cA = nA; cB = nB; ++ui;
        if constexpr (ALIGN_EPI) { if (wr == 1) PG8_BAR; }
    }
    PG8_WAIT_V(0);
    if constexpr (!ALIGN_EPI) { if (wr == 0) PG8_BAR; }
    PG8_BAR;
#undef KT
#undef PG8_SA
#undef PG8_SB
#undef PG8_STAGE
#undef PG8_LDA
#undef PG8_LDB
#undef PG8_MMA
#undef PG8_WAIT_V
#undef PG8_WAIT_L
#undef PG8_BAR
#undef PG8_SCHED
}
}

struct RsLds { const LAS float* tab; const LAS int* pml;
    __device__ __forceinline__ const LAS float* panel(int pm) const { const int p0 = pml[0], p1 = pml[1], p2 = pml[2]; const int slot = pm == p0 ? 0 : (pm == p1 ? 1 : (pm == p2 ? 2 : 3)); return tab + slot * 256; } };

template <int ACT  > __device__ __forceinline__ u32x4 proj_pack(const f32x4 a, const f32x4 b, float s) {
    const float v[8] = {a.x, a.y, a.z, a.w, b.x, b.y, b.z, b.w};
    if constexpr (ACT == 0) return pack8(v, s);
    else { const float s2 = s * -1.4426950408889634f; float e[8], o[8];
#pragma unroll
        for (int j = 0; j < 8; ++j) e[j] = __builtin_amdgcn_exp2f(v[j] * s2);
#pragma unroll
        for (int j = 0; j < 8; ++j) e[j] = __builtin_amdgcn_rcpf(1.0f + e[j]);
#pragma unroll
        for (int j = 0; j < 8; ++j) o[j] = ACT == 1 ? (v[j] * s) * e[j] : e[j];
        return pack8(o, 1.0f); }
}
template <int ACT> __device__ __forceinline__ void proj_rows(const f32x4 (&acc)[2][2][4][2], const LAS float* rt, LAS unsigned char* s, unsigned w0, unsigned w1, unsigned rd, bf16_t* tb, int ld, int r8, int c8) {
#pragma unroll
    for (int ai = 0; ai < 2; ++ai) {
        float sc[4];
#pragma unroll
        for (int m = 0; m < 4; ++m) sc[m] = rt[ai * 128 + m * 16];
#pragma unroll
        for (int mh = 0; mh < 2; ++mh) {
            u32x4 q[2][2];
#pragma unroll
            for (int mm = 0; mm < 2; ++mm) { const int m = 2 * mh + mm;
                *(LAS u32x4*)(s + w0) = proj_pack<ACT>(acc[ai][0][m][0], acc[ai][0][m][1], sc[m]);
                *(LAS u32x4*)(s + w1) = proj_pack<ACT>(acc[ai][1][m][0], acc[ai][1][m][1], sc[m]);
                q[mm][0] = *(const LAS u32x4*)(s + rd); q[mm][1] = *(const LAS u32x4*)(s + 1024 + rd); }
#pragma unroll
            for (int mm = 0; mm < 2; ++mm) { bf16_t* p = tb + (size_t)(ai * 128 + (2 * mh + mm) * 16 + r8) * ld + 8 * c8;
                st16_wt(p, q[mm][0]); st16_wt(p + (size_t)8 * ld, q[mm][1]); }
        }
    }
}
struct EpiProjT {
    static constexpr bool REPEATABLE = false;
    RsLds rs; bf16_t *patt, *pret, *prg, *pga, *pgr; LAS unsigned char* scr;
    __device__ __forceinline__ void operator()(const f32x4 (&acc)[2][2][4][2], const pg8::Unit& u, int wr, int wc, int fr, int fq) const {
        int lane_ = fq * 16 + fr; asm volatile("" : "+v"(lane_));
        const int wid = wr * 4 + wc, lane = lane_, r8 = lane >> 3, c8 = lane & 7; fr = lane & 15; fq = lane >> 4;
        LAS unsigned char* s = scr + wid * 2048;
        const int colw = u.pn * 256 + wc * 64; const size_t rowg = (size_t)u.pm * 256 + wr * 64;
        const unsigned w0 = (unsigned)fr * 128u + (((unsigned)fq ^ ((unsigned)fr & 7u)) << 4), w1 = (unsigned)fr * 128u + (((unsigned)(4 + fq) ^ ((unsigned)fr & 7u)) << 4);
        const unsigned rd = (unsigned)r8 * 128u + (((unsigned)c8 ^ (unsigned)r8) << 4);
        const LAS float* rt = rs.panel(u.pm) + wr * 64 + fr;
        if (colw < 768) proj_rows<0>(acc, rt, s, w0, w1, rd, patt + rowg * 768 + colw, 768, r8, c8);
        else if (colw < 2816) proj_rows<0>(acc, rt, s, w0, w1, rd, pret + rowg * 2048 + (colw - 768), 2048, r8, c8);
        else if (colw < 3840) proj_rows<1>(acc, rt, s, w0, w1, rd, prg + rowg * 1024 + (colw - 2816), 1024, r8, c8);
        else proj_rows<2>(acc, rt, s, w0, w1, rd, (colw < 4864 ? pga + (colw - 3840) : pgr + (colw - 4864)) + rowg * 1024, 1024, r8, c8);
    }
};
template <class Ap> struct Epi8Dual {
    static constexpr bool REPEATABLE = false; Ap ap;
    __device__ __forceinline__ void operator()(const f32x4 (&acc)[2][2][4][2], const pg8::Unit& u, int wr, int wc, int fr, int fq) const {
        const int row0 = u.pm * 256 + wr * 64 + fr, col0 = u.pn * 128 + wc * 32 + 8 * fq;
        const LAS float* rt = ap.rs.panel(u.pm); float sc[2][4];
#pragma unroll
        for (int ai = 0; ai < 2; ++ai)
#pragma unroll
            for (int m = 0; m < 4; ++m) sc[ai][m] = rt[ai * 128 + wr * 64 + m * 16 + fr];
#pragma unroll
        for (int ai = 0; ai < 2; ++ai)
#pragma unroll
            for (int m = 0; m < 4; ++m) { const f32x4 a = acc[ai][0][m][0], b = acc[ai][0][m][1], c = acc[ai][1][m][0], d = acc[ai][1][m][1];
                const float gv[8] = {a.x, a.y, a.z, a.w, b.x, b.y, b.z, b.w}, uv[8] = {c.x, c.y, c.z, c.w, d.x, d.y, d.z, d.w};
                ap.apply8(row0 + ai * 128 + m * 16, col0, sc[ai][m], gv, uv); }
    }
};
struct WaveTile {
    LAS unsigned char* s; unsigned w0, w1, rd; int r8, c8, fr, fq;
    __device__ __forceinline__ void init(LAS unsigned char* scr, int wr, int wc, int fr_, int fq_) {
        int lane_ = fq_ * 16 + fr_; asm volatile("" : "+v"(lane_));
        fr = lane_ & 15; fq = lane_ >> 4; r8 = lane_ >> 3; c8 = lane_ & 7; s = scr + (wr * 4 + wc) * 2048;
        w0 = (unsigned)fr * 128u + (((unsigned)fq ^ ((unsigned)fr & 7u)) << 4); w1 = (unsigned)fr * 128u + (((unsigned)(4 + fq) ^ ((unsigned)fr & 7u)) << 4);
        rd = (unsigned)r8 * 128u + (((unsigned)c8 ^ (unsigned)r8) << 4);
    }
    __device__ __forceinline__ void lines_to_acc(u32x4 l0, u32x4 l1, u32x4& a0, u32x4& a1) const { *(LAS u32x4*)(s + rd) = l0; *(LAS u32x4*)(s + 1024 + rd) = l1; a0 = *(const LAS u32x4*)(s + w0); a1 = *(const LAS u32x4*)(s + w1); }
    __device__ __forceinline__ void acc_to_lines(u32x4 a0, u32x4 a1, u32x4& l0, u32x4& l1) const { *(LAS u32x4*)(s + w0) = a0; *(LAS u32x4*)(s + w1) = a1; l0 = *(const LAS u32x4*)(s + rd); l1 = *(const LAS u32x4*)(s + 1024 + rd); }
};
struct EpiM1F {
    static constexpr bool REPEATABLE = false;
    const bf16_t* ga; bf16_t* m1; LAS unsigned char* scr;
    __device__ __forceinline__ void operator()(const f32x4 (&acc)[2][2][4][2], const pg8::Unit& u, int wr, int wc, int fr, int fq) const {
        WaveTile W; W.init(scr, wr, wc, fr, fq);
        const size_t base = ((size_t)u.pm * 256 + wr * 64 + W.r8) * 1024 + (u.pn * 256 + wc * 64) + 8 * W.c8;
#pragma unroll
        for (int ai = 0; ai < 2; ++ai)
#pragma unroll
            for (int mh = 0; mh < 2; ++mh) {
                u32x4 L[2][2];
#pragma unroll
                for (int mm = 0; mm < 2; ++mm) { const size_t o = base + (size_t)(ai * 128 + (2 * mh + mm) * 16) * 1024; L[mm][0] = *(const u32x4*)(ga + o); L[mm][1] = *(const u32x4*)(ga + o + 8 * 1024); }
#pragma unroll
                for (int mm = 0; mm < 2; ++mm) { const int m = 2 * mh + mm; u32x4 g0, g1, q0, q1; W.lines_to_acc(L[mm][0], L[mm][1], g0, g1);
                    float gv[8], o[8];
                    { unpack8(g0, gv); const f32x4 a = acc[ai][0][m][0], b = acc[ai][0][m][1]; const float v[8] = {a.x, a.y, a.z, a.w, b.x, b.y, b.z, b.w};
#pragma unroll
                      for (int j = 0; j < 8; ++j) o[j] = gv[j] * v[j];
                      g0 = pack8(o, 1.0f); }
                    { unpack8(g1, gv); const f32x4 a = acc[ai][1][m][0], b = acc[ai][1][m][1]; const float v[8] = {a.x, a.y, a.z, a.w, b.x, b.y, b.z, b.w};
#pragma unroll
                      for (int j = 0; j < 8; ++j) o[j] = gv[j] * v[j];
                      g1 = pack8(o, 1.0f); }
                    W.acc_to_lines(g0, g1, q0, q1);
                    const size_t oo = base + (size_t)(ai * 128 + m * 16) * 1024; *(u32x4*)(m1 + oo) = q0; *(u32x4*)(m1 + oo + 8 * 1024) = q1; }
            }
    }
};
struct EpiMrgF {
    static constexpr bool REPEATABLE = false;
    const bf16_t* gr; bf16_t* m1; LAS unsigned char* scr;
    __device__ __forceinline__ void operator()(const f32x4 (&acc)[2][2][4][2], const pg8::Unit& u, int wr, int wc, int fr, int fq) const {
        WaveTile W; W.init(scr, wr, wc, fr, fq);
        const size_t base = ((size_t)u.pm * 256 + wr * 64 + W.r8) * 1024 + (u.pn * 256 + wc * 64) + 8 * W.c8;
#pragma unroll
        for (int ai = 0; ai < 2; ++ai)
#pragma unroll
            for (int mh = 0; mh < 2; ++mh) {
                u32x4 L[2][2], M[2][2];
#pragma unroll
                for (int mm = 0; mm < 2; ++mm) { const size_t o = base + (size_t)(ai * 128 + (2 * mh + mm) * 16) * 1024;
                    L[mm][0] = *(const u32x4*)(gr + o); L[mm][1] = *(const u32x4*)(gr + o + 8 * 1024); M[mm][0] = *(const u32x4*)(m1 + o); M[mm][1] = *(const u32x4*)(m1 + o + 8 * 1024); }
#pragma unroll
                for (int mm = 0; mm < 2; ++mm) { const int m = 2 * mh + mm; u32x4 g0, g1, p0, p1, q0, q1; W.lines_to_acc(L[mm][0], L[mm][1], g0, g1); W.lines_to_acc(M[mm][0], M[mm][1], p0, p1);
                    float gv[8], mv[8], o[8];
                    { unpack8(g0, gv); unpack8(p0, mv); const f32x4 a = acc[ai][0][m][0], b = acc[ai][0][m][1]; const float v[8] = {a.x, a.y, a.z, a.w, b.x, b.y, b.z, b.w};
#pragma unroll
                      for (int j = 0; j < 8; ++j) o[j] = mv[j] + gv[j] * v[j];
                      g0 = pack8(o, 1.0f); }
                    { unpack8(g1, gv); unpack8(p1, mv); const f32x4 a = acc[ai][1][m][0], b = acc[ai][1][m][1]; const float v[8] = {a.x, a.y, a.z, a.w, b.x, b.y, b.z, b.w};
#pragma unroll
                      for (int j = 0; j < 8; ++j) o[j] = mv[j] + gv[j] * v[j];
                      g1 = pack8(o, 1.0f); }
                    W.acc_to_lines(g0, g1, q0, q1);
                    const size_t oo = base + (size_t)(ai * 128 + m * 16) * 1024; st16_wt(m1 + oo, q0); st16_wt(m1 + oo + 8 * 1024, q1); }
            }
    }
};
struct EpiResF {
    static constexpr bool REPEATABLE = false;
    bf16_t* xb; float* ssp; LAS unsigned char* scr;
    __device__ __forceinline__ void operator()(const f32x4 (&acc)[2][2][4][2], const pg8::Unit& u, int wr, int wc, int fr, int fq) const {
        WaveTile W; W.init(scr, wr, wc, fr, fq);
        const size_t base = ((size_t)u.pm * 256 + wr * 64 + W.r8) * D + (u.pn * 256 + wc * 64) + 8 * W.c8;
#pragma unroll
        for (int ai = 0; ai < 2; ++ai) {
            float ssm[4];
#pragma unroll
            for (int mh = 0; mh < 2; ++mh) {
                u32x4 L[2][2];
#pragma unroll
                for (int mm = 0; mm < 2; ++mm) { const size_t o = base + (size_t)(ai * 128 + (2 * mh + mm) * 16) * D; L[mm][0] = *(const u32x4*)(xb + o); L[mm][1] = *(const u32x4*)(xb + o + 8 * D); }
#pragma unroll
                for (int mm = 0; mm < 2; ++mm) { const int m = 2 * mh + mm; u32x4 b0, b1, q0, q1; W.lines_to_acc(L[mm][0], L[mm][1], b0, b1); float ss = 0.f;
                    { float x[8]; unpack8(b0, x); const f32x4 a = acc[ai][0][m][0], b = acc[ai][0][m][1];
                      x[0] += a.x; x[1] += a.y; x[2] += a.z; x[3] += a.w; x[4] += b.x; x[5] += b.y; x[6] += b.z; x[7] += b.w; b0 = pack8(x, 1.0f);
                      ss += (x[0] * x[0] + x[1] * x[1]) + (x[2] * x[2] + x[3] * x[3]) + (x[4] * x[4] + x[5] * x[5]) + (x[6] * x[6] + x[7] * x[7]); }
                    { float x[8]; unpack8(b1, x); const f32x4 a = acc[ai][1][m][0], b = acc[ai][1][m][1];
                      x[0] += a.x; x[1] += a.y; x[2] += a.z; x[3] += a.w; x[4] += b.x; x[5] += b.y; x[6] += b.z; x[7] += b.w; b1 = pack8(x, 1.0f);
                      ss += (x[0] * x[0] + x[1] * x[1]) + (x[2] * x[2] + x[3] * x[3]) + (x[4] * x[4] + x[5] * x[5]) + (x[6] * x[6] + x[7] * x[7]); }
                    ss += __shfl_xor(ss, 16); ss += __shfl_xor(ss, 32); ssm[m] = ss;
                    W.acc_to_lines(b0, b1, q0, q1);
                    const size_t oo = base + (size_t)(ai * 128 + m * 16) * D; st16_wt(xb + oo, q0); st16_wt(xb + oo + 8 * D, q1); }
            }
            { const float sel = W.fq == 0 ? ssm[0] : (W.fq == 1 ? ssm[1] : (W.fq == 2 ? ssm[2] : ssm[3]));
              ssp[((size_t)u.pm * 256 + wr * 64 + ai * 128 + W.fq * 16 + W.fr) * 16 + u.pn * 4 + wc] = sel; }
        }
    }
};

constexpr int NWAVES = 8;
constexpr int RING_OFF = 0, RING_BYTES = 131072;
constexpr int RS_OFF = RING_BYTES;
constexpr int EPI_OFF = RS_OFF + 4096;
constexpr int LDSCTL_OFF = 157696;   static_assert(LDSCTL_OFF >= mx::RT_END, "LDS map");
constexpr int LDS_BYTES = 158720;
constexpr size_t CTL_ZERO_BYTES = 131072;
constexpr int CW_BAR = 4096;
#define XB_TMO      128
#define XB_XCNT(j)  (256  + 64 * (j))
#define XB_XSUB(j)  (1280 + 64 * (j))
#define XB_XGEN(j)  (2304 + 64 * (j))
#define XB_TOP      3328
#define XB_TOPGEN   3392
#define XCD_BAR_WORDS 3456
#define XB_SPIN_CAP (1u << 22)
__device__ __forceinline__ unsigned xb_ld(unsigned* p)              { return __hip_atomic_load(p, __ATOMIC_RELAXED, __HIP_MEMORY_SCOPE_AGENT); }
__device__ __forceinline__ unsigned xb_add(unsigned* p, unsigned v) { return __hip_atomic_fetch_add(p, v, __ATOMIC_RELAXED, __HIP_MEMORY_SCOPE_AGENT); }
__device__ __forceinline__ unsigned xb_xcc_id() { return (unsigned)__builtin_amdgcn_s_getreg((3 << 11) | 20) & 0xFu; }
#define XB_SPIN(cond, bar) do { unsigned _sp = 0; while (cond) { __builtin_amdgcn_s_sleep(1); \
    if ((++_sp & 255u) == 0u) { if (xb_ld(&(bar)[XB_TMO])) break; if (_sp > XB_SPIN_CAP) { atomicAdd(&(bar)[XB_TMO], 1u); break; } } } } while (0)
struct XcdBarrier { unsigned* bar; unsigned x; volatile LAS unsigned* st; };
__device__ __forceinline__ XcdBarrier xcd_barrier_post(unsigned* bar, volatile LAS unsigned* st) {
    XcdBarrier b; b.bar = bar; b.x = xb_xcc_id(); b.st = st;
    if (threadIdx.x == 0) st[3] = xb_add(&bar[XB_XCNT(b.x)], 1u);
    return b;
}
__device__ __forceinline__ void xcd_barrier_complete(unsigned* bar, unsigned x, unsigned& nloc, unsigned& nx, unsigned& regular) {
    const unsigned G = gridDim.x * gridDim.y * gridDim.z;
    unsigned sum, cnt, mine, reg, sp = 0u;
    for (;;) {
        sum = 0u; cnt = 0u; mine = 0u; reg = (G % 8u == 0u) ? 1u : 0u;
#pragma unroll
        for (unsigned j = 0; j < 16; ++j) { const unsigned c = xb_ld(&bar[XB_XCNT(j)]); sum += c; cnt += (c > 0u) ? 1u : 0u; mine = (j == x) ? c : mine; reg = (c == (j < 8u ? G / 8u : 0u)) ? reg : 0u; }
        if (sum == G) break;
        __builtin_amdgcn_s_sleep(1);
        if ((++sp & 255u) == 0u) { if (xb_ld(&bar[XB_TMO])) break; if (sp > XB_SPIN_CAP) { atomicAdd(&bar[XB_TMO], 1u); break; } }
    }
    nloc = mine > 0u ? mine : 1u; nx = cnt > 0u ? cnt : 1u; regular = reg;
}
__device__ __forceinline__ void xcd_barrier(const XcdBarrier& b, int wave, bool local = false) {
    asm volatile("s_waitcnt vmcnt(0)" ::: "memory");
    __syncthreads();
    if (tid_from_wave(wave) == 0) {
        unsigned* bar = b.bar;
        __builtin_amdgcn_s_waitcnt(0);
        unsigned nloc = b.st[0], nx = b.st[1];
        if (nloc == 0u) { unsigned reg; xcd_barrier_complete(bar, b.x, nloc, nx, reg); b.st[0] = nloc; b.st[1] = nx; b.st[2] = reg; }
        const unsigned old = xb_add(&bar[XB_XSUB(b.x)], 1u);
        const unsigned gen = old / nloc;
        if (old + 1u == (gen + 1u) * nloc) {
            if (!local) { __builtin_amdgcn_fence(__ATOMIC_RELEASE, "agent"); asm volatile("s_waitcnt vmcnt(0)" ::: "memory"); }
            if (!local) {
                const unsigned og = xb_add(&bar[XB_TOP], 1u);
                const unsigned tg = og / nx;
                __builtin_amdgcn_fence(__ATOMIC_ACQUIRE, "agent");
                if (og + 1u == (tg + 1u) * nx) xb_add(&bar[XB_TOPGEN], 1u);
                else XB_SPIN(xb_ld(&bar[XB_TOPGEN]) == tg, bar);
            } else __builtin_amdgcn_fence(__ATOMIC_ACQUIRE, "agent");
            xb_add(&bar[XB_XGEN(b.x)], 1u);
            asm volatile("s_waitcnt vmcnt(0)" ::: "memory");
        } else {
            __builtin_amdgcn_fence(__ATOMIC_ACQUIRE, "agent");
            XB_SPIN(xb_ld(&bar[XB_XGEN(b.x)]) == gen, bar);
            asm volatile("s_waitcnt vmcnt(0)" ::: "memory");
        }
    }
    __syncthreads();
}

template <class Sched>
__device__ __forceinline__ void build_rstd_table(LAS unsigned char* lds, const Sched& S, const float* ssp, int wave) {
    LAS float* tab = (LAS float*)(lds + RS_OFF); volatile LAS int* pml = (volatile LAS int*)(lds + LDSCTL_OFF);
    int p0 = -1, p1 = -1, p2 = -1, p3 = -1; pg8::Unit u;
    for (int i = 0; S.next(i, u); ++i) { const int pm = u.pm; if (pm == p0 || pm == p1 || pm == p2 || pm == p3) continue;
        if (p0 < 0) p0 = pm; else if (p1 < 0) p1 = pm; else if (p2 < 0) p2 = pm; else if (p3 < 0) p3 = pm; }
    int t0_ = tid_from_wave(wave); asm volatile("" : "+v"(t0_));
    if (t0_ == 0) { pml[0] = p0; pml[1] = p1; pml[2] = p2; pml[3] = p3; }
    for (int idx = t0_; idx < 1024; idx += NWAVES * 64) { const int slot = idx >> 8; const int pm = slot == 0 ? p0 : (slot == 1 ? p1 : (slot == 2 ? p2 : p3));
        if (pm >= 0) { const f32x4* q = (const f32x4*)(ssp + (size_t)(pm * 256 + (idx & 255)) * 16); const f32x4 a = q[0], b = q[1], c = q[2], d = q[3];
            const float s = ((a.x + a.y) + (a.z + a.w)) + ((b.x + b.y) + (b.z + b.w)) + ((c.x + c.y) + (c.z + c.w)) + ((d.x + d.y) + (d.z + d.w));
            tab[idx] = rsqrtf(s * (1.0f / D) + EPS); } }
    __syncthreads();
}

__device__ __forceinline__ void st4_wt(void* p, float v) { asm volatile("global_store_dword %0, %1, off sc0 sc1\n\ts_nop 1" :: "v"(p), "v"(v) : "memory"); }
__device__ __forceinline__ void ld16x8_sys(f32x4 (&v)[8], const float* const (&p)[8]) {
    asm volatile("global_load_dwordx4 %0, %8, off sc0 sc1\n\tglobal_load_dwordx4 %1, %9, off sc0 sc1\n\tglobal_load_dwordx4 %2, %10, off sc0 sc1\n\tglobal_load_dwordx4 %3, %11, off sc0 sc1\n\t"
                 "global_load_dwordx4 %4, %12, off sc0 sc1\n\tglobal_load_dwordx4 %5, %13, off sc0 sc1\n\tglobal_load_dwordx4 %6, %14, off sc0 sc1\n\tglobal_load_dwordx4 %7, %15, off sc0 sc1\n\t"
                 "s_waitcnt vmcnt(0)"
                 : "=&v"(v[0]), "=&v"(v[1]), "=&v"(v[2]), "=&v"(v[3]), "=&v"(v[4]), "=&v"(v[5]), "=&v"(v[6]), "=&v"(v[7])
                 : "v"(p[0]), "v"(p[1]), "v"(p[2]), "v"(p[3]), "v"(p[4]), "v"(p[5]), "v"(p[6]), "v"(p[7]) : "memory"); }
constexpr int CW_CONV = 18432;
constexpr int CW_FIN = 16384;
struct EpiFinal {
    static constexpr bool REPEATABLE = false;
    const bf16_t* xb; float* ssp; const float* gfin; float* out; unsigned* cnt; LAS unsigned char* scr;
    __device__ __forceinline__ void operator()(f32x4 (&acc)[2][2][4][2], const pg8::Unit& u, int wr, int wc, int fr_, int fq_) const {
        WaveTile W; W.init(scr, wr, wc, fr_, fq_);
        const int fr = W.fr, fq = W.fq;
        const size_t rowb = (size_t)u.pm * 256 + wr * 64; const int colb = u.pn * 256 + wc * 64;
        const size_t base = (rowb + W.r8) * D + colb + 8 * W.c8;
#pragma unroll
        for (int ai = 0; ai < 2; ++ai) {
            float ssm[4];
#pragma unroll
            for (int mh = 0; mh < 2; ++mh) {
                u32x4 L[2][2];
#pragma unroll
                for (int mm = 0; mm < 2; ++mm) { const size_t o = base + (size_t)(ai * 128 + (2 * mh + mm) * 16) * D; L[mm][0] = *(const u32x4*)(xb + o); L[mm][1] = *(const u32x4*)(xb + o + 8 * D); }
#pragma unroll
                for (int mm = 0; mm < 2; ++mm) { const int m = 2 * mh + mm; u32x4 b0, b1; W.lines_to_acc(L[mm][0], L[mm][1], b0, b1); float ss = 0.f;
#pragma unroll
                    for (int bj = 0; bj < 2; ++bj) { float x[8]; unpack8(bj == 0 ? b0 : b1, x); f32x4& a = acc[ai][bj][m][0]; f32x4& b = acc[ai][bj][m][1];
                        a.x += x[0]; a.y += x[1]; a.z += x[2]; a.w += x[3]; b.x += x[4]; b.y += x[5]; b.z += x[6]; b.w += x[7];
                        ss += (a.x * a.x + a.y * a.y) + (a.z * a.z + a.w * a.w) + (b.x * b.x + b.y * b.y) + (b.z * b.z + b.w * b.w); }
                    ss += __shfl_xor(ss, 16); ss += __shfl_xor(ss, 32); ssm[m] = ss; }
            }
            const float sel = fq == 0 ? ssm[0] : (fq == 1 ? ssm[1] : (fq == 2 ? ssm[2] : ssm[3]));
            st4_wt(ssp + (rowb + ai * 128 + fq * 16 + fr) * 16 + u.pn * 4 + wc, sel);
        }
        asm volatile("s_waitcnt vmcnt(0)" ::: "memory");
        unsigned* c = cnt + u.pm * 16;
        if (fr_ == 0 && fq_ == 0) (void)xb_add(c, 1u);
        { unsigned sp = 0; while (xb_ld(c) < 32u) { __builtin_amdgcn_s_sleep(1); if (++sp > XB_SPIN_CAP) break; } }
        float rs[2][4]; f32x4 pp[8]; const float* pa[8];
#pragma unroll
        for (int i = 0; i < 8; ++i) pa[i] = ssp + (rowb + (i >> 2) * 128 + (i & 3) * 16 + fr) * 16 + 4 * fq;
        ld16x8_sys(pp, pa);
#pragma unroll
        for (int i = 0; i < 8; ++i) { const f32x4 p = pp[i]; float t = (p.x + p.y) + (p.z + p.w); t += __shfl_xor(t, 16); t += __shfl_xor(t, 32); rs[i >> 2][i & 3] = rsqrtf(t * (1.0f / D) + EPS); }
        const unsigned v0 = (unsigned)fr * 128u + ((((unsigned)(2 * fq)) ^ ((unsigned)fr & 7u)) << 4), v1 = (unsigned)fr * 128u + ((((unsigned)(2 * fq + 1)) ^ ((unsigned)fr & 7u)) << 4);
#pragma unroll
        for (int bj = 0; bj < 2; ++bj) {
            const f32x4 g0 = *(const f32x4*)(gfin + colb + 32 * bj + 8 * fq), g1 = *(const f32x4*)(gfin + colb + 32 * bj + 8 * fq + 4);
            float* ob = out + (rowb + W.r8) * D + colb + 32 * bj + 4 * W.c8;
#pragma unroll
            for (int ai = 0; ai < 2; ++ai)
#pragma unroll
                for (int m = 0; m < 4; ++m) { const float r = rs[ai][m]; const f32x4 a = acc[ai][bj][m][0], b = acc[ai][bj][m][1];
                    *(LAS f32x4*)(W.s + v0) = (f32x4){a.x * r * g0.x, a.y * r * g0.y, a.z * r * g0.z, a.w * r * g0.w};
                    *(LAS f32x4*)(W.s + v1) = (f32x4){b.x * r * g1.x, b.y * r * g1.y, b.z * r * g1.z, b.w * r * g1.w};
                    const f32x4 q0 = *(const LAS f32x4*)(W.s + W.rd), q1 = *(const LAS f32x4*)(W.s + 1024 + W.rd);
                    float* o = ob + (size_t)(ai * 128 + m * 16) * D; *(f32x4*)o = q0; *(f32x4*)(o + (size_t)8 * D) = q1; }
        }
    }
};

struct RstdPre { LAS unsigned char* lds; const pg8::StaticOrder* S; const float* ssp; int wave;
    __device__ __forceinline__ void operator()() const { build_rstd_table(lds, *S, ssp, wave); } };
constexpr int PH_PRO = 0, PH_FIN = 1 + 6 * DEPTH, NPH = PH_FIN + 1;
struct Args { const float* in[13]; float* out; unsigned char* ws; int ph_lo, ph_hi, li, pad; };
__global__ void __launch_bounds__(NWAVES * 64, 2) mega(Args args) {
    extern __shared__ __attribute__((aligned(16))) unsigned char lds_raw[];
    LAS unsigned char* lds = (LAS unsigned char*)lds_raw;
    const int tid = threadIdx.x, wave = __builtin_amdgcn_readfirstlane(tid >> 6);
    const int G = gridDim.x, bx = blockIdx.x, vcu = (G % 8 == 0) ? (bx % 8) * (G / 8) + bx / 8 : bx;
    unsigned char* ws = args.ws;
    for (int u = tid; u < 512 / 4; u += NWAVES * 64) ((LAS unsigned*)(lds + LDSCTL_OFF))[u] = 0u;
    __syncthreads();
    XcdBarrier bar = xcd_barrier_post((unsigned*)(ws + WS_CTL) + CW_BAR + args.li * XCD_BAR_WORDS, (volatile LAS unsigned*)(lds + LDSCTL_OFF) + 8);
    float* xf = args.out; bf16_t* xb = (bf16_t*)(ws + WS_XB); float* ssp = (float*)(ws + WS_SSP);
    bf16_t* patt = (bf16_t*)(ws + WS_PATT); bf16_t* pret = (bf16_t*)(ws + WS_PRET); bf16_t* prg = (bf16_t*)(ws + WS_PRG);
    bf16_t* pga = (bf16_t*)(ws + WS_PGA); bf16_t* pgr = (bf16_t*)(ws + WS_PGR); bf16_t* m1 = pga  ; bf16_t* act = (bf16_t*)(ws + WS_ACT);
    const int gw = vcu * NWAVES + wave, ngw = G * NWAVES;
    const RsLds rs{(const LAS float*)(lds + RS_OFF), (const LAS int*)(lds + LDSCTL_OFF)};

    const int lo = args.ph_lo, hi = args.ph_hi;
    const bool full = lo == 0 && hi == NPH;
    const bool fuse_fin = (G % 128 == 0) && full;
#define IN(k) (lo <= (k) && (k) < hi)
#define SEAM(k) do { if (IN(k) && IN((k) + 1)) xcd_barrier(bar, wave); } while (0)
#define SEAM_L(k) do { if (IN(k) && IN((k) + 1)) xcd_barrier(bar, wave, xl); } while (0)
    if (IN(PH_PRO)) {
        int tl_ = tid_from_wave(wave); asm volatile("" : "+v"(tl_)); const int lane = tl_ & 63;
        WPtrs P{args.in[1], args.in[2], args.in[5], args.in[6], args.in[7], args.in[8], args.in[9], args.in[10], args.in[11], args.in[4]};
        prologue_weights(P, ws, (float*)(lds_raw + wave * 16384), gw, ngw, lane, 0, PRO_I_IN0);
        const float* x = args.in[0];
        for (int t0 = gw * 4; t0 < T; t0 += ngw * 4) {
            f32x4 v[4][4];
#pragma unroll
            for (int rr = 0; rr < 4; ++rr) { const f32x4* xr = (const f32x4*)(x + (size_t)(t0 + rr) * D) + lane;
#pragma unroll
                for (int j = 0; j < 4; ++j) v[rr][j] = xr[64 * j]; }
#pragma unroll
            for (int rr = 0; rr < 4; ++rr) { const int t = t0 + rr; float s = 0.f;
#pragma unroll
                for (int j = 0; j < 4; ++j) s += (v[rr][j].x * v[rr][j].x + v[rr][j].y * v[rr][j].y) + (v[rr][j].z * v[rr][j].z + v[rr][j].w * v[rr][j].w);
                s = wave_sum(s);
                unsigned long long* o8 = (unsigned long long*)(xb + (size_t)t * D) + lane;
#pragma unroll
                for (int j = 0; j < 4; ++j) o8[64 * j] = (unsigned long long)pk2(v[rr][j].x, v[rr][j].y) | ((unsigned long long)pk2(v[rr][j].z, v[rr][j].w) << 32);
                if (lane < 16) ssp[(size_t)t * 16 + lane] = lane == 0 ? s : 0.f; }
        }
    }
    SEAM(PH_PRO);
    const bool xl = (G == 256) && (((volatile LAS unsigned*)(lds + LDSCTL_OFF))[10] != 0u);
    const int vb = xl ? (int)(((volatile LAS unsigned*)(lds + LDSCTL_OFF))[11] * 8u + bar.x) : bx;
    for (int l = 0; l < DEPTH; ++l) {
        const int pb = 1 + 6 * l;
        const unsigned char* wl = ws + WS_W + (size_t)l * W_LAYER;
        if (IN(pb + 0)) {
            pg8::StaticOrder S; S.init(T, DIN, G, vb);
            const pg8::Gemm g{xb, (const bf16_t*)(wl + W_IN), D, D, T, DIN, D};
            const EpiProjT E{rs, patt, pret, prg, pga, pgr, lds + EPI_OFF};
            pg8::gemm_phase<EpiProjT, pg8::StaticOrder, true>(lds + RING_OFF, g, S, E, wave, RstdPre{lds, &S, ssp, wave});
            if (2 * vb >= G) {
                int tl_ = tid_from_wave(wave); asm volatile("" : "+v"(tl_));
                WPtrs P{args.in[1], args.in[2], args.in[5], args.in[6], args.in[7], args.in[8], args.in[9], args.in[10], args.in[11], args.in[4]};
                prologue_weights(P, ws, (float*)(lds_raw + wave * 16384), (vb - G / 2) * NWAVES + wave, (G - G / 2) * NWAVES, tl_ & 63,
                                 l == 0 ? PRO_I_IN0 : PRO_PER_LAYER + PRO_I_IN0, l == 0 ? PRO_PER_LAYER + PRO_I_IN0 : 2 * PRO_PER_LAYER);
                asm volatile("s_waitcnt vmcnt(0)" ::: "memory");
                if ((tl_ & 63) == 0) (void)xb_add((unsigned*)(ws + WS_CTL) + CW_CONV + 16 * l, 1u);
            }
        }
        if (IN(pb + 0) && IN(pb + 1)) xcd_barrier(bar, wave, xl && full);
        if (IN(pb + 1)) mixer_phase_impl<3>(lds, ws, args.in[3] + l * AH, args.in[4] + l * RH * RDV, vb, G, patt, prg, wave, xl);
        if (full && IN(pb + 1) && IN(pb + 2) && tid_from_wave(wave) == 0) { unsigned* cw = (unsigned*)(ws + WS_CTL) + CW_CONV + 16 * l; const unsigned need = (unsigned)((G - G / 2) * NWAVES);
            unsigned sp = 0; while (xb_ld(cw) < need) { __builtin_amdgcn_s_sleep(1); if (++sp > XB_SPIN_CAP) break; } }
        SEAM_L(pb + 1);
        if (IN(pb + 2)) {
            pg8::StaticOrder S; S.init(T, D, G, vb);
            { const pg8::Gemm g{patt, (const bf16_t*)(wl + W_AO), 768, 512, T, D, 512}; const EpiM1F E{pga, m1, lds + EPI_OFF};
              pg8::gemm_phase<EpiM1F, pg8::StaticOrder, true>(lds + RING_OFF, g, S, E, wave); }
            { const pg8::Gemm g{prg, (const bf16_t*)(wl + W_RO), D, D, T, D, D}; const EpiMrgF E{pgr, m1, lds + EPI_OFF};
              pg8::gemm_phase<EpiMrgF, pg8::StaticOrder, true>(lds + RING_OFF, g, S, E, wave); }
        }
        SEAM_L(pb + 2);
        if (IN(pb + 3)) {
            pg8::StaticOrder S; S.init(T, D, G, vb);
            const pg8::Gemm g{m1, (const bf16_t*)(wl + W_OUT), D, D, T, D, D}; const EpiResF E{xb, ssp, lds + EPI_OFF};
            pg8::gemm_phase<EpiResF, pg8::StaticOrder, true>(lds + RING_OFF, g, S, E, wave);
        }
        SEAM_L(pb + 3);
        if (IN(pb + 4)) {
            pg8::StaticOrder S; S.init(T, 2 * DFF, G, vb);
            const pg8::Gemm g{xb, (const bf16_t*)(wl + W_GU), D, D, T, 2 * DFF, D}; const Epi8Dual<EpiAct<RsLds>> E{{rs, act}};
            pg8::gemm_phase<Epi8Dual<EpiAct<RsLds>>, pg8::StaticOrder, true>(lds + RING_OFF, g, S, E, wave, RstdPre{lds, &S, ssp, wave});
        }
        SEAM_L(pb + 4);
        if (IN(pb + 5)) {
            pg8::StaticOrder S; S.init(T, D, G, vb);
            const pg8::Gemm g{act, (const bf16_t*)(wl + W_DN), DFF, DFF, T, D, DFF, true};
            if (l == DEPTH - 1 && fuse_fin) { const EpiFinal E{xb, (float*)(ws + WS_SSP2), args.in[12], xf, (unsigned*)(ws + WS_CTL) + CW_FIN, lds + EPI_OFF};
                pg8::gemm_phase<EpiFinal, pg8::StaticOrder, true>(lds + RING_OFF, g, S, E, wave); }
            else { const EpiResF E{xb, ssp, lds + EPI_OFF};
                pg8::gemm_phase<EpiResF, pg8::StaticOrder, true>(lds + RING_OFF, g, S, E, wave); }
        }
        if (l < DEPTH - 1) SEAM_L(pb + 5); else if (!fuse_fin) SEAM(pb + 5);
    }
    if (IN(PH_FIN) && !fuse_fin) {
        int tl_ = tid_from_wave(wave); asm volatile("" : "+v"(tl_)); const int lane = tl_ & 63;
        const float* g = args.in[12];
        for (int t = gw; t < T; t += ngw) {
            const u32x4* xr = (const u32x4*)(xb + (size_t)t * D) + lane; u32x4 w[2]; float v[2][8]; float s = 0.f;
#pragma unroll
            for (int j = 0; j < 2; ++j) { w[j] = xr[64 * j]; unpack8(w[j], v[j]);
#pragma unroll
                for (int e = 0; e < 8; ++e) s += v[j][e] * v[j][e]; }
            s = wave_sum(s); const float r = rsqrtf(s * (1.0f / D) + EPS);
#pragma unroll
            for (int j = 0; j < 2; ++j) { const f32x4* gr = (const f32x4*)(g + 512 * j + 8 * lane); f32x4* o = (f32x4*)(xf + (size_t)t * D + 512 * j + 8 * lane); const f32x4 g0 = gr[0], g1 = gr[1];
                o[0] = (f32x4){v[j][0] * r * g0.x, v[j][1] * r * g0.y, v[j][2] * r * g0.z, v[j][3] * r * g0.w};
                o[1] = (f32x4){v[j][4] * r * g1.x, v[j][5] * r * g1.y, v[j][6] * r * g1.z, v[j][7] * r * g1.w}; }
        }
    }
#undef IN
#undef SEAM
#undef SEAM_L
}
extern "C" void kernel_launch(void* const* d_in, const int* in_sizes, int n_in, void* d_out, int out_size, void* d_ws, size_t ws_size, hipStream_t stream) {
    static int grid = 0;
    if (grid == 0) {
        if (n_in != 13 || in_sizes[0] != T * D || out_size != T * D || ws_size < WS_END) { fprintf(stderr, "kernel_launch: bad arguments (n_in %d, out %d, ws %zu)\n", n_in, out_size, ws_size); grid = -1; return; }
        int dev = 0, cus = 0, per_cu = 0;
        if (hipGetDevice(&dev) != hipSuccess || hipDeviceGetAttribute(&cus, hipDeviceAttributeMultiprocessorCount, dev) != hipSuccess) { grid = -1; return; }
        if (hipFuncSetAttribute((const void*)mega, hipFuncAttributeMaxDynamicSharedMemorySize, LDS_BYTES) != hipSuccess) { fprintf(stderr, "kernel_launch: hipFuncSetAttribute failed\n"); grid = -1; return; }
        if (hipOccupancyMaxActiveBlocksPerMultiprocessor(&per_cu, (const void*)mega, NWAVES * 64, LDS_BYTES) != hipSuccess || per_cu < 1) { fprintf(stderr, "kernel_launch: occupancy query says %d\n", per_cu); grid = -1; (void)hipGetLastError(); return; }
        grid = cus;
    }
    if (grid < 0) return;
    (void)hipMemsetAsync((char*)d_ws + WS_CTL, 0, CTL_ZERO_BYTES, stream);
    Args a{};
    for (int i = 0; i < 13; ++i) a.in[i] = (const float*)d_in[i];
    a.out = (float*)d_out; a.ws = (unsigned char*)d_ws; a.ph_lo = 0; a.ph_hi = NPH; a.li = 0;
    hipLaunchKernelGGL(mega, dim3(grid), dim3(NWAVES * 64), LDS_BYTES, stream, a);
}
```

```cpp
#include <hip/hip_runtime.h>
#include <cstdio>
#include <cstdint>

constexpr int D = 1024, BATCH = 16, SEQ = 2048, DEPTH = 2, T = BATCH * SEQ;
constexpr int AH = 8, AHD = 64;
constexpr int RH = 4, RDK = 128, RDV = 256;
constexpr int DFF = 2816, DIN = 5888;
constexpr float EPS = 1e-6f;

typedef unsigned short bf16_t;
typedef unsigned u32x4 __attribute__((ext_vector_type(4)));
typedef float f32x4 __attribute__((ext_vector_type(4)));

constexpr size_t MiB = 1u << 20;
constexpr size_t WS_CTL = 0;
constexpr size_t WS_W = 2 * MiB;
constexpr size_t W_IN = 0, W_AO = W_IN + (size_t)DIN * D * 2, W_RO = W_AO + (size_t)D * 512 * 2, W_OUT = W_RO + (size_t)D * D * 2,
                 W_GU = W_OUT + (size_t)D * D * 2, W_DN = W_GU + (size_t)2 * DFF * D * 2, W_LAYER = W_DN + (size_t)D * DFF * 2;
static_assert(W_LAYER == 33 * MiB, "weights per layer");
constexpr size_t WS_XB = 68 * MiB;
constexpr size_t WS_SSP = 132 * MiB;
constexpr size_t WS_PATT = 134 * MiB;
constexpr size_t WS_PRET = 182 * MiB;
constexpr size_t WS_PRG = 310 * MiB;
constexpr size_t WS_PGA = 374 * MiB;
constexpr size_t WS_PGR = 438 * MiB;
constexpr size_t WS_SSP2 = 502 * MiB;
constexpr size_t WS_END = 504 * MiB;
constexpr size_t WS_ACT = WS_PRET;
constexpr size_t ACT_PANEL = (size_t)256 * DFF * 2;
static_assert(11 * ACT_PANEL <= 16 * MiB && 5 * ACT_PANEL <= 8 * MiB && WS_PRG == WS_PRET + 128 * MiB, "act panels");
__host__ __device__ __forceinline__ size_t act_panel_off(int pm) {
    const int x = pm >> 4, j = pm & 15;
    return j < 11 ? (size_t)x * (16 * MiB) + (size_t)j * ACT_PANEL : (WS_PRG - WS_PRET) + (size_t)x * (8 * MiB) + (size_t)(j - 11) * ACT_PANEL; }

__device__ __forceinline__ void st16_wt(void* p, u32x4 v) { asm volatile("global_store_dwordx4 %0, %1, off sc1\n\ts_nop 1" :: "v"(p), "v"(v) : "memory"); }
__device__ __forceinline__ float bf2f(bf16_t b) { return __uint_as_float(((unsigned)b) << 16); }
__device__ __forceinline__ unsigned f2bf(float f) { unsigned u = __float_as_uint(f); return (u + 0x7fffu + ((u >> 16) & 1u)) >> 16; }
typedef float f32x2_hw __attribute__((ext_vector_type(2)));
typedef __bf16 bf16x2_hw __attribute__((ext_vector_type(2)));
__device__ __forceinline__ unsigned pk2(float lo, float hi) { f32x2_hw v = {lo, hi}; bf16x2_hw b = __builtin_convertvector(v, bf16x2_hw); return __builtin_bit_cast(unsigned, b); }
__device__ __forceinline__ float sigmoidf_(float x) { return __builtin_amdgcn_rcpf(1.0f + __builtin_amdgcn_exp2f(x * -1.4426950408889634f)); }
__device__ __forceinline__ float wave_sum(float v) {
#pragma unroll
    for (int o = 1; o < 64; o <<= 1) v += __shfl_xor(v, o);
    return v;
}
__device__ __forceinline__ float wave_max(float v) {
#pragma unroll
    for (int o = 1; o < 64; o <<= 1) v = fmaxf(v, __shfl_xor(v, o));
    return v;
}
__device__ __forceinline__ u32x4 pack8(const float* v, float s) {
    u32x4 w; w.x = pk2(v[0] * s, v[1] * s); w.y = pk2(v[2] * s, v[3] * s); w.z = pk2(v[4] * s, v[5] * s); w.w = pk2(v[6] * s, v[7] * s); return w;
}
__device__ __forceinline__ void unpack8(u32x4 w, float* v) {
    v[0] = __uint_as_float(w.x << 16); v[1] = __uint_as_float(w.x & 0xffff0000u); v[2] = __uint_as_float(w.y << 16); v[3] = __uint_as_float(w.y & 0xffff0000u);
    v[4] = __uint_as_float(w.z << 16); v[5] = __uint_as_float(w.z & 0xffff0000u); v[6] = __uint_as_float(w.w << 16); v[7] = __uint_as_float(w.w & 0xffff0000u);
}

__device__ __forceinline__ void transpose_item(const float* W, int K, int N, const float* g, bf16_t* WT, float* scr, int k0, int n0, int orow0, int lane) {
    float v[32];
    const float* src = W + (size_t)(k0 + (lane >> 5)) * N + n0 + (lane & 31);
#pragma unroll
    for (int i = 0; i < 32; ++i) v[i] = src[(size_t)(2 * i) * N];
    if (g) {
#pragma unroll
        for (int i = 0; i < 32; ++i) v[i] *= g[k0 + 2 * i + (lane >> 5)];
    }
#pragma unroll
    for (int i = 0; i < 32; ++i) scr[(2 * i + (lane >> 5)) * 33 + (lane & 31)] = v[i];
    asm volatile("s_waitcnt lgkmcnt(0)" ::: "memory");
    const int c = lane & 7;
#pragma unroll
    for (int j = 0; j < 4; ++j) { const int n = (lane >> 3) + 8 * j; const float* s = scr + (8 * c) * 33 + n;
        u32x4 o; o.x = pk2(s[0 * 33], s[1 * 33]); o.y = pk2(s[2 * 33], s[3 * 33]); o.z = pk2(s[4 * 33], s[5 * 33]); o.w = pk2(s[6 * 33], s[7 * 33]);
        st16_wt(WT + (size_t)(orow0 + n) * K + k0 + 8 * c, o); }
    asm volatile("s_waitcnt lgkmcnt(0)" ::: "memory");
}
struct WPtrs { const float *norm_mix, *w_in, *w_ao, *w_ro, *w_out, *norm_ffn, *w_gate, *w_up, *w_dn, *gn_gain; };
constexpr int PRO_I_IN0 = (D / 64) * (DIN / 32);
constexpr int PRO_PER_LAYER = (D / 64) * (DIN / 32) + (512 / 64) * (D / 32) + 2 * (D / 64) * (D / 32) + 2 * (D / 64) * (DFF / 32) + (DFF / 64) * (D / 32);
__device__ __forceinline__ void prologue_weights(const WPtrs& P, unsigned char* ws, float* scr, int gw, int ngw, int lane, int it_lo = 0, int it_hi = 1 << 30) {
    constexpr int I_IN = (D / 64) * (DIN / 32), I_AO = (512 / 64) * (D / 32), I_SQ = (D / 64) * (D / 32), I_GU = (D / 64) * (DFF / 32), I_DN = (DFF / 64) * (D / 32);
    constexpr int PER_LAYER = I_IN + I_AO + 2 * I_SQ + 2 * I_GU + I_DN; static_assert(PER_LAYER == PRO_PER_LAYER, "item list");
    const int it_end = it_hi < DEPTH * PER_LAYER ? it_hi : DEPTH * PER_LAYER;
    for (int it = it_lo + gw; it < it_end; it += ngw) {
        const int l = it / PER_LAYER; int r = it % PER_LAYER;
        unsigned char* wl = ws + WS_W + (size_t)l * W_LAYER;
        if (r < I_IN) { const int nb = DIN / 32, kb = r / nb, n0 = 32 * (r % nb); transpose_item(P.w_in + (size_t)l * D * DIN, D, DIN, P.norm_mix + l * D, (bf16_t*)(wl + W_IN), scr, 64 * kb, n0, n0, lane); continue; } r -= I_IN;
        if (r < I_AO) { const int nb = D / 32, kb = r / nb, n0 = 32 * (r % nb); transpose_item(P.w_ao + (size_t)l * 512 * D, 512, D, nullptr, (bf16_t*)(wl + W_AO), scr, 64 * kb, n0, n0, lane); continue; } r -= I_AO;
        if (r < I_SQ) { const int nb = D / 32, kb = r / nb, n0 = 32 * (r % nb); transpose_item(P.w_ro + (size_t)l * D * D, D, D, P.gn_gain + l * D, (bf16_t*)(wl + W_RO), scr, 64 * kb, n0, n0, lane); continue; } r -= I_SQ;
        if (r < I_SQ) { const int nb = D / 32, kb = r / nb, n0 = 32 * (r % nb); transpose_item(P.w_out + (size_t)l * D * D, D, D, nullptr, (bf16_t*)(wl + W_OUT), scr, 64 * kb, n0, n0, lane); continue; } r -= I_SQ;
        if (r < I_GU) { const int nb = DFF / 32, kb = r / nb, n0 = 32 * (r % nb); transpose_item(P.w_gate + (size_t)l * D * DFF, D, DFF, P.norm_ffn + l * D, (bf16_t*)(wl + W_GU), scr, 64 * kb, n0, 256 * (n0 / 128) + 64 * ((n0 % 128) / 32), lane); continue; } r -= I_GU;
        if (r < I_GU) { const int nb = DFF / 32, kb = r / nb, n0 = 32 * (r % nb); transpose_item(P.w_up + (size_t)l * D * DFF, D, DFF, P.norm_ffn + l * D, (bf16_t*)(wl + W_GU), scr, 64 * kb, n0, 256 * (n0 / 128) + 64 * ((n0 % 128) / 32) + 32, lane); continue; } r -= I_GU;
        { const int nb = D / 32, kb = r / nb, n0 = 32 * (r % nb); transpose_item(P.w_dn + (size_t)l * DFF * D, DFF, D, nullptr, (bf16_t*)(wl + W_DN), scr, 64 * kb, n0, n0, lane); }
    }
}
typedef float f32x2p __attribute__((ext_vector_type(2)));
template <class RS> struct EpiAct {
    RS rs; bf16_t* act;
    __device__ __forceinline__ void apply8(int row, int col0, float s, const float* g, const float* u) const {
        const float s2 = s * -1.4426950408889634f, ss = s * s; u32x4 w; float e[8], o[8];
#pragma unroll
        for (int j = 0; j < 8; ++j) e[j] = __builtin_amdgcn_exp2f(g[j] * s2);
#pragma unroll
        for (int j = 0; j < 8; ++j) o[j] = (g[j] * u[j]) * ss;
#pragma unroll
        for (int j = 0; j < 8; ++j) e[j] = __builtin_amdgcn_rcpf(1.0f + e[j]);
#pragma unroll
        for (int j = 0; j < 8; ++j) o[j] *= e[j];
        w.x = pk2(o[0], o[1]); w.y = pk2(o[2], o[3]); w.z = pk2(o[4], o[5]); w.w = pk2(o[6], o[7]);
        st16_wt((bf16_t*)((unsigned char*)act + act_panel_off(row >> 8)) + (size_t)(row & 255) * DFF + col0, w);
    }
};
#define LAS __attribute__((address_space(3)))
#define GAS __attribute__((address_space(1)))
namespace mx {
typedef short bf16x8 __attribute__((ext_vector_type(8)));
typedef short s16x4 __attribute__((ext_vector_type(4)));
typedef float f32x16 __attribute__((ext_vector_type(16)));
typedef unsigned u32x2 __attribute__((ext_vector_type(2)));
typedef float f32x2_t __attribute__((ext_vector_type(2)));
typedef __bf16 bf16x2_t __attribute__((ext_vector_type(2)));
typedef short v4i16_t __attribute__((ext_vector_type(4)));
constexpr float LOG2E = 1.4426950408889634f;
#define MFMA32(a, b, c) __builtin_amdgcn_mfma_f32_32x32x16_bf16((a), (b), (c), 0, 0, 0)
__device__ __forceinline__ unsigned cvtpk(float lo, float hi) { f32x2_t v = {lo, hi}; bf16x2_t b = __builtin_convertvector(v, bf16x2_t); return __builtin_bit_cast(unsigned, b); }
template <int S> __device__ __forceinline__ bf16x8 pack_step(const f32x16& x) {
    u32x4 p; p.x = cvtpk(x[8 * S + 0], x[8 * S + 1]); p.y = cvtpk(x[8 * S + 2], x[8 * S + 3]); p.z = cvtpk(x[8 * S + 4], x[8 * S + 5]); p.w = cvtpk(x[8 * S + 6], x[8 * S + 7]);
    return __builtin_bit_cast(bf16x8, p);
}
__device__ __forceinline__ bf16x8 join4(s16x4 a, s16x4 b) { bf16x8 r; r[0] = a[0]; r[1] = a[1]; r[2] = a[2]; r[3] = a[3]; r[4] = b[0]; r[5] = b[1]; r[6] = b[2]; r[7] = b[3]; return r; }
__device__ __forceinline__ s16x4 tr_read(const LAS unsigned char* p) { return __builtin_bit_cast(s16x4, __builtin_amdgcn_ds_read_tr16_b64_v4i16((LAS v4i16_t*)p)); }
__device__ __forceinline__ f32x16 zero16() { f32x16 z;
#pragma unroll
    for (int i = 0; i < 16; ++i) z[i] = 0.f; return z; }
__device__ __forceinline__ constexpr int cr(int r) { return (r & 3) + 8 * (r >> 2); }

constexpr int AT_KP = 144, AT_VP = 192;
constexpr int AT_VOFF = 256 * AT_KP;
struct AttnStage { u32x4 kv[4], vv[4]; bf16x8 qn[2][4]; };
__device__ __forceinline__ void attn_load(AttnStage& S, const bf16_t* patt, int item, int tid) {
    const int kvh = item & 1, nb = (item >> 1) & 15, b = item >> 5;
    const int lane = tid & 63, w = __builtin_amdgcn_readfirstlane(tid >> 6), q = lane & 31, hh = lane >> 5, g = w & 3, qh = w >> 2;
    const bf16_t* tb = patt + ((size_t)b * SEQ + (size_t)nb * 128) * 768;
    const bf16_t* base = tb + 512 + kvh * 64;
    const int radd = nb == 0 ? 128 : 0;
#pragma unroll
    for (int i = 0; i < 4; ++i) { const int c = tid + 512 * i, row = c >> 3, ch = c & 7, re = row < 128 ? row + radd : row;
        const bf16_t* src = base + (re - 128) * 768 + ch * 8; S.kv[i] = *(const u32x4*)src; S.vv[i] = *(const u32x4*)(src + 128); }
#pragma unroll
    for (int sb = 0; sb < 2; ++sb)
#pragma unroll
        for (int ks = 0; ks < 4; ++ks) S.qn[sb][ks] = *(const bf16x8*)(tb + (unsigned)((64 * qh + 32 * sb + q) * 768 + kvh * 256 + (8 * g + 2 * ks + hh) * 8));
}
constexpr int AT_QOFF = AT_VOFF + 256 * AT_VP;
constexpr int AT_SINK_OFF = AT_QOFF + 65536;
__device__ __forceinline__ void attn_flush(LAS unsigned char* lds, bf16_t* aout, int item, int tid) {
    const int lane = tid & 63, w = __builtin_amdgcn_readfirstlane(tid >> 6), g = w & 3, qh = w >> 2;
    const int kvh = item & 1, nb = (item >> 1) & 15, b = item >> 5;
    const LAS unsigned char* Ob = lds + AT_QOFF + w * 8192;
    bf16_t* ob_ = aout + ((size_t)b * SEQ + (size_t)nb * 128 + 64 * qh) * 768 + kvh * 256 + g * 64;
    u32x4 yv[8]; const int r8 = lane >> 3, c8 = lane & 7;
#pragma unroll
    for (int i = 0; i < 8; ++i) { const int row = 8 * i + r8; yv[i] = *(const LAS u32x4*)(Ob + row * 128 + ((c8 ^ (row & 7)) << 4)); }
#pragma unroll
    for (int i = 0; i < 8; ++i) { const int row = 8 * i + r8; st16_wt(ob_ + (unsigned)(row * 768 + c8 * 8), yv[i]); }
}
__device__ __forceinline__ void attn_item(LAS unsigned char* lds, const bf16_t* patt, bf16_t* aout, int item, int next_item, int prev_item, AttnStage& S, int tid) {
    asm volatile("" : "+v"(tid));
    const int lane = tid & 63, w = __builtin_amdgcn_readfirstlane(tid >> 6), q = lane & 31, hh = lane >> 5;
    const int kvh = item & 1, nb = (item >> 1) & 15, b = item >> 5;
    const int g = w & 3, qh = w >> 2, h = kvh * 4 + g;
    const size_t tok0 = (size_t)b * SEQ + (size_t)nb * 128;
    LAS unsigned char* Kimg = lds; LAS unsigned char* Vimg = lds + AT_VOFF; LAS unsigned char* Ob = lds + AT_QOFF + w * 8192;
    bf16x8 qc[2][4];
#pragma unroll
    for (int sb = 0; sb < 2; ++sb)
#pragma unroll
        for (int ks = 0; ks < 4; ++ks) qc[sb][ks] = S.qn[sb][ks];
#pragma unroll
    for (int i = 0; i < 4; ++i) { const int c = tid + 512 * i, row = c >> 3, ch = c & 7;
        *(LAS u32x4*)(Kimg + row * AT_KP + ch * 16) = S.kv[i]; *(LAS u32x4*)(Vimg + row * AT_VP + ch * 16) = S.vv[i]; }
    asm volatile("s_waitcnt lgkmcnt(0)" ::: "memory"); __builtin_amdgcn_s_barrier(); asm volatile("" ::: "memory");
    attn_load(S, patt, next_item >= 0 ? next_item : item, tid);
    if (prev_item >= 0) attn_flush(lds, aout, prev_item, tid);
    const float c0s = 0.125f * LOG2E, slr = exp2f(-(float)(h + 1)) * 8.0f  , sink2 = ((const LAS float*)(lds + AT_SINK_OFF))[h] * LOG2E;
    const int q4 = (lane & 15) >> 2, p4 = lane & 3, blk = (lane >> 4) & 1;
#pragma unroll
    for (int sb = 0; sb < 2; ++sb) {
        const int jt0 = 2 * qh + sb;
        const unsigned orb = (unsigned)(32 * sb + q) * 128u, orx = (unsigned)(q & 7);
        int qm = q - 4 * hh; asm volatile("" : "+v"(qm));
        f32x16 sa[5];
#pragma unroll
        for (int u = 0; u < 5; ++u) {
            if (nb > 0 || jt0 + u >= 4) {
                const float offu = -slr * (float)(128 - 32 * u + qm);
#pragma unroll
                for (int r = 0; r < 16; ++r) sa[u][r] = offu + slr * (float)cr(r);
#pragma unroll
                for (int ks = 0; ks < 4; ++ks) { const bf16x8 kf = *(const LAS bf16x8*)(Kimg + (32 * (jt0 + u) + q) * AT_KP + (2 * ks + hh) * 16); sa[u] = MFMA32(kf, qc[sb][ks], sa[u]); }
            } else {
#pragma unroll
                for (int r = 0; r < 16; ++r) sa[u][r] = -INFINITY;
            }
        }
#pragma unroll
        for (int r = 0; r < 16; ++r) { sa[0][r] = (cr(r) > qm) ? sa[0][r] : -INFINITY; sa[4][r] = (cr(r) <= qm) ? sa[4][r] : -INFINITY; }
        float m = -INFINITY;
#pragma unroll
        for (int u = 0; u < 5; ++u)
#pragma unroll
            for (int r = 0; r < 16; ++r) m = fmaxf(m, sa[u][r]);
        m = fmaxf(m, __shfl_xor(m, 32)); const float mc = fmaxf(m * c0s, sink2);
        float l = 0.f;
#pragma unroll
        for (int u = 0; u < 5; ++u)
#pragma unroll
            for (int r = 0; r < 16; ++r) { const float p = __builtin_amdgcn_exp2f(__builtin_fmaf(sa[u][r], c0s, -mc)); sa[u][r] = p; l += p; }
        l += __shfl_xor(l, 32); l += __builtin_amdgcn_exp2f(sink2 - mc);
        f32x16 oa[2]; oa[0] = zero16(); oa[1] = zero16();
#pragma unroll
        for (int u = 0; u < 5; ++u) {
            if (nb > 0 || jt0 + u >= 4) {
                const bf16x8 pf0 = pack_step<0>(sa[u]), pf1 = pack_step<1>(sa[u]);
#pragma unroll
                for (int s2 = 0; s2 < 2; ++s2)
#pragma unroll
                    for (int dt = 0; dt < 2; ++dt) {
                        const LAS unsigned char* vp = Vimg + (32 * (jt0 + u) + 16 * s2 + 4 * hh + q4) * AT_VP + (32 * dt + 16 * blk + 4 * p4) * 2;
                        const bf16x8 vf = join4(tr_read(vp), tr_read(vp + 8 * AT_VP));
                        oa[dt] = MFMA32(vf, s2 == 0 ? pf0 : pf1, oa[dt]);
                    }
            }
        }
        const float inv = __builtin_amdgcn_rcpf(l);
#pragma unroll
        for (int dt = 0; dt < 2; ++dt)
#pragma unroll
            for (int g4 = 0; g4 < 4; ++g4) { u32x2 o; o.x = cvtpk(oa[dt][4 * g4] * inv, oa[dt][4 * g4 + 1] * inv); o.y = cvtpk(oa[dt][4 * g4 + 2] * inv, oa[dt][4 * g4 + 3] * inv);
                *(LAS u32x2*)(Ob + orb + ((((unsigned)(4 * dt + g4)) ^ orx) << 4) + 8 * hh) = o; }
    }
    asm volatile("s_waitcnt lgkmcnt(0)" ::: "memory"); __builtin_amdgcn_s_barrier(); asm volatile("" ::: "memory");
}

constexpr int QP = 272, KP = 320, VP = 512;
constexpr int RT_Q = 0, RT_KD = RT_Q + 128 * QP, RT_V = RT_KD + 128 * KP, RT_ST = RT_V + 128 * VP, RT_END = RT_ST + 8192;
__device__ __forceinline__ void ret_item(LAS unsigned char* lds, const bf16_t* pret, const bf16_t* prg, bf16_t* rout, const float* gain, int b, int h, int c0, int c1, int tid) {
    const int w = __builtin_amdgcn_readfirstlane(tid >> 6);
    LAS unsigned char* Qimg = lds + RT_Q; LAS unsigned char* KDimg = lds + RT_KD; LAS unsigned char* Vimg = lds + RT_V; LAS float* st = (LAS float*)(lds + RT_ST);
    const float lg = log2f(1.0f - exp2f(-5.0f - (float)h));
    const float g128 = exp2f(128.0f * lg), kbase = 0.08838834764831845f;
    const bf16_t* pb = pret + (size_t)b * SEQ * 2048 + h * 128;
    f32x16 state[4];
#pragma unroll
    for (int d = 0; d < 4; ++d) state[d] = zero16();
    u32x4 kr[4], qr[4];
#define RT_OFFS() const unsigned kqoff = (unsigned)(tid >> 4) * 2048u + (unsigned)(tid & 15) * 8u, voff = (unsigned)(tid >> 5) * 2048u + (unsigned)(tid & 31) * 8u
#define RT_LOAD_K(c) do { const bf16_t* cb_ = pb + (size_t)(c) * (128 * 2048) + 512; _Pragma("unroll") for (int i = 0; i < 4; ++i) kr[i] = *(const u32x4*)(cb_ + (size_t)i * (32 * 2048) + kqoff); } while (0)
#define RT_LOAD_Q(c) do { const bf16_t* cb_ = pb + (size_t)(c) * (128 * 2048); _Pragma("unroll") for (int i = 0; i < 4; ++i) qr[i] = *(const u32x4*)(cb_ + (size_t)i * (32 * 2048) + kqoff); } while (0)
#define RT_LOAD_V(c) do { const bf16_t* cb_ = pb + (size_t)(c) * (128 * 2048) + 1024 + h * 128; _Pragma("unroll") for (int i = 0; i < 8; ++i) vr[i] = *(const u32x4*)(cb_ + (size_t)i * (16 * 2048) + voff); } while (0)
#define RT_STORE_KD() do { _Pragma("unroll") for (int i = 0; i < 4; ++i) { const int cc = tid + 512 * i, row = cc >> 4, ch = cc & 15; float f[8]; unpack8(kr[i], f); const float sc = kbase * exp2f(lg * (float)(127 - row)); \
        u32x4 o_; o_.x = cvtpk(f[0] * sc, f[1] * sc); o_.y = cvtpk(f[2] * sc, f[3] * sc); o_.z = cvtpk(f[4] * sc, f[5] * sc); o_.w = cvtpk(f[6] * sc, f[7] * sc); *(LAS u32x4*)(KDimg + row * KP + ch * 16) = o_; } } while (0)
#define RT_STORE_Q() do { _Pragma("unroll") for (int i = 0; i < 4; ++i) { const int cc = tid + 512 * i, row = cc >> 4, ch = cc & 15; *(LAS u32x4*)(Qimg + row * QP + ch * 16) = qr[i]; } } while (0)
#define RT_STORE_V() do { _Pragma("unroll") for (int i = 0; i < 8; ++i) { const int cc = tid + 512 * i, row = cc >> 5, ch = cc & 31; *(LAS u32x4*)(Vimg + row * VP + ((ch ^ ((row & 3) << 2)) * 16)) = vr[i]; } } while (0)
    if (c0 > 0) {
    u32x4 vr[8];
    { asm volatile("" : "+v"(tid)); RT_OFFS(); RT_LOAD_K(0); RT_LOAD_V(0); }
    for (int c = 0; c < c0; ++c) {
        asm volatile("" : "+v"(tid));
        const int lane = tid & 63, hh = lane >> 5, q4 = (lane & 15) >> 2, p4 = lane & 3, blk = (lane >> 4) & 1;
        RT_STORE_KD(); RT_STORE_V();
        { const int cn = (c + 1 < c0) ? c + 1 : c; RT_OFFS(); RT_LOAD_K(cn); RT_LOAD_V(cn); }
        __syncthreads();
#pragma unroll
        for (int d = 0; d < 4; ++d)
#pragma unroll
            for (int r = 0; r < 16; ++r) state[d][r] *= g128;
        {
            const LAS unsigned char* vb = Vimg + (8 * hh + q4) * VP + ((4 * (w ^ q4) + 2 * blk) * 16 + 8 * p4);
            const LAS unsigned char* kb = KDimg + (8 * hh + q4) * KP + (16 * blk + 4 * p4) * 2;
            bf16x8 vf[2], kt[2][4];
#define RT_LDW(s_, b_) do { vf[b_] = join4(tr_read(vb + (16 * (s_)) * VP), tr_read(vb + (16 * (s_) + 4) * VP)); \
                _Pragma("unroll") for (int dkt = 0; dkt < 4; ++dkt) kt[b_][dkt] = join4(tr_read(kb + (16 * (s_)) * KP + 64 * dkt), tr_read(kb + (16 * (s_) + 4) * KP + 64 * dkt)); } while (0)
            RT_LDW(0, 0);
#pragma unroll
            for (int s = 0; s < 8; ++s) {
                if (s < 7) RT_LDW(s + 1, (s + 1) & 1);
#pragma unroll
                for (int dkt = 0; dkt < 4; ++dkt) state[dkt] = MFMA32(kt[s & 1][dkt], vf[s & 1], state[dkt]);
            }
#undef RT_LDW
        }
        __syncthreads();
    }
    }
    { asm volatile("" : "+v"(tid)); RT_OFFS(); RT_LOAD_K(c0); RT_LOAD_Q(c0); }
    __builtin_amdgcn_s_waitcnt(0x0070);
    for (int c = c0; c < c1; ++c) {
        const size_t tokc = (size_t)b * SEQ + (size_t)c * 128;
        asm volatile("" : "+v"(tid));
        const int lane = tid & 63, q = lane & 31, hh = lane >> 5, q4 = (lane & 15) >> 2, p4 = lane & 3, blk = (lane >> 4) & 1;
        RT_STORE_KD(); RT_STORE_Q();
        {
            const int vrow = 16 * w + (lane >> 5), vch = (lane & 31); const bf16_t* cb_ = pb + (size_t)c * (128 * 2048) + 1024 + h * 128;
#pragma unroll
            for (int i = 0; i < 8; ++i) { const int row = vrow + 2 * i, ch = vch ^ ((row & 3) << 2);
                __builtin_amdgcn_global_load_lds((const unsigned*)(cb_ + (unsigned)(row * 2048 + ch * 8)), (LAS unsigned*)(Vimg + (8 * w + i) * 1024), 16, 0, 0); }
        }
        asm volatile("s_waitcnt lgkmcnt(0)" ::: "memory"); __builtin_amdgcn_s_barrier(); asm volatile("" ::: "memory");
        f32x16 o[4];
        unsigned sp[2][8];
#pragma unroll
        for (int sl = 0; sl < 2; ++sl) {
            const int n = w + 8 * sl;
            if (n < 10) {
                const int it = n >= 6 ? 3 : (n >= 3 ? 2 : (n >= 1 ? 1 : 0)), jt = n - (it * (it + 1)) / 2;
                f32x16 a = zero16();
                {
                    const LAS unsigned char* kp1 = KDimg + (32 * jt + q) * KP + hh * 16; const LAS unsigned char* qp1 = Qimg + (32 * it + q) * QP + hh * 16;
                    bf16x8 kf[2], qq[2]; kf[0] = *(const LAS bf16x8*)kp1; qq[0] = *(const LAS bf16x8*)qp1;
#pragma unroll
                    for (int ks = 0; ks < 8; ++ks) { if (ks < 7) { kf[(ks + 1) & 1] = *(const LAS bf16x8*)(kp1 + 32 * (ks + 1)); qq[(ks + 1) & 1] = *(const LAS bf16x8*)(qp1 + 32 * (ks + 1)); }
                        a = MFMA32(kf[ks & 1], qq[ks & 1], a); }
                }
                const float fi = exp2f(lg * (float)(32 * it + q - 127));
#pragma unroll
                for (int r = 0; r < 16; ++r) { float v = a[r] * fi; if (it == jt && (cr(r) + 4 * hh > q)) v = 0.f; a[r] = v; }
#pragma unroll
                for (int g4 = 0; g4 < 4; ++g4) { sp[sl][2 * g4] = cvtpk(a[4 * g4], a[4 * g4 + 1]); sp[sl][2 * g4 + 1] = cvtpk(a[4 * g4 + 2], a[4 * g4 + 3]); }
            }
        }
#pragma unroll
        for (int it = 0; it < 4; ++it) o[it] = zero16();
        {
            const LAS unsigned char* qb3 = Qimg + q * QP + 8 * hh;
            bf16x8 bq[2][4];
#define RT_LD3(g_, b_) do { _Pragma("unroll") for (int it = 0; it < 4; ++it) bq[b_][it] = join4(*(const LAS s16x4*)(qb3 + (32 * it) * QP + 32 * (g_)), *(const LAS s16x4*)(qb3 + (32 * it) * QP + 32 * (g_) + 16)); } while (0)
            RT_LD3(0, 0);
#pragma unroll
            for (int g = 0; g < 8; ++g) {
                if (g < 7) RT_LD3(g + 1, (g + 1) & 1);
                const bf16x8 af = (g & 1) ? pack_step<1>(state[g >> 1]) : pack_step<0>(state[g >> 1]);
#pragma unroll
                for (int it = 0; it < 4; ++it) o[it] = MFMA32(af, bq[g & 1][it], o[it]);
            }
#undef RT_LD3
        }
        asm volatile("" ::: "memory"); __builtin_amdgcn_s_waitcnt(0x0070); __builtin_amdgcn_s_barrier(); asm volatile("" ::: "memory");
#pragma unroll
        for (int sl = 0; sl < 2; ++sl) {
            const int n = w + 8 * sl;
            if (n < 10) {
                const int it = n >= 6 ? 3 : (n >= 3 ? 2 : (n >= 1 ? 1 : 0)), jt = n - (it * (it + 1)) / 2;
#pragma unroll
                for (int g4 = 0; g4 < 4; ++g4) { u32x2 v; v.x = sp[sl][2 * g4]; v.y = sp[sl][2 * g4 + 1]; *(LAS u32x2*)(Qimg + (32 * it + q) * QP + (4 * jt + g4) * 16 + 8 * hh) = v; }
            }
        }
        __syncthreads();
        { const int cn = (c + 1 < c1) ? c + 1 : c; RT_OFFS(); RT_LOAD_K(cn); RT_LOAD_Q(cn); }
#pragma unroll
        for (int it = 0; it < 4; ++it) { const float gi = exp2f(lg * (float)(32 * it + q + 1));
#pragma unroll
            for (int r = 0; r < 16; ++r) o[it][r] *= gi; }
#pragma unroll
        for (int d = 0; d < 4; ++d)
#pragma unroll
            for (int r = 0; r < 16; ++r) state[d][r] *= g128;
        {
            const LAS unsigned char* vb = Vimg + (8 * hh + q4) * VP + ((4 * (w ^ q4) + 2 * blk) * 16 + 8 * p4);
            const LAS unsigned char* sb2 = Qimg + q * QP + hh * 16;
            bf16x8 vf[2], sf[2][4];
#define RT_LD2(s_, b_) do { vf[b_] = join4(tr_read(vb + (16 * (s_)) * VP), tr_read(vb + (16 * (s_) + 4) * VP)); \
                _Pragma("unroll") for (int it = 0; it < 4; ++it) if (2 * it + 1 >= (s_)) sf[b_][it] = *(const LAS bf16x8*)(sb2 + (32 * it) * QP + 32 * (s_)); } while (0)
            RT_LD2(0, 0);
#pragma unroll
            for (int s = 0; s < 8; ++s) {
                if (s < 7) RT_LD2(s + 1, (s + 1) & 1);
#pragma unroll
                for (int it = 0; it < 4; ++it) if (2 * it + 1 >= s) o[it] = MFMA32(vf[s & 1], sf[s & 1][it], o[it]);
            }
#undef RT_LD2
        }
        if (c < 15) {
            const LAS unsigned char* vb = Vimg + (8 * hh + q4) * VP + ((4 * (w ^ q4) + 2 * blk) * 16 + 8 * p4);
            const LAS unsigned char* kb = KDimg + (8 * hh + q4) * KP + (16 * blk + 4 * p4) * 2;
            bf16x8 vf[2], kt[2][4];
#define RT_LD4(s_, b_) do { vf[b_] = join4(tr_read(vb + (16 * (s_)) * VP), tr_read(vb + (16 * (s_) + 4) * VP)); \
                _Pragma("unroll") for (int dkt = 0; dkt < 4; ++dkt) kt[b_][dkt] = join4(tr_read(kb + (16 * (s_)) * KP + 64 * dkt), tr_read(kb + (16 * (s_) + 4) * KP + 64 * dkt)); } while (0)
            RT_LD4(0, 0);
#pragma unroll
            for (int s = 0; s < 8; ++s) {
                if (s < 7) RT_LD4(s + 1, (s + 1) & 1);
#pragma unroll
                for (int dkt = 0; dkt < 4; ++dkt) state[dkt] = MFMA32(kt[s & 1][dkt], vf[s & 1], state[dkt]);
            }
#undef RT_LD4
        }
        __syncthreads();
        {
            const int grow0 = 16 * w + (lane >> 5), gch = lane & 31; const bf16_t* gb_ = prg + tokc * 1024 + h * 256;
#pragma unroll
            for (int i = 0; i < 8; ++i) { const int row = grow0 + 2 * i, ch = gch ^ (row & 31);
                __builtin_amdgcn_global_load_lds((const unsigned*)(gb_ + (unsigned)(row * 1024 + ch * 8)), (LAS unsigned*)(Qimg + (8 * w + i) * 1024), 16, 0, 0); }
        }
        float mean[4], rstd[4];
#pragma unroll
        for (int it = 0; it < 4; ++it) { float ps = 0.f, pq = 0.f;
#pragma unroll
            for (int r = 0; r < 16; ++r) { ps += o[it][r]; pq += o[it][r] * o[it][r]; }
            ps += __shfl_xor(ps, 32); pq += __shfl_xor(pq, 32); if (hh == 0) { st[w * 128 + 32 * it + q] = ps; st[1024 + w * 128 + 32 * it + q] = pq; } }
        asm volatile("s_waitcnt lgkmcnt(0)" ::: "memory"); __builtin_amdgcn_s_barrier(); asm volatile("" ::: "memory");
#pragma unroll
        for (int it = 0; it < 4; ++it) { float s8 = 0.f, q8 = 0.f;
#pragma unroll
            for (int ww = 0; ww < 8; ++ww) { s8 += st[ww * 128 + 32 * it + q]; q8 += st[1024 + ww * 128 + 32 * it + q]; }
            mean[it] = s8 * (1.0f / 256.0f); rstd[it] = rsqrtf(fmaxf(q8 * (1.0f / 256.0f) - mean[it] * mean[it], 0.f) + EPS); }
        asm volatile("" ::: "memory"); __builtin_amdgcn_s_waitcnt(0x0070); __builtin_amdgcn_s_barrier(); asm volatile("" ::: "memory");
#pragma unroll
        for (int it = 0; it < 4; ++it) {
            const int row = 32 * it + q; const unsigned rbase = (unsigned)row * 512u, rx = (unsigned)(row & 31);
#pragma unroll
            for (int g4 = 0; g4 < 4; ++g4) {
                const unsigned c8 = (unsigned)(8 * w + 2 * g4 + hh);
                const unsigned off = rbase + (((c8 >> 1) ^ rx) << 4) + ((c8 & 1u) << 3);
                const u32x2 rw = *(const LAS u32x2*)(Qimg + off); const float ms = rstd[it];
                const float rg0 = __uint_as_float(rw.x << 16), rg1 = __uint_as_float(rw.x & 0xffff0000u), rg2 = __uint_as_float(rw.y << 16), rg3 = __uint_as_float(rw.y & 0xffff0000u);
                const float y0 = (o[it][4 * g4 + 0] - mean[it]) * ms * rg0, y1 = (o[it][4 * g4 + 1] - mean[it]) * ms * rg1;
                const float y2 = (o[it][4 * g4 + 2] - mean[it]) * ms * rg2, y3 = (o[it][4 * g4 + 3] - mean[it]) * ms * rg3;
                u32x2 ov; ov.x = cvtpk(y0, y1); ov.y = cvtpk(y2, y3); *(LAS u32x2*)(Vimg + off) = ov;
            }
        }
        asm volatile("s_waitcnt lgkmcnt(0)" ::: "memory"); __builtin_amdgcn_s_barrier(); asm volatile("" ::: "memory");
        {
            u32x4 yv[8]; bf16_t* ob_ = rout + tokc * 1024 + h * 256;
#pragma unroll
            for (int i = 0; i < 8; ++i) { const int cc = tid + 512 * i, row = cc >> 5, ch = cc & 31; yv[i] = *(const LAS u32x4*)(Vimg + row * 512 + ((ch ^ (row & 31)) << 4)); }
#pragma unroll
            for (int i = 0; i < 8; ++i) { const int cc = tid + 512 * i, row = cc >> 5, ch = cc & 31; st16_wt(ob_ + (unsigned)(row * 1024 + ch * 8), yv[i]); }
        }
        __syncthreads();
    }
#undef RT_OFFS
#undef RT_LOAD_K
#undef RT_LOAD_Q
#undef RT_LOAD_V
#undef RT_STORE_KD
#undef RT_STORE_Q
#undef RT_STORE_V
}
}

__device__ __forceinline__ int tid_from_wave(int wave) { unsigned z = 0u; asm volatile("" : "+v"(z));
    return wave * 64 + (int)__builtin_amdgcn_mbcnt_hi(~0u, __builtin_amdgcn_mbcnt_lo(~0u, z)); }
struct Args;
template <int WHAT  >
__device__ __forceinline__ void mixer_phase_impl(LAS unsigned char* lds, unsigned char* ws, const float* sinks, const float* gain, int bx, int G, bf16_t* aout, bf16_t* rout, int wave, bool consec) {
    const bf16_t* patt = (const bf16_t*)(ws + WS_PATT); const bf16_t* pret = (const bf16_t*)(ws + WS_PRET); const bf16_t* prg = (const bf16_t*)(ws + WS_PRG);
    int tid_ = tid_from_wave(wave); asm volatile("" : "+v"(tid_));
    const int tid = tid_;
    const int vcu = (G % 8 == 0) ? (bx % 8) * (G / 8) + bx / 8 : bx;
    if constexpr ((WHAT & 2) != 0)
    for (int it = vcu; it < BATCH * RH * 4; it += G) {
        const int bh = it >> 2, seg = it & 3, c0 = seg == 0 ? 0 : (seg == 1 ? 5 : (seg == 2 ? 9 : 13)), c1 = seg == 0 ? 5 : (seg == 1 ? 9 : (seg == 2 ? 13 : 16));
        mx::ret_item(lds, pret, prg, rout, gain, bh >> 2, bh & 3, c0, c1, tid);
    }
    if constexpr ((WHAT & 1) != 0)
    {
        if (tid < AH) ((LAS float*)(lds + mx::AT_SINK_OFF))[tid] = sinks[tid];
        const int NIT = BATCH * 16 * 2, npc = NIT / G, first = consec ? vcu * npc : vcu, step = consec ? 1 : G, last = consec ? first + npc : NIT;
        mx::AttnStage S; if (first < last) mx::attn_load(S, patt, first, tid);
        int prev = -1;
        for (int it = first; it < last; it += step) { mx::attn_item(lds, patt, aout, it, (it + step < last) ? it + step : -1, prev, S, tid); prev = it; }
        if (prev >= 0) mx::attn_flush(lds, aout, prev, tid);
    }
}


namespace pg8 {
typedef short bf16x8 __attribute__((ext_vector_type(8)));
constexpr int BM = 256, BK = 64, HALF = 128, HTB = HALF * BK * 2  , STAGE_BYTES = 8 * HTB, NXCD = 8;
#ifndef PG8_WGM
#define PG8_WGM 4
#endif
constexpr int WGM = PG8_WGM;
__host__ __device__ __forceinline__ int lds_byte(int r, int c) { const int st = (r >> 4) * 2 + (c >> 5), rr = r & 15, cc = c & 31, ob = rr * 64 + cc * 2; return st * 1024 + (ob ^ (((ob >> 9) & 1) << 5)); }
__host__ __device__ __forceinline__ void stage_rc(int b, int& R, int& C) { const int st = b / 1024, sb = b % 1024, swz = sb ^ (((sb >> 9) & 1) << 5); R = (st >> 1) * 16 + swz / 64; C = (st & 1) * 32 + (swz % 64) / 2; }
__host__ __device__ __forceinline__ int perm32(int rho) { const int n = rho >> 4, i = rho & 15; return 8 * (i >> 2) + 4 * n + (i & 3); }
struct Unit { int pm, pn; };
struct Gemm { const bf16_t* A; const bf16_t* Bt; int lda, ldb, M, N, K; bool apan = false; };
__device__ __forceinline__ const char* panelA(const Gemm& g, int pm, size_t tstepA) { return (const char*)g.A + (g.apan ? act_panel_off(pm) : (size_t)pm * tstepA); }
struct StaticOrder {
    int nM, nN, nwg, G, c;
    __host__ __device__ void init(int M, int N, int G_, int c_) { nM = M / BM; nN = N / BM; nwg = nM * nN; G = G_; c = c_; }
    __host__ __device__ bool next(int i, Unit& u) const {
        const long L = (long)i * G + c; if (L >= nwg) return false;
        int wgid = (int)L; { const int q = nwg / NXCD, r = nwg % NXCD, xcd = wgid % NXCD, off = wgid / NXCD; wgid = (xcd < r ? xcd * (q + 1) : r * (q + 1) + (xcd - r) * q) + off; }
        const int nig = WGM * nN, gid = wgid / nig, fm = gid * WGM, gsz = (nM - fm) < WGM ? (nM - fm) : WGM;
        u.pm = fm + ((wgid % nig) % gsz); u.pn = (wgid % nig) / gsz; return true;
    }
};
struct NoPre { __device__ __forceinline__ void operator()() const {} };
template <class Epi, class Sched, bool ALIGN_EPI, class Pre = NoPre>
__device__ __forceinline__ void gemm_phase(LAS unsigned char* lds, const Gemm g, const Sched& S, const Epi& E, int wave, const Pre& pre = Pre()) {
    int tid_ = tid_from_wave(wave); asm volatile("" : "+v"(tid_));
    int wid_ = wave; asm volatile("" : "+s"(wid_));
    const int tid = tid_, wid = wid_, lane = tid & 63, wr = wid >> 2, wc = wid & 3, fr = lane & 15, fq = lane >> 4;
    const int nt = g.K / BK;
#define KT(t) ((size_t)(t))
    unsigned voffA[2], voffB[2];
#pragma unroll
    for (int i = 0; i < 2; ++i) { int R, C; stage_rc(tid * 16 + i * 8192, R, C); const int Rb = 64 * (R >> 5) + perm32(R & 31);
        voffA[i] = (unsigned)(R * g.lda + C) * 2u; voffB[i] = (unsigned)(Rb * g.ldb + C) * 2u; }
    const size_t kstep = (size_t)(BK * 2);
    const size_t hstepA = (size_t)HALF * g.lda * 2, hstepB = (size_t)32 * g.ldb * 2, tstepA = 2 * hstepA, tstepB = (size_t)BM * g.ldb * 2;
    const unsigned ldsw = (unsigned)wid * 1024u;
    const int aoff = lds_byte(wr * 64 + fr, fq * 8), boff = lds_byte(wc * 32 + fr, fq * 8);
#define PG8_SA(b, h) (((b) * 2 + (h)) * HTB)
#define PG8_SB(b, h) ((4 + (b) * 2 + (h)) * HTB)
#define PG8_STAGE(bufoff, gbase, voff) do { _Pragma("unroll") for (int _i = 0; _i < 2; ++_i) \
        __builtin_amdgcn_global_load_lds((const unsigned*)((const char*)(gbase) + (voff)[_i]), (LAS unsigned*)(lds + (bufoff) + ldsw + _i * 8192), 16, 0, 0); } while (0)
#define PG8_LDA(dst, b, h) do { _Pragma("unroll") for (int m = 0; m < 4; ++m) _Pragma("unroll") for (int k = 0; k < 2; ++k) dst[m][k] = *(const LAS bf16x8*)(lds + PG8_SA(b, h) + aoff + m * 2048 + k * 1024); } while (0)
#define PG8_LDB(dst, b, h) do { _Pragma("unroll") for (int n = 0; n < 2; ++n) _Pragma("unroll") for (int k = 0; k < 2; ++k) dst[n][k] = *(const LAS bf16x8*)(lds + PG8_SB(b, h) + boff + n * 2048 + k * 1024); } while (0)
#define PG8_MMA(ai, bj, At, Bt) do { __builtin_amdgcn_s_setprio(1); _Pragma("unroll") for (int m = 0; m < 4; ++m) _Pragma("unroll") for (int n = 0; n < 2; ++n) _Pragma("unroll") for (int k = 0; k < 2; ++k) \
        acc[ai][bj][m][n] = __builtin_amdgcn_mfma_f32_16x16x32_bf16(Bt[n][k], At[m][k], acc[ai][bj][m][n], 0, 0, 0); __builtin_amdgcn_s_setprio(0); } while (0)
#define PG8_WAIT_V(n) asm volatile("s_waitcnt vmcnt(" #n ")" ::: "memory")
#define PG8_WAIT_L(n) asm volatile("s_waitcnt lgkmcnt(" #n ")" ::: "memory")
#define PG8_BAR __builtin_amdgcn_s_barrier()
#define PG8_SCHED __builtin_amdgcn_sched_barrier(0)
    Unit cur, nxt; int ui = 0;
    if (!S.next(0, cur)) return;
    f32x4 acc[2][2][4][2];
#pragma unroll
    for (int a = 0; a < 2; ++a)
#pragma unroll
        for (int b = 0; b < 2; ++b)
#pragma unroll
            for (int m = 0; m < 4; ++m)
#pragma unroll
                for (int n = 0; n < 2; ++n) acc[a][b][m][n] = (f32x4){0.f, 0.f, 0.f, 0.f};
    bf16x8 At[4][2], B0[2][2], B1[2][2];
    const char* cA = panelA(g, cur.pm, tstepA); const char* cB = (const char*)g.Bt + (size_t)cur.pn * tstepB;
    PG8_STAGE(PG8_SB(0, 0), cB, voffB); PG8_STAGE(PG8_SB(0, 1), cB + hstepB, voffB); PG8_STAGE(PG8_SA(0, 0), cA, voffA); PG8_STAGE(PG8_SA(0, 1), cA + hstepA, voffA);
    pre();
    if (wr == 1) PG8_BAR;
    PG8_WAIT_V(2); PG8_BAR;
    PG8_STAGE(PG8_SB(1, 0), cB + kstep, voffB); PG8_STAGE(PG8_SA(1, 0), cA + kstep, voffA); PG8_STAGE(PG8_SB(1, 1), cB + hstepB + kstep, voffB);
    PG8_WAIT_V(6); PG8_BAR;
    for (;;) {
        const bool has_next = S.next(ui + 1, nxt);
        const char* nA = has_next ? panelA(g, nxt.pm, tstepA) : cA; const char* nB = has_next ? (const char*)g.Bt + (size_t)nxt.pn * tstepB : cB;
        for (int t = 0; t < nt; t += 2) {
            const bool last = (t == nt - 2);
            const char* a1 = cA + KT(t + 1) * kstep;
            const char* a2 = last ? nA : cA + KT(t + 2) * kstep; const char* b2 = last ? nB : cB + KT(t + 2) * kstep;
            const char* a3 = last ? nA + kstep : cA + KT(t + 3) * kstep; const char* b3 = last ? nB + kstep : cB + KT(t + 3) * kstep;
            PG8_LDB(B0, 0, 0); PG8_LDB(B1, 0, 1); PG8_SCHED; PG8_LDA(At, 0, 0); PG8_STAGE(PG8_SA(1, 1), a1 + hstepA, voffA);
            PG8_WAIT_V(8); PG8_WAIT_L(0); PG8_BAR; PG8_MMA(0, 0, At, B0); PG8_MMA(0, 1, At, B1); PG8_BAR; PG8_SCHED;
            PG8_LDA(At, 0, 1); PG8_STAGE(PG8_SB(0, 0), b2, voffB); PG8_STAGE(PG8_SB(0, 1), b2 + hstepB, voffB); PG8_STAGE(PG8_SA(0, 0), a2, voffA);
            PG8_WAIT_V(8); PG8_WAIT_L(0); PG8_BAR; PG8_MMA(1, 0, At, B0); PG8_MMA(1, 1, At, B1); PG8_BAR; PG8_SCHED;
            PG8_LDB(B0, 1, 0); PG8_LDB(B1, 1, 1); PG8_SCHED; PG8_LDA(At, 1, 0); PG8_STAGE(PG8_SA(0, 1), a2 + hstepA, voffA);
            PG8_WAIT_V(8); PG8_WAIT_L(0); PG8_BAR; PG8_MMA(0, 0, At, B0); PG8_MMA(0, 1, At, B1); PG8_BAR; PG8_SCHED;
            PG8_LDA(At, 1, 1); PG8_STAGE(PG8_SB(1, 0), b3, voffB); PG8_STAGE(PG8_SB(1, 1), b3 + hstepB, voffB); PG8_STAGE(PG8_SA(1, 0), a3, voffA);
            PG8_WAIT_V(8); PG8_WAIT_L(0); PG8_BAR; PG8_MMA(1, 0, At, B0); PG8_MMA(1, 1, At, B1); PG8_BAR; PG8_SCHED;
        }
        if constexpr (ALIGN_EPI) { if (wr == 0) PG8_BAR; }
        E(acc, cur, wr, wc, fr, fq);
        if (!has_next) break;
#pragma unroll
        for (int a = 0; a < 2; ++a)
#pragma unroll
            for (int b = 0; b < 2; ++b)
#pragma unroll
                for (int m = 0; m < 4; ++m)
#pragma unroll
                    for (int n = 0; n < 2; ++n) acc[a][b][m][n] = (f32x4){0.f, 0.f, 0.f, 0.f};
        cur = nxt; cA = nA; cB = nB; ++ui;
        if constexpr (ALIGN_EPI) { if (wr == 1) PG8_BAR; }
    }
    PG8_WAIT_V(0);
    if constexpr (!ALIGN_EPI) { if (wr == 0) PG8_BAR; }
    PG8_BAR;
#undef KT
#undef PG8_SA
#undef PG8_SB
#undef PG8_STAGE
#undef PG8_LDA
#undef PG8_LDB
#undef PG8_MMA
#undef PG8_WAIT_V
#undef PG8_WAIT_L
#undef PG8_BAR
#undef PG8_SCHED
}
}

struct RsLds { const LAS float* tab; const LAS int* pml;
    __device__ __forceinline__ const LAS float* panel(int pm) const { const int p0 = pml[0], p1 = pml[1], p2 = pml[2]; const int slot = pm == p0 ? 0 : (pm == p1 ? 1 : (pm == p2 ? 2 : 3)); return tab + slot * 256; } };

template <int ACT  > __device__ __forceinline__ u32x4 proj_pack(const f32x4 a, const f32x4 b, float s) {
    const float v[8] = {a.x, a.y, a.z, a.w, b.x, b.y, b.z, b.w};
    if constexpr (ACT == 0) return pack8(v, s);
    else { const float s2 = s * -1.4426950408889634f; float e[8], o[8];
#pragma unroll
        for (int j = 0; j < 8; ++j) e[j] = __builtin_amdgcn_exp2f(v[j] * s2);
#pragma unroll
        for (int j = 0; j < 8; ++j) e[j] = __builtin_amdgcn_rcpf(1.0f + e[j]);
#pragma unroll
        for (int j = 0; j < 8; ++j) o[j] = ACT == 1 ? (v[j] * s) * e[j] : e[j];
        return pack8(o, 1.0f); }
}
template <int ACT> __device__ __forceinline__ void proj_rows(const f32x4 (&acc)[2][2][4][2], const LAS float* rt, LAS unsigned char* s, unsigned w0, unsigned w1, unsigned rd, bf16_t* tb, int ld, int r8, int c8) {
#pragma unroll
    for (int ai = 0; ai < 2; ++ai) {
        float sc[4];
#pragma unroll
        for (int m = 0; m < 4; ++m) sc[m] = rt[ai * 128 + m * 16];
#pragma unroll
        for (int mh = 0; mh < 2; ++mh) {
            u32x4 q[2][2];
#pragma unroll
            for (int mm = 0; mm < 2; ++mm) { const int m = 2 * mh + mm;
                *(LAS u32x4*)(s + w0) = proj_pack<ACT>(acc[ai][0][m][0], acc[ai][0][m][1], sc[m]);
                *(LAS u32x4*)(s + w1) = proj_pack<ACT>(acc[ai][1][m][0], acc[ai][1][m][1], sc[m]);
                q[mm][0] = *(const LAS u32x4*)(s + rd); q[mm][1] = *(const LAS u32x4*)(s + 1024 + rd); }
#pragma unroll
            for (int mm = 0; mm < 2; ++mm) { bf16_t* p = tb + (size_t)(ai * 128 + (2 * mh + mm) * 16 + r8) * ld + 8 * c8;
                st16_wt(p, q[mm][0]); st16_wt(p + (size_t)8 * ld, q[mm][1]); }
        }
    }
}
struct EpiProjT {
    static constexpr bool REPEATABLE = false;
    RsLds rs; bf16_t *patt, *pret, *prg, *pga, *pgr; LAS unsigned char* scr;
    __device__ __forceinline__ void operator()(const f32x4 (&acc)[2][2][4][2], const pg8::Unit& u, int wr, int wc, int fr, int fq) const {
        int lane_ = fq * 16 + fr; asm volatile("" : "+v"(lane_));
        const int wid = wr * 4 + wc, lane = lane_, r8 = lane >> 3, c8 = lane & 7; fr = lane & 15; fq = lane >> 4;
        LAS unsigned char* s = scr + wid * 2048;
        const int colw = u.pn * 256 + wc * 64; const size_t rowg = (size_t)u.pm * 256 + wr * 64;
        const unsigned w0 = (unsigned)fr * 128u + (((unsigned)fq ^ ((unsigned)fr & 7u)) << 4), w1 = (unsigned)fr * 128u + (((unsigned)(4 + fq) ^ ((unsigned)fr & 7u)) << 4);
        const unsigned rd = (unsigned)r8 * 128u + (((unsigned)c8 ^ (unsigned)r8) << 4);
        const LAS float* rt = rs.panel(u.pm) + wr * 64 + fr;
        if (colw < 768) proj_rows<0>(acc, rt, s, w0, w1, rd, patt + rowg * 768 + colw, 768, r8, c8);
        else if (colw < 2816) proj_rows<0>(acc, rt, s, w0, w1, rd, pret + rowg * 2048 + (colw - 768), 2048, r8, c8);
        else if (colw < 3840) proj_rows<1>(acc, rt, s, w0, w1, rd, prg + rowg * 1024 + (colw - 2816), 1024, r8, c8);
        else proj_rows<2>(acc, rt, s, w0, w1, rd, (colw < 4864 ? pga + (colw - 3840) : pgr + (colw - 4864)) + rowg * 1024, 1024, r8, c8);
    }
};
template <class Ap> struct Epi8Dual {
    static constexpr bool REPEATABLE = false; Ap ap;
    __device__ __forceinline__ void operator()(const f32x4 (&acc)[2][2][4][2], const pg8::Unit& u, int wr, int wc, int fr, int fq) const {
        const int row0 = u.pm * 256 + wr * 64 + fr, col0 = u.pn * 128 + wc * 32 + 8 * fq;
        const LAS float* rt = ap.rs.panel(u.pm); float sc[2][4];
#pragma unroll
        for (int ai = 0; ai < 2; ++ai)
#pragma unroll
            for (int m = 0; m < 4; ++m) sc[ai][m] = rt[ai * 128 + wr * 64 + m * 16 + fr];
#pragma unroll
        for (int ai = 0; ai < 2; ++ai)
#pragma unroll
            for (int m = 0; m < 4; ++m) { const f32x4 a = acc[ai][0][m][0], b = acc[ai][0][m][1], c = acc[ai][1][m][0], d = acc[ai][1][m][1];
                const float gv[8] = {a.x, a.y, a.z, a.w, b.x, b.y, b.z, b.w}, uv[8] = {c.x, c.y, c.z, c.w, d.x, d.y, d.z, d.w};
                ap.apply8(row0 + ai * 128 + m * 16, col0, sc[ai][m], gv, uv); }
    }
};
struct WaveTile {
    LAS unsigned char* s; unsigned w0, w1, rd; int r8, c8, fr, fq;
    __device__ __forceinline__ void init(LAS unsigned char* scr, int wr, int wc, int fr_, int fq_) {
        int lane_ = fq_ * 16 + fr_; asm volatile("" : "+v"(lane_));
        fr = lane_ & 15; fq = lane_ >> 4; r8 = lane_ >> 3; c8 = lane_ & 7; s = scr + (wr * 4 + wc) * 2048;
        w0 = (unsigned)fr * 128u + (((unsigned)fq ^ ((unsigned)fr & 7u)) << 4); w1 = (unsigned)fr * 128u + (((unsigned)(4 + fq) ^ ((unsigned)fr & 7u)) << 4);
        rd = (unsigned)r8 * 128u + (((unsigned)c8 ^ (unsigned)r8) << 4);
    }
    __device__ __forceinline__ void lines_to_acc(u32x4 l0, u32x4 l1, u32x4& a0, u32x4& a1) const { *(LAS u32x4*)(s + rd) = l0; *(LAS u32x4*)(s + 1024 + rd) = l1; a0 = *(const LAS u32x4*)(s + w0); a1 = *(const LAS u32x4*)(s + w1); }
    __device__ __forceinline__ void acc_to_lines(u32x4 a0, u32x4 a1, u32x4& l0, u32x4& l1) const { *(LAS u32x4*)(s + w0) = a0; *(LAS u32x4*)(s + w1) = a1; l0 = *(const LAS u32x4*)(s + rd); l1 = *(const LAS u32x4*)(s + 1024 + rd); }
};
struct EpiM1F {
    static constexpr bool REPEATABLE = false;
    const bf16_t* ga; bf16_t* m1; LAS unsigned char* scr;
    __device__ __forceinline__ void operator()(const f32x4 (&acc)[2][2][4][2], const pg8::Unit& u, int wr, int wc, int fr, int fq) const {
        WaveTile W; W.init(scr, wr, wc, fr, fq);
        const size_t base = ((size_t)u.pm * 256 + wr * 64 + W.r8) * 1024 + (u.pn * 256 + wc * 64) + 8 * W.c8;
#pragma unroll
        for (int ai = 0; ai < 2; ++ai)
#pragma unroll
            for (int mh = 0; mh < 2; ++mh) {
                u32x4 L[2][2];
#pragma unroll
                for (int mm = 0; mm < 2; ++mm) { const size_t o = base + (size_t)(ai * 128 + (2 * mh + mm) * 16) * 1024; L[mm][0] = *(const u32x4*)(ga + o); L[mm][1] = *(const u32x4*)(ga + o + 8 * 1024); }
#pragma unroll
                for (int mm = 0; mm < 2; ++mm) { const int m = 2 * mh + mm; u32x4 g0, g1, q0, q1; W.lines_to_acc(L[mm][0], L[mm][1], g0, g1);
                    float gv[8], o[8];
                    { unpack8(g0, gv); const f32x4 a = acc[ai][0][m][0], b = acc[ai][0][m][1]; const float v[8] = {a.x, a.y, a.z, a.w, b.x, b.y, b.z, b.w};
#pragma unroll
                      for (int j = 0; j < 8; ++j) o[j] = gv[j] * v[j];
                      g0 = pack8(o, 1.0f); }
                    { unpack8(g1, gv); const f32x4 a = acc[ai][1][m][0], b = acc[ai][1][m][1]; const float v[8] = {a.x, a.y, a.z, a.w, b.x, b.y, b.z, b.w};
#pragma unroll
                      for (int j = 0; j < 8; ++j) o[j] = gv[j] * v[j];
                      g1 = pack8(o, 1.0f); }
                    W.acc_to_lines(g0, g1, q0, q1);
                    const size_t oo = base + (size_t)(ai * 128 + m * 16) * 1024; *(u32x4*)(m1 + oo) = q0; *(u32x4*)(m1 + oo + 8 * 1024) = q1; }
            }
    }
};
struct EpiMrgF {
    static constexpr bool REPEATABLE = false;
    const bf16_t* gr; bf16_t* m1; LAS unsigned char* scr;
    __device__ __forceinline__ void operator()(const f32x4 (&acc)[2][2][4][2], const pg8::Unit& u, int wr, int wc, int fr, int fq) const {
        WaveTile W; W.init(scr, wr, wc, fr, fq);
        const size_t base = ((size_t)u.pm * 256 + wr * 64 + W.r8) * 1024 + (u.pn * 256 + wc * 64) + 8 * W.c8;
#pragma unroll
        for (int ai = 0; ai < 2; ++ai)
#pragma unroll
            for (int mh = 0; mh < 2; ++mh) {
                u32x4 L[2][2], M[2][2];
#pragma unroll
                for (int mm = 0; mm < 2; ++mm) { const size_t o = base + (size_t)(ai * 128 + (2 * mh + mm) * 16) * 1024;
                    L[mm][0] = *(const u32x4*)(gr + o); L[mm][1] = *(const u32x4*)(gr + o + 8 * 1024); M[mm][0] = *(const u32x4*)(m1 + o); M[mm][1] = *(const u32x4*)(m1 + o + 8 * 1024); }
#pragma unroll
                for (int mm = 0; mm < 2; ++mm) { const int m = 2 * mh + mm; u32x4 g0, g1, p0, p1, q0, q1; W.lines_to_acc(L[mm][0], L[mm][1], g0, g1); W.lines_to_acc(M[mm][0], M[mm][1], p0, p1);
                    float gv[8], mv[8], o[8];
                    { unpack8(g0, gv); unpack8(p0, mv); const f32x4 a = acc[ai][0][m][0], b = acc[ai][0][m][1]; const float v[8] = {a.x, a.y, a.z, a.w, b.x, b.y, b.z, b.w};
#pragma unroll
                      for (int j = 0; j < 8; ++j) o[j] = mv[j] + gv[j] * v[j];
                      g0 = pack8(o, 1.0f); }
                    { unpack8(g1, gv); unpack8(p1, mv); const f32x4 a = acc[ai][1][m][0], b = acc[ai][1][m][1]; const float v[8] = {a.x, a.y, a.z, a.w, b.x, b.y, b.z, b.w};
#pragma unroll
                      for (int j = 0; j < 8; ++j) o[j] = mv[j] + gv[j] * v[j];
                      g1 = pack8(o, 1.0f); }
                    W.acc_to_lines(g0, g1, q0, q1);
                    const size_t oo = base + (size_t)(ai * 128 + m * 16) * 1024; st16_wt(m1 + oo, q0); st16_wt(m1 + oo + 8 * 1024, q1); }
            }
    }
};
struct EpiResF {
    static constexpr bool REPEATABLE = false;
    bf16_t* xb; float* ssp; LAS unsigned char* scr;
    __device__ __forceinline__ void operator()(const f32x4 (&acc)[2][2][4][2], const pg8::Unit& u, int wr, int wc, int fr, int fq) const {
        WaveTile W; W.init(scr, wr, wc, fr, fq);
        const size_t base = ((size_t)u.pm * 256 + wr * 64 + W.r8) * D + (u.pn * 256 + wc * 64) + 8 * W.c8;
#pragma unroll
        for (int ai = 0; ai < 2; ++ai) {
            float ssm[4];
#pragma unroll
            for (int mh = 0; mh < 2; ++mh) {
                u32x4 L[2][2];
#pragma unroll
                for (int mm = 0; mm < 2; ++mm) { const size_t o = base + (size_t)(ai * 128 + (2 * mh + mm) * 16) * D; L[mm][0] = *(const u32x4*)(xb + o); L[mm][1] = *(const u32x4*)(xb + o + 8 * D); }
#pragma unroll
                for (int mm = 0; mm < 2; ++mm) { const int m = 2 * mh + mm; u32x4 b0, b1, q0, q1; W.lines_to_acc(L[mm][0], L[mm][1], b0, b1); float ss = 0.f;
                    { float x[8]; unpack8(b0, x); const f32x4 a = acc[ai][0][m][0], b = acc[ai][0][m][1];
                      x[0] += a.x; x[1] += a.y; x[2] += a.z; x[3] += a.w; x[4] += b.x; x[5] += b.y; x[6] += b.z; x[7] += b.w; b0 = pack8(x, 1.0f);
                      ss += (x[0] * x[0] + x[1] * x[1]) + (x[2] * x[2] + x[3] * x[3]) + (x[4] * x[4] + x[5] * x[5]) + (x[6] * x[6] + x[7] * x[7]); }
                    { float x[8]; unpack8(b1, x); const f32x4 a = acc[ai][1][m][0], b = acc[ai][1][m][1];
                      x[0] += a.x; x[1] += a.y; x[2] += a.z; x[3] += a.w; x[4] += b.x; x[5] += b.y; x[6] += b.z; x[7] += b.w; b1 = pack8(x, 1.0f);
                      ss += (x[0] * x[0] + x[1] * x[1]) + (x[2] * x[2] + x[3] * x[3]) + (x[4] * x[4] + x[5] * x[5]) + (x[6] * x[6] + x[7] * x[7]); }
                    ss += __shfl_xor(ss, 16); ss += __shfl_xor(ss, 32); ssm[m] = ss;
                    W.acc_to_lines(b0, b1, q0, q1);
                    const size_t oo = base + (size_t)(ai * 128 + m * 16) * D; st16_wt(xb + oo, q0); st16_wt(xb + oo + 8 * D, q1); }
            }
            { const float sel = W.fq == 0 ? ssm[0] : (W.fq == 1 ? ssm[1] : (W.fq == 2 ? ssm[2] : ssm[3]));
              ssp[((size_t)u.pm * 256 + wr * 64 + ai * 128 + W.fq * 16 + W.fr) * 16 + u.pn * 4 + wc] = sel; }
        }
    }
};

constexpr int NWAVES = 8;
constexpr int RING_OFF = 0, RING_BYTES = 131072;
constexpr int RS_OFF = RING_BYTES;
constexpr int EPI_OFF = RS_OFF + 4096;
constexpr int LDSCTL_OFF = 157696;   static_assert(LDSCTL_OFF >= mx::RT_END, "LDS map");
constexpr int LDS_BYTES = 158720;
constexpr size_t CTL_ZERO_BYTES = 131072;
constexpr int CW_BAR = 4096;
#define XB_TMO      128
#define XB_XCNT(j)  (256  + 64 * (j))
#define XB_XSUB(j)  (1280 + 64 * (j))
#define XB_XGEN(j)  (2304 + 64 * (j))
#define XB_TOP      3328
#define XB_TOPGEN   3392
#define XB_XLOC(j)  (3456 + 64 * (j))
#define XCD_BAR_WORDS 4480
#define XB_SPIN_CAP (1u << 22)
__device__ __forceinline__ unsigned xb_ld(unsigned* p)              { return __hip_atomic_load(p, __ATOMIC_RELAXED, __HIP_MEMORY_SCOPE_AGENT); }
__device__ __forceinline__ unsigned xb_add(unsigned* p, unsigned v) { return __hip_atomic_fetch_add(p, v, __ATOMIC_RELAXED, __HIP_MEMORY_SCOPE_AGENT); }
__device__ __forceinline__ unsigned xb_xcc_id() { return (unsigned)__builtin_amdgcn_s_getreg((3 << 11) | 20) & 0xFu; }
#define XB_SPIN(cond, bar) do { unsigned _sp = 0; while (cond) { __builtin_amdgcn_s_sleep(1); \
    if ((++_sp & 255u) == 0u) { if (xb_ld(&(bar)[XB_TMO])) break; if (_sp > XB_SPIN_CAP) { atomicAdd(&(bar)[XB_TMO], 1u); break; } } } } while (0)
struct XcdBarrier { unsigned* bar; unsigned x; volatile LAS unsigned* st; };
__device__ __forceinline__ XcdBarrier xcd_barrier_post(unsigned* bar, volatile LAS unsigned* st) {
    XcdBarrier b; b.bar = bar; b.x = xb_xcc_id(); b.st = st;
    if (threadIdx.x == 0) st[3] = xb_add(&bar[XB_XCNT(b.x)], 1u);
    return b;
}
__device__ __forceinline__ void xcd_barrier_complete(unsigned* bar, unsigned x, unsigned& nloc, unsigned& nx, unsigned& regular) {
    const unsigned G = gridDim.x * gridDim.y * gridDim.z;
    unsigned sum, cnt, mine, reg, sp = 0u;
    for (;;) {
        sum = 0u; cnt = 0u; mine = 0u; reg = (G % 8u == 0u) ? 1u : 0u;
#pragma unroll
        for (unsigned j = 0; j < 16; ++j) { const unsigned c = xb_ld(&bar[XB_XCNT(j)]); sum += c; cnt += (c > 0u) ? 1u : 0u; mine = (j == x) ? c : mine; reg = (c == (j < 8u ? G / 8u : 0u)) ? reg : 0u; }
        if (sum == G) break;
        __builtin_amdgcn_s_sleep(1);
        if ((++sp & 255u) == 0u) { if (xb_ld(&bar[XB_TMO])) break; if (sp > XB_SPIN_CAP) { atomicAdd(&bar[XB_TMO], 1u); break; } }
    }
    nloc = mine > 0u ? mine : 1u; nx = cnt > 0u ? cnt : 1u; regular = reg;
}
__device__ __forceinline__ void xcd_barrier(const XcdBarrier& b, int wave, bool local = false) {
    asm volatile("s_waitcnt vmcnt(0)" ::: "memory");
    __syncthreads();
    if (tid_from_wave(wave) == 0) {
        unsigned* bar = b.bar;
        __builtin_amdgcn_s_waitcnt(0);
        unsigned nloc = b.st[0], nx = b.st[1];
        if (nloc == 0u) { unsigned reg; xcd_barrier_complete(bar, b.x, nloc, nx, reg); b.st[0] = nloc; b.st[1] = nx; b.st[2] = reg; }
        if (local) {
            const unsigned kl = b.st[4]; b.st[4] = kl + 1u;
            __builtin_amdgcn_fence(__ATOMIC_ACQUIRE, "agent");
            (void)xb_add(&bar[XB_XLOC(b.x)], 1u);
            { const unsigned target = (kl + 1u) * nloc; XB_SPIN(xb_ld(&bar[XB_XLOC(b.x)]) < target, bar); }
            asm volatile("s_waitcnt vmcnt(0)" ::: "memory");
        } else {
        const unsigned old = xb_add(&bar[XB_XSUB(b.x)], 1u);
        const unsigned gen = old / nloc;
        if (old + 1u == (gen + 1u) * nloc) {
            __builtin_amdgcn_fence(__ATOMIC_RELEASE, "agent"); asm volatile("s_waitcnt vmcnt(0)" ::: "memory");
            {
                const unsigned og = xb_add(&bar[XB_TOP], 1u);
                const unsigned tg = og / nx;
                __builtin_amdgcn_fence(__ATOMIC_ACQUIRE, "agent");
                if (og + 1u == (tg + 1u) * nx) xb_add(&bar[XB_TOPGEN], 1u);
                else XB_SPIN(xb_ld(&bar[XB_TOPGEN]) == tg, bar);
            }
            xb_add(&bar[XB_XGEN(b.x)], 1u);
            asm volatile("s_waitcnt vmcnt(0)" ::: "memory");
        } else {
            __builtin_amdgcn_fence(__ATOMIC_ACQUIRE, "agent");
            XB_SPIN(xb_ld(&bar[XB_XGEN(b.x)]) == gen, bar);
            asm volatile("s_waitcnt vmcnt(0)" ::: "memory");
        }
        }
    }
    __syncthreads();
}

template <class Sched>
__device__ __forceinline__ void build_rstd_table(LAS unsigned char* lds, const Sched& S, const float* ssp, int wave) {
    LAS float* tab = (LAS float*)(lds + RS_OFF); volatile LAS int* pml = (volatile LAS int*)(lds + LDSCTL_OFF);
    int p0 = -1, p1 = -1, p2 = -1, p3 = -1; pg8::Unit u;
    for (int i = 0; S.next(i, u); ++i) { const int pm = u.pm; if (pm == p0 || pm == p1 || pm == p2 || pm == p3) continue;
        if (p0 < 0) p0 = pm; else if (p1 < 0) p1 = pm; else if (p2 < 0) p2 = pm; else if (p3 < 0) p3 = pm; }
    int t0_ = tid_from_wave(wave); asm volatile("" : "+v"(t0_));
    if (t0_ == 0) { pml[0] = p0; pml[1] = p1; pml[2] = p2; pml[3] = p3; }
    for (int idx = t0_; idx < 1024; idx += NWAVES * 64) { const int slot = idx >> 8; const int pm = slot == 0 ? p0 : (slot == 1 ? p1 : (slot == 2 ? p2 : p3));
        if (pm >= 0) { const f32x4* q = (const f32x4*)(ssp + (size_t)(pm * 256 + (idx & 255)) * 16); const f32x4 a = q[0], b = q[1], c = q[2], d = q[3];
            const float s = ((a.x + a.y) + (a.z + a.w)) + ((b.x + b.y) + (b.z + b.w)) + ((c.x + c.y) + (c.z + c.w)) + ((d.x + d.y) + (d.z + d.w));
            tab[idx] = rsqrtf(s * (1.0f / D) + EPS); } }
    __syncthreads();
}

__device__ __forceinline__ void st4_wt(void* p, float v) { asm volatile("global_store_dword %0, %1, off sc0 sc1\n\ts_nop 1" :: "v"(p), "v"(v) : "memory"); }
__device__ __forceinline__ void ld16x8_sys(f32x4 (&v)[8], const float* const (&p)[8]) {
    asm volatile("global_load_dwordx4 %0, %8, off sc0 sc1\n\tglobal_load_dwordx4 %1, %9, off sc0 sc1\n\tglobal_load_dwordx4 %2, %10, off sc0 sc1\n\tglobal_load_dwordx4 %3, %11, off sc0 sc1\n\t"
                 "global_load_dwordx4 %4, %12, off sc0 sc1\n\tglobal_load_dwordx4 %5, %13, off sc0 sc1\n\tglobal_load_dwordx4 %6, %14, off sc0 sc1\n\tglobal_load_dwordx4 %7, %15, off sc0 sc1\n\t"
                 "s_waitcnt vmcnt(0)"
                 : "=&v"(v[0]), "=&v"(v[1]), "=&v"(v[2]), "=&v"(v[3]), "=&v"(v[4]), "=&v"(v[5]), "=&v"(v[6]), "=&v"(v[7])
                 : "v"(p[0]), "v"(p[1]), "v"(p[2]), "v"(p[3]), "v"(p[4]), "v"(p[5]), "v"(p[6]), "v"(p[7]) : "memory"); }
constexpr int CW_CONV = 18432;
constexpr int CW_FIN = 16384;
struct EpiFinal {
    static constexpr bool REPEATABLE = false;
    const bf16_t* xb; float* ssp; const float* gfin; float* out; unsigned* cnt; LAS unsigned char* scr;
    __device__ __forceinline__ void operator()(f32x4 (&acc)[2][2][4][2], const pg8::Unit& u, int wr, int wc, int fr_, int fq_) const {
        WaveTile W; W.init(scr, wr, wc, fr_, fq_);
        const int fr = W.fr, fq = W.fq;
        const size_t rowb = (size_t)u.pm * 256 + wr * 64; const int colb = u.pn * 256 + wc * 64;
        const size_t base = (rowb + W.r8) * D + colb + 8 * W.c8;
#pragma unroll
        for (int ai = 0; ai < 2; ++ai) {
            float ssm[4];
#pragma unroll
            for (int mh = 0; mh < 2; ++mh) {
                u32x4 L[2][2];
#pragma unroll
                for (int mm = 0; mm < 2; ++mm) { const size_t o = base + (size_t)(ai * 128 + (2 * mh + mm) * 16) * D; L[mm][0] = *(const u32x4*)(xb + o); L[mm][1] = *(const u32x4*)(xb + o + 8 * D); }
#pragma unroll
                for (int mm = 0; mm < 2; ++mm) { const int m = 2 * mh + mm; u32x4 b0, b1; W.lines_to_acc(L[mm][0], L[mm][1], b0, b1); float ss = 0.f;
#pragma unroll
                    for (int bj = 0; bj < 2; ++bj) { float x[8]; unpack8(bj == 0 ? b0 : b1, x); f32x4& a = acc[ai][bj][m][0]; f32x4& b = acc[ai][bj][m][1];
                        a.x += x[0]; a.y += x[1]; a.z += x[2]; a.w += x[3]; b.x += x[4]; b.y += x[5]; b.z += x[6]; b.w += x[7];
                        ss += (a.x * a.x + a.y * a.y) + (a.z * a.z + a.w * a.w) + (b.x * b.x + b.y * b.y) + (b.z * b.z + b.w * b.w); }
                    ss += __shfl_xor(ss, 16); ss += __shfl_xor(ss, 32); ssm[m] = ss; }
            }
            const float sel = fq == 0 ? ssm[0] : (fq == 1 ? ssm[1] : (fq == 2 ? ssm[2] : ssm[3]));
            st4_wt(ssp + (rowb + ai * 128 + fq * 16 + fr) * 16 + u.pn * 4 + wc, sel);
        }
        asm volatile("s_waitcnt vmcnt(0)" ::: "memory");
        unsigned* c = cnt + u.pm * 16;
        if (fr_ == 0 && fq_ == 0) (void)xb_add(c, 1u);
        { unsigned sp = 0; while (xb_ld(c) < 32u) { __builtin_amdgcn_s_sleep(1); if (++sp > XB_SPIN_CAP) break; } }
        float rs[2][4]; f32x4 pp[8]; const float* pa[8];
#pragma unroll
        for (int i = 0; i < 8; ++i) pa[i] = ssp + (rowb + (i >> 2) * 128 + (i & 3) * 16 + fr) * 16 + 4 * fq;
        ld16x8_sys(pp, pa);
#pragma unroll
        for (int i = 0; i < 8; ++i) { const f32x4 p = pp[i]; float t = (p.x + p.y) + (p.z + p.w); t += __shfl_xor(t, 16); t += __shfl_xor(t, 32); rs[i >> 2][i & 3] = rsqrtf(t * (1.0f / D) + EPS); }
        const unsigned v0 = (unsigned)fr * 128u + ((((unsigned)(2 * fq)) ^ ((unsigned)fr & 7u)) << 4), v1 = (unsigned)fr * 128u + ((((unsigned)(2 * fq + 1)) ^ ((unsigned)fr & 7u)) << 4);
#pragma unroll
        for (int bj = 0; bj < 2; ++bj) {
            const f32x4 g0 = *(const f32x4*)(gfin + colb + 32 * bj + 8 * fq), g1 = *(const f32x4*)(gfin + colb + 32 * bj + 8 * fq + 4);
            float* ob = out + (rowb + W.r8) * D + colb + 32 * bj + 4 * W.c8;
#pragma unroll
            for (int ai = 0; ai < 2; ++ai)
#pragma unroll
                for (int m = 0; m < 4; ++m) { const float r = rs[ai][m]; const f32x4 a = acc[ai][bj][m][0], b = acc[ai][bj][m][1];
                    *(LAS f32x4*)(W.s + v0) = (f32x4){a.x * r * g0.x, a.y * r * g0.y, a.z * r * g0.z, a.w * r * g0.w};
                    *(LAS f32x4*)(W.s + v1) = (f32x4){b.x * r * g1.x, b.y * r * g1.y, b.z * r * g1.z, b.w * r * g1.w};
                    const f32x4 q0 = *(const LAS f32x4*)(W.s + W.rd), q1 = *(const LAS f32x4*)(W.s + 1024 + W.rd);
                    float* o = ob + (size_t)(ai * 128 + m * 16) * D; *(f32x4*)o = q0; *(f32x4*)(o + (size_t)8 * D) = q1; }
        }
    }
};

struct RstdPre { LAS unsigned char* lds; const pg8::StaticOrder* S; const float* ssp; int wave;
    __device__ __forceinline__ void operator()() const { build_rstd_table(lds, *S, ssp, wave); } };
constexpr int PH_PRO = 0, PH_FIN = 1 + 6 * DEPTH, NPH = PH_FIN + 1;
struct Args { const float* in[13]; float* out; unsigned char* ws; int ph_lo, ph_hi, li, pad; };
__global__ void __launch_bounds__(NWAVES * 64, 2) mega(Args args) {
    extern __shared__ __attribute__((aligned(16))) unsigned char lds_raw[];
    LAS unsigned char* lds = (LAS unsigned char*)lds_raw;
    const int tid = threadIdx.x, wave = __builtin_amdgcn_readfirstlane(tid >> 6);
    const int G = gridDim.x, bx = blockIdx.x, vcu = (G % 8 == 0) ? (bx % 8) * (G / 8) + bx / 8 : bx;
    unsigned char* ws = args.ws;
    for (int u = tid; u < 512 / 4; u += NWAVES * 64) ((LAS unsigned*)(lds + LDSCTL_OFF))[u] = 0u;
    __syncthreads();
    XcdBarrier bar = xcd_barrier_post((unsigned*)(ws + WS_CTL) + CW_BAR + args.li * XCD_BAR_WORDS, (volatile LAS unsigned*)(lds + LDSCTL_OFF) + 8);
    float* xf = args.out; bf16_t* xb = (bf16_t*)(ws + WS_XB); float* ssp = (float*)(ws + WS_SSP);
    bf16_t* patt = (bf16_t*)(ws + WS_PATT); bf16_t* pret = (bf16_t*)(ws + WS_PRET); bf16_t* prg = (bf16_t*)(ws + WS_PRG);
    bf16_t* pga = (bf16_t*)(ws + WS_PGA); bf16_t* pgr = (bf16_t*)(ws + WS_PGR); bf16_t* m1 = pga  ; bf16_t* act = (bf16_t*)(ws + WS_ACT);
    const int gw = vcu * NWAVES + wave, ngw = G * NWAVES;
    const RsLds rs{(const LAS float*)(lds + RS_OFF), (const LAS int*)(lds + LDSCTL_OFF)};

    const int lo = args.ph_lo, hi = args.ph_hi;
    const bool full = lo == 0 && hi == NPH;
    const bool fuse_fin = (G % 128 == 0) && full;
#define IN(k) (lo <= (k) && (k) < hi)
#define SEAM(k) do { if (IN(k) && IN((k) + 1)) xcd_barrier(bar, wave); } while (0)
#define SEAM_L(k) do { if (IN(k) && IN((k) + 1)) xcd_barrier(bar, wave, xl); } while (0)
    if (IN(PH_PRO)) {
        int tl_ = tid_from_wave(wave); asm volatile("" : "+v"(tl_)); const int lane = tl_ & 63;
        WPtrs P{args.in[1], args.in[2], args.in[5], args.in[6], args.in[7], args.in[8], args.in[9], args.in[10], args.in[11], args.in[4]};
        prologue_weights(P, ws, (float*)(lds_raw + wave * 16384), gw, ngw, lane, 0, PRO_I_IN0);
        const float* x = args.in[0];
        for (int t0 = gw * 4; t0 < T; t0 += ngw * 4) {
            f32x4 v[4][4];
#pragma unroll
            for (int rr = 0; rr < 4; ++rr) { const f32x4* xr = (const f32x4*)(x + (size_t)(t0 + rr) * D) + lane;
#pragma unroll
                for (int j = 0; j < 4; ++j) v[rr][j] = xr[64 * j]; }
#pragma unroll
            for (int rr = 0; rr < 4; ++rr) { const int t = t0 + rr; float s = 0.f;
#pragma unroll
                for (int j = 0; j < 4; ++j) s += (v[rr][j].x * v[rr][j].x + v[rr][j].y * v[rr][j].y) + (v[rr][j].z * v[rr][j].z + v[rr][j].w * v[rr][j].w);
                s = wave_sum(s);
                unsigned long long* o8 = (unsigned long long*)(xb + (size_t)t * D) + lane;
#pragma unroll
                for (int j = 0; j < 4; ++j) o8[64 * j] = (unsigned long long)pk2(v[rr][j].x, v[rr][j].y) | ((unsigned long long)pk2(v[rr][j].z, v[rr][j].w) << 32);
                if (lane < 16) ssp[(size_t)t * 16 + lane] = lane == 0 ? s : 0.f; }
        }
    }
    SEAM(PH_PRO);
    const bool xl = (G == 256) && (((volatile LAS unsigned*)(lds + LDSCTL_OFF))[10] != 0u);
    const int vb = xl ? (int)(((volatile LAS unsigned*)(lds + LDSCTL_OFF))[11] * 8u + bar.x) : bx;
    for (int l = 0; l < DEPTH; ++l) {
        const int pb = 1 + 6 * l;
        const unsigned char* wl = ws + WS_W + (size_t)l * W_LAYER;
        if (IN(pb + 0)) {
            pg8::StaticOrder S; S.init(T, DIN, G, vb);
            const pg8::Gemm g{xb, (const bf16_t*)(wl + W_IN), D, D, T, DIN, D};
            const EpiProjT E{rs, patt, pret, prg, pga, pgr, lds + EPI_OFF};
            pg8::gemm_phase<EpiProjT, pg8::StaticOrder, true>(lds + RING_OFF, g, S, E, wave, RstdPre{lds, &S, ssp, wave});
            if (2 * vb >= G) {
                int tl_ = tid_from_wave(wave); asm volatile("" : "+v"(tl_));
                WPtrs P{args.in[1], args.in[2], args.in[5], args.in[6], args.in[7], args.in[8], args.in[9], args.in[10], args.in[11], args.in[4]};
                prologue_weights(P, ws, (float*)(lds_raw + wave * 16384), (vb - G / 2) * NWAVES + wave, (G - G / 2) * NWAVES, tl_ & 63,
                                 l == 0 ? PRO_I_IN0 : PRO_PER_LAYER + PRO_I_IN0, l == 0 ? PRO_PER_LAYER + PRO_I_IN0 : 2 * PRO_PER_LAYER);
                asm volatile("s_waitcnt vmcnt(0)" ::: "memory");
                if ((tl_ & 63) == 0) (void)xb_add((unsigned*)(ws + WS_CTL) + CW_CONV + 16 * l, 1u);
            }
        }
        if (IN(pb + 0) && IN(pb + 1)) xcd_barrier(bar, wave, xl && full);
        if (IN(pb + 1)) mixer_phase_impl<3>(lds, ws, args.in[3] + l * AH, args.in[4] + l * RH * RDV, vb, G, patt, prg, wave, xl);
        if (full && IN(pb + 1) && IN(pb + 2) && tid_from_wave(wave) == 0) { unsigned* cw = (unsigned*)(ws + WS_CTL) + CW_CONV + 16 * l; const unsigned need = (unsigned)((G - G / 2) * NWAVES);
            unsigned sp = 0; while (xb_ld(cw) < need) { __builtin_amdgcn_s_sleep(1); if (++sp > XB_SPIN_CAP) break; } }
        SEAM_L(pb + 1);
        if (IN(pb + 2)) {
            pg8::StaticOrder S; S.init(T, D, G, vb);
            { const pg8::Gemm g{patt, (const bf16_t*)(wl + W_AO), 768, 512, T, D, 512}; const EpiM1F E{pga, m1, lds + EPI_OFF};
              pg8::gemm_phase<EpiM1F, pg8::StaticOrder, true>(lds + RING_OFF, g, S, E, wave); }
            { const pg8::Gemm g{prg, (const bf16_t*)(wl + W_RO), D, D, T, D, D}; const EpiMrgF E{pgr, m1, lds + EPI_OFF};
              pg8::gemm_phase<EpiMrgF, pg8::StaticOrder, true>(lds + RING_OFF, g, S, E, wave); }
        }
        SEAM_L(pb + 2);
        if (IN(pb + 3)) {
            pg8::StaticOrder S; S.init(T, D, G, vb);
            const pg8::Gemm g{m1, (const bf16_t*)(wl + W_OUT), D, D, T, D, D}; const EpiResF E{xb, ssp, lds + EPI_OFF};
            pg8::gemm_phase<EpiResF, pg8::StaticOrder, true>(lds + RING_OFF, g, S, E, wave);
        }
        SEAM_L(pb + 3);
        if (IN(pb + 4)) {
            pg8::StaticOrder S; S.init(T, 2 * DFF, G, vb);
            const pg8::Gemm g{xb, (const bf16_t*)(wl + W_GU), D, D, T, 2 * DFF, D}; const Epi8Dual<EpiAct<RsLds>> E{{rs, act}};
            pg8::gemm_phase<Epi8Dual<EpiAct<RsLds>>, pg8::StaticOrder, true>(lds + RING_OFF, g, S, E, wave, RstdPre{lds, &S, ssp, wave});
        }
        SEAM_L(pb + 4);
        if (IN(pb + 5)) {
            pg8::StaticOrder S; S.init(T, D, G, vb);
            const pg8::Gemm g{act, (const bf16_t*)(wl + W_DN), DFF, DFF, T, D, DFF, true};
            if (l == DEPTH - 1 && fuse_fin) { const EpiFinal E{xb, (float*)(ws + WS_SSP2), args.in[12], xf, (unsigned*)(ws + WS_CTL) + CW_FIN, lds + EPI_OFF};
                pg8::gemm_phase<EpiFinal, pg8::StaticOrder, true>(lds + RING_OFF, g, S, E, wave); }
            else { const EpiResF E{xb, ssp, lds + EPI_OFF};
                pg8::gemm_phase<EpiResF, pg8::StaticOrder, true>(lds + RING_OFF, g, S, E, wave); }
        }
        if (l < DEPTH - 1) SEAM_L(pb + 5); else if (!fuse_fin) SEAM(pb + 5);
    }
    if (IN(PH_FIN) && !fuse_fin) {
        int tl_ = tid_from_wave(wave); asm volatile("" : "+v"(tl_)); const int lane = tl_ & 63;
        const float* g = args.in[12];
        for (int t = gw; t < T; t += ngw) {
            const u32x4* xr = (const u32x4*)(xb + (size_t)t * D) + lane; u32x4 w[2]; float v[2][8]; float s = 0.f;
#pragma unroll
            for (int j = 0; j < 2; ++j) { w[j] = xr[64 * j]; unpack8(w[j], v[j]);
#pragma unroll
                for (int e = 0; e < 8; ++e) s += v[j][e] * v[j][e]; }
            s = wave_sum(s); const float r = rsqrtf(s * (1.0f / D) + EPS);
#pragma unroll
            for (int j = 0; j < 2; ++j) { const f32x4* gr = (const f32x4*)(g + 512 * j + 8 * lane); f32x4* o = (f32x4*)(xf + (size_t)t * D + 512 * j + 8 * lane); const f32x4 g0 = gr[0], g1 = gr[1];
                o[0] = (f32x4){v[j][0] * r * g0.x, v[j][1] * r * g0.y, v[j][2] * r * g0.z, v[j][3] * r * g0.w};
                o[1] = (f32x4){v[j][4] * r * g1.x, v[j][5] * r * g1.y, v[j][6] * r * g1.z, v[j][7] * r * g1.w}; }
        }
    }
#undef IN
#undef SEAM
#undef SEAM_L
}
extern "C" void kernel_launch(void* const* d_in, const int* in_sizes, int n_in, void* d_out, int out_size, void* d_ws, size_t ws_size, hipStream_t stream) {
    static int grid = 0;
    if (grid == 0) {
        if (n_in != 13 || in_sizes[0] != T * D || out_size != T * D || ws_size < WS_END) { fprintf(stderr, "kernel_launch: bad arguments (n_in %d, out %d, ws %zu)\n", n_in, out_size, ws_size); grid = -1; return; }
        int dev = 0, cus = 0, per_cu = 0;
        if (hipGetDevice(&dev) != hipSuccess || hipDeviceGetAttribute(&cus, hipDeviceAttributeMultiprocessorCount, dev) != hipSuccess) { grid = -1; return; }
        if (hipFuncSetAttribute((const void*)mega, hipFuncAttributeMaxDynamicSharedMemorySize, LDS_BYTES) != hipSuccess) { fprintf(stderr, "kernel_launch: hipFuncSetAttribute failed\n"); grid = -1; return; }
        if (hipOccupancyMaxActiveBlocksPerMultiprocessor(&per_cu, (const void*)mega, NWAVES * 64, LDS_BYTES) != hipSuccess || per_cu < 1) { fprintf(stderr, "kernel_launch: occupancy query says %d\n", per_cu); grid = -1; (void)hipGetLastError(); return; }
        grid = cus;
    }
    if (grid < 0) return;
    (void)hipMemsetAsync((char*)d_ws + WS_CTL, 0, CTL_ZERO_BYTES, stream);
    Args a{};
    for (int i = 0; i < 13; ++i) a.in[i] = (const float*)d_in[i];
    a.out = (float*)d_out; a.ws = (unsigned char*)d_ws; a.ph_lo = 0; a.ph_hi = NPH; a.li = 0;
    hipLaunchKernelGGL(mega, dim3(grid), dim3(NWAVES * 64), LDS_BYTES, stream, a);
}
```

```cpp
#include <hip/hip_runtime.h>
#include <cstdio>
#include <cstdint>

constexpr int D = 1024, BATCH = 16, SEQ = 2048, DEPTH = 2, T = BATCH * SEQ;
constexpr int AH = 8, AHD = 64;
constexpr int RH = 4, RDK = 128, RDV = 256;
constexpr int DFF = 2816, DIN = 5888;
constexpr float EPS = 1e-6f;

typedef unsigned short bf16_t;
typedef unsigned u32x4 __attribute__((ext_vector_type(4)));
typedef float f32x4 __attribute__((ext_vector_type(4)));

constexpr size_t MiB = 1u << 20;
constexpr size_t WS_CTL = 0;
constexpr size_t WS_W = 2 * MiB;
constexpr size_t W_IN = 0, W_AO = W_IN + (size_t)DIN * D * 2, W_RO = W_AO + (size_t)D * 512 * 2, W_OUT = W_RO + (size_t)D * D * 2,
                 W_GU = W_OUT + (size_t)D * D * 2, W_DN = W_GU + (size_t)2 * DFF * D * 2, W_LAYER = W_DN + (size_t)D * DFF * 2;
static_assert(W_LAYER == 33 * MiB, "weights per layer");
constexpr size_t WS_XB = 68 * MiB;
constexpr size_t WS_SSP = 132 * MiB;
constexpr size_t WS_PATT = 134 * MiB;
constexpr size_t WS_PRET = 182 * MiB;
constexpr size_t WS_PRG = 310 * MiB;
constexpr size_t WS_PGA = 374 * MiB;
constexpr size_t WS_PGR = 438 * MiB;
constexpr size_t WS_SSP2 = 502 * MiB;
constexpr size_t WS_END = 504 * MiB;
constexpr size_t WS_ACT = WS_PRET;
constexpr size_t ACT_PANEL = (size_t)256 * DFF * 2;
static_assert(11 * ACT_PANEL <= 16 * MiB && 5 * ACT_PANEL <= 8 * MiB && WS_PRG == WS_PRET + 128 * MiB, "act panels");
__host__ __device__ __forceinline__ size_t act_panel_off(int pm) {
    const int x = pm >> 4, j = pm & 15;
    return j < 11 ? (size_t)x * (16 * MiB) + (size_t)j * ACT_PANEL : (WS_PRG - WS_PRET) + (size_t)x * (8 * MiB) + (size_t)(j - 11) * ACT_PANEL; }

__device__ __forceinline__ void st16_wt(void* p, u32x4 v) { asm volatile("global_store_dwordx4 %0, %1, off sc1\n\ts_nop 1" :: "v"(p), "v"(v) : "memory"); }
__device__ __forceinline__ float bf2f(bf16_t b) { return __uint_as_float(((unsigned)b) << 16); }
__device__ __forceinline__ unsigned f2bf(float f) { unsigned u = __float_as_uint(f); return (u + 0x7fffu + ((u >> 16) & 1u)) >> 16; }
typedef float f32x2_hw __attribute__((ext_vector_type(2)));
typedef __bf16 bf16x2_hw __attribute__((ext_vector_type(2)));
__device__ __forceinline__ unsigned pk2(float lo, float hi) { f32x2_hw v = {lo, hi}; bf16x2_hw b = __builtin_convertvector(v, bf16x2_hw); return __builtin_bit_cast(unsigned, b); }
__device__ __forceinline__ float sigmoidf_(float x) { return __builtin_amdgcn_rcpf(1.0f + __builtin_amdgcn_exp2f(x * -1.4426950408889634f)); }
__device__ __forceinline__ float wave_sum(float v) {
#pragma unroll
    for (int o = 1; o < 64; o <<= 1) v += __shfl_xor(v, o);
    return v;
}
__device__ __forceinline__ float wave_max(float v) {
#pragma unroll
    for (int o = 1; o < 64; o <<= 1) v = fmaxf(v, __shfl_xor(v, o));
    return v;
}
__device__ __forceinline__ u32x4 pack8(const float* v, float s) {
    u32x4 w; w.x = pk2(v[0] * s, v[1] * s); w.y = pk2(v[2] * s, v[3] * s); w.z = pk2(v[4] * s, v[5] * s); w.w = pk2(v[6] * s, v[7] * s); return w;
}
__device__ __forceinline__ void unpack8(u32x4 w, float* v) {
    v[0] = __uint_as_float(w.x << 16); v[1] = __uint_as_float(w.x & 0xffff0000u); v[2] = __uint_as_float(w.y << 16); v[3] = __uint_as_float(w.y & 0xffff0000u);
    v[4] = __uint_as_float(w.z << 16); v[5] = __uint_as_float(w.z & 0xffff0000u); v[6] = __uint_as_float(w.w << 16); v[7] = __uint_as_float(w.w & 0xffff0000u);
}

__device__ __forceinline__ void transpose_item(const float* W, int K, int N, const float* g, bf16_t* WT, float* scr, int k0, int n0, int orow0, int lane) {
    float v[32];
    const float* src = W + (size_t)(k0 + (lane >> 5)) * N + n0 + (lane & 31);
#pragma unroll
    for (int i = 0; i < 32; ++i) v[i] = src[(size_t)(2 * i) * N];
    if (g) {
#pragma unroll
        for (int i = 0; i < 32; ++i) v[i] *= g[k0 + 2 * i + (lane >> 5)];
    }
#pragma unroll
    for (int i = 0; i < 32; ++i) scr[(2 * i + (lane >> 5)) * 33 + (lane & 31)] = v[i];
    asm volatile("s_waitcnt lgkmcnt(0)" ::: "memory");
    const int c = lane & 7;
#pragma unroll
    for (int j = 0; j < 4; ++j) { const int n = (lane >> 3) + 8 * j; const float* s = scr + (8 * c) * 33 + n;
        u32x4 o; o.x = pk2(s[0 * 33], s[1 * 33]); o.y = pk2(s[2 * 33], s[3 * 33]); o.z = pk2(s[4 * 33], s[5 * 33]); o.w = pk2(s[6 * 33], s[7 * 33]);
        st16_wt(WT + (size_t)(orow0 + n) * K + k0 + 8 * c, o); }
    asm volatile("s_waitcnt lgkmcnt(0)" ::: "memory");
}
struct WPtrs { const float *norm_mix, *w_in, *w_ao, *w_ro, *w_out, *norm_ffn, *w_gate, *w_up, *w_dn, *gn_gain; };
constexpr int PRO_I_IN0 = (D / 64) * (DIN / 32);
constexpr int PRO_PER_LAYER = (D / 64) * (DIN / 32) + (512 / 64) * (D / 32) + 2 * (D / 64) * (D / 32) + 2 * (D / 64) * (DFF / 32) + (DFF / 64) * (D / 32);
__device__ __forceinline__ void prologue_weights(const WPtrs& P, unsigned char* ws, float* scr, int gw, int ngw, int lane, int it_lo = 0, int it_hi = 1 << 30) {
    constexpr int I_IN = (D / 64) * (DIN / 32), I_AO = (512 / 64) * (D / 32), I_SQ = (D / 64) * (D / 32), I_GU = (D / 64) * (DFF / 32), I_DN = (DFF / 64) * (D / 32);
    constexpr int PER_LAYER = I_IN + I_AO + 2 * I_SQ + 2 * I_GU + I_DN; static_assert(PER_LAYER == PRO_PER_LAYER, "item list");
    const int it_end = it_hi < DEPTH * PER_LAYER ? it_hi : DEPTH * PER_LAYER;
    for (int it = it_lo + gw; it < it_end; it += ngw) {
        const int l = it / PER_LAYER; int r = it % PER_LAYER;
        unsigned char* wl = ws + WS_W + (size_t)l * W_LAYER;
        if (r < I_IN) { const int nb = DIN / 32, kb = r / nb, n0 = 32 * (r % nb); transpose_item(P.w_in + (size_t)l * D * DIN, D, DIN, P.norm_mix + l * D, (bf16_t*)(wl + W_IN), scr, 64 * kb, n0, n0, lane); continue; } r -= I_IN;
        if (r < I_AO) { const int nb = D / 32, kb = r / nb, n0 = 32 * (r % nb); transpose_item(P.w_ao + (size_t)l * 512 * D, 512, D, nullptr, (bf16_t*)(wl + W_AO), scr, 64 * kb, n0, n0, lane); continue; } r -= I_AO;
        if (r < I_SQ) { const int nb = D / 32, kb = r / nb, n0 = 32 * (r % nb); transpose_item(P.w_ro + (size_t)l * D * D, D, D, P.gn_gain + l * D, (bf16_t*)(wl + W_RO), scr, 64 * kb, n0, n0, lane); continue; } r -= I_SQ;
        if (r < I_SQ) { const int nb = D / 32, kb = r / nb, n0 = 32 * (r % nb); transpose_item(P.w_out + (size_t)l * D * D, D, D, nullptr, (bf16_t*)(wl + W_OUT), scr, 64 * kb, n0, n0, lane); continue; } r -= I_SQ;
        if (r < I_GU) { const int nb = DFF / 32, kb = r / nb, n0 = 32 * (r % nb); transpose_item(P.w_gate + (size_t)l * D * DFF, D, DFF, P.norm_ffn + l * D, (bf16_t*)(wl + W_GU), scr, 64 * kb, n0, 256 * (n0 / 128) + 64 * ((n0 % 128) / 32), lane); continue; } r -= I_GU;
        if (r < I_GU) { const int nb = DFF / 32, kb = r / nb, n0 = 32 * (r % nb); transpose_item(P.w_up + (size_t)l * D * DFF, D, DFF, P.norm_ffn + l * D, (bf16_t*)(wl + W_GU), scr, 64 * kb, n0, 256 * (n0 / 128) + 64 * ((n0 % 128) / 32) + 32, lane); continue; } r -= I_GU;
        { const int nb = D / 32, kb = r / nb, n0 = 32 * (r % nb); transpose_item(P.w_dn + (size_t)l * DFF * D, DFF, D, nullptr, (bf16_t*)(wl + W_DN), scr, 64 * kb, n0, n0, lane); }
    }
}
typedef float f32x2p __attribute__((ext_vector_type(2)));
template <class RS> struct EpiAct {
    RS rs; bf16_t* act;
    __device__ __forceinline__ void apply8(int row, int col0, float s, const float* g, const float* u) const {
        const float s2 = s * -1.4426950408889634f, ss = s * s; u32x4 w; float e[8], o[8];
#pragma unroll
        for (int j = 0; j < 8; ++j) e[j] = __builtin_amdgcn_exp2f(g[j] * s2);
#pragma unroll
        for (int j = 0; j < 8; ++j) o[j] = (g[j] * u[j]) * ss;
#pragma unroll
        for (int j = 0; j < 8; ++j) e[j] = __builtin_amdgcn_rcpf(1.0f + e[j]);
#pragma unroll
        for (int j = 0; j < 8; ++j) o[j] *= e[j];
        w.x = pk2(o[0], o[1]); w.y = pk2(o[2], o[3]); w.z = pk2(o[4], o[5]); w.w = pk2(o[6], o[7]);
        st16_wt((bf16_t*)((unsigned char*)act + act_panel_off(row >> 8)) + (size_t)(row & 255) * DFF + col0, w);
    }
};
#define LAS __attribute__((address_space(3)))
#define GAS __attribute__((address_space(1)))
namespace mx {
typedef short bf16x8 __attribute__((ext_vector_type(8)));
typedef short s16x4 __attribute__((ext_vector_type(4)));
typedef float f32x16 __attribute__((ext_vector_type(16)));
typedef unsigned u32x2 __attribute__((ext_vector_type(2)));
typedef float f32x2_t __attribute__((ext_vector_type(2)));
typedef __bf16 bf16x2_t __attribute__((ext_vector_type(2)));
typedef short v4i16_t __attribute__((ext_vector_type(4)));
constexpr float LOG2E = 1.4426950408889634f;
#define MFMA32(a, b, c) __builtin_amdgcn_mfma_f32_32x32x16_bf16((a), (b), (c), 0, 0, 0)
__device__ __forceinline__ unsigned cvtpk(float lo, float hi) { f32x2_t v = {lo, hi}; bf16x2_t b = __builtin_convertvector(v, bf16x2_t); return __builtin_bit_cast(unsigned, b); }
template <int S> __device__ __forceinline__ bf16x8 pack_step(const f32x16& x) {
    u32x4 p; p.x = cvtpk(x[8 * S + 0], x[8 * S + 1]); p.y = cvtpk(x[8 * S + 2], x[8 * S + 3]); p.z = cvtpk(x[8 * S + 4], x[8 * S + 5]); p.w = cvtpk(x[8 * S + 6], x[8 * S + 7]);
    return __builtin_bit_cast(bf16x8, p);
}
__device__ __forceinline__ bf16x8 join4(s16x4 a, s16x4 b) { bf16x8 r; r[0] = a[0]; r[1] = a[1]; r[2] = a[2]; r[3] = a[3]; r[4] = b[0]; r[5] = b[1]; r[6] = b[2]; r[7] = b[3]; return r; }
__device__ __forceinline__ s16x4 tr_read(const LAS unsigned char* p) { return __builtin_bit_cast(s16x4, __builtin_amdgcn_ds_read_tr16_b64_v4i16((LAS v4i16_t*)p)); }
__device__ __forceinline__ f32x16 zero16() { f32x16 z;
#pragma unroll
    for (int i = 0; i < 16; ++i) z[i] = 0.f; return z; }
__device__ __forceinline__ constexpr int cr(int r) { return (r & 3) + 8 * (r >> 2); }

constexpr int AT_KP = 144, AT_VP = 192;
constexpr int AT_VOFF = 256 * AT_KP;
struct AttnStage { u32x4 kv[4], vv[4]; bf16x8 qn[2][4]; };
__device__ __forceinline__ void attn_load(AttnStage& S, const bf16_t* patt, int item, int tid) {
    const int kvh = item & 1, nb = (item >> 1) & 15, b = item >> 5;
    const int lane = tid & 63, w = __builtin_amdgcn_readfirstlane(tid >> 6), q = lane & 31, hh = lane >> 5, g = w & 3, qh = w >> 2;
    const bf16_t* tb = patt + ((size_t)b * SEQ + (size_t)nb * 128) * 768;
    const bf16_t* base = tb + 512 + kvh * 64;
    const int radd = nb == 0 ? 128 : 0;
#pragma unroll
    for (int i = 0; i < 4; ++i) { const int c = tid + 512 * i, row = c >> 3, ch = c & 7, re = row < 128 ? row + radd : row;
        const bf16_t* src = base + (re - 128) * 768 + ch * 8; S.kv[i] = *(const u32x4*)src; S.vv[i] = *(const u32x4*)(src + 128); }
#pragma unroll
    for (int sb = 0; sb < 2; ++sb)
#pragma unroll
        for (int ks = 0; ks < 4; ++ks) S.qn[sb][ks] = *(const bf16x8*)(tb + (unsigned)((64 * qh + 32 * sb + q) * 768 + kvh * 256 + (8 * g + 2 * ks + hh) * 8));
}
constexpr int AT_QOFF = AT_VOFF + 256 * AT_VP;
constexpr int AT_SINK_OFF = AT_QOFF + 65536;
__device__ __forceinline__ void attn_flush(LAS unsigned char* lds, bf16_t* aout, int item, int tid) {
    const int lane = tid & 63, w = __builtin_amdgcn_readfirstlane(tid >> 6), g = w & 3, qh = w >> 2;
    const int kvh = item & 1, nb = (item >> 1) & 15, b = item >> 5;
    const LAS unsigned char* Ob = lds + AT_QOFF + w * 8192;
    bf16_t* ob_ = aout + ((size_t)b * SEQ + (size_t)nb * 128 + 64 * qh) * 768 + kvh * 256 + g * 64;
    u32x4 yv[8]; const int r8 = lane >> 3, c8 = lane & 7;
#pragma unroll
    for (int i = 0; i < 8; ++i) { const int row = 8 * i + r8; yv[i] = *(const LAS u32x4*)(Ob + row * 128 + ((c8 ^ (row & 7)) << 4)); }
#pragma unroll
    for (int i = 0; i < 8; ++i) { const int row = 8 * i + r8; st16_wt(ob_ + (unsigned)(row * 768 + c8 * 8), yv[i]); }
}
__device__ __forceinline__ void attn_item(LAS unsigned char* lds, const bf16_t* patt, bf16_t* aout, int item, int next_item, int prev_item, AttnStage& S, int tid) {
    asm volatile("" : "+v"(tid));
    const int lane = tid & 63, w = __builtin_amdgcn_readfirstlane(tid >> 6), q = lane & 31, hh = lane >> 5;
    const int kvh = item & 1, nb = (item >> 1) & 15, b = item >> 5;
    const int g = w & 3, qh = w >> 2, h = kvh * 4 + g;
    const size_t tok0 = (size_t)b * SEQ + (size_t)nb * 128;
    LAS unsigned char* Kimg = lds; LAS unsigned char* Vimg = lds + AT_VOFF; LAS unsigned char* Ob = lds + AT_QOFF + w * 8192;
    bf16x8 qc[2][4];
#pragma unroll
    for (int sb = 0; sb < 2; ++sb)
#pragma unroll
        for (int ks = 0; ks < 4; ++ks) qc[sb][ks] = S.qn[sb][ks];
#pragma unroll
    for (int i = 0; i < 4; ++i) { const int c = tid + 512 * i, row = c >> 3, ch = c & 7;
        *(LAS u32x4*)(Kimg + row * AT_KP + ch * 16) = S.kv[i]; *(LAS u32x4*)(Vimg + row * AT_VP + ch * 16) = S.vv[i]; }
    asm volatile("s_waitcnt lgkmcnt(0)" ::: "memory"); __builtin_amdgcn_s_barrier(); asm volatile("" ::: "memory");
    attn_load(S, patt, next_item >= 0 ? next_item : item, tid);
    if (prev_item >= 0) attn_flush(lds, aout, prev_item, tid);
    const float c0s = 0.125f * LOG2E, slr = exp2f(-(float)(h + 1)) * 8.0f  , sink2 = ((const LAS float*)(lds + AT_SINK_OFF))[h] * LOG2E;
    const int q4 = (lane & 15) >> 2, p4 = lane & 3, blk = (lane >> 4) & 1;
#pragma unroll
    for (int sb = 0; sb < 2; ++sb) {
        const int jt0 = 2 * qh + sb;
        const unsigned orb = (unsigned)(32 * sb + q) * 128u, orx = (unsigned)(q & 7);
        int qm = q - 4 * hh; asm volatile("" : "+v"(qm));
        f32x16 sa[5];
#pragma unroll
        for (int u = 0; u < 5; ++u) {
            if (nb > 0 || jt0 + u >= 4) {
                const float offu = -slr * (float)(128 - 32 * u + qm);
#pragma unroll
                for (int r = 0; r < 16; ++r) sa[u][r] = offu + slr * (float)cr(r);
#pragma unroll
                for (int ks = 0; ks < 4; ++ks) { const bf16x8 kf = *(const LAS bf16x8*)(Kimg + (32 * (jt0 + u) + q) * AT_KP + (2 * ks + hh) * 16); sa[u] = MFMA32(kf, qc[sb][ks], sa[u]); }
            } else {
#pragma unroll
                for (int r = 0; r < 16; ++r) sa[u][r] = -INFINITY;
            }
        }
#pragma unroll
        for (int r = 0; r < 16; ++r) { sa[0][r] = (cr(r) > qm) ? sa[0][r] : -INFINITY; sa[4][r] = (cr(r) <= qm) ? sa[4][r] : -INFINITY; }
        float m = -INFINITY;
#pragma unroll
        for (int u = 0; u < 5; ++u)
#pragma unroll
            for (int r = 0; r < 16; ++r) m = fmaxf(m, sa[u][r]);
        m = fmaxf(m, __shfl_xor(m, 32)); const float mc = fmaxf(m * c0s, sink2);
        float l = 0.f;
#pragma unroll
        for (int u = 0; u < 5; ++u)
#pragma unroll
            for (int r = 0; r < 16; ++r) { const float p = __builtin_amdgcn_exp2f(__builtin_fmaf(sa[u][r], c0s, -mc)); sa[u][r] = p; l += p; }
        l += __shfl_xor(l, 32); l += __builtin_amdgcn_exp2f(sink2 - mc);
        f32x16 oa[2]; oa[0] = zero16(); oa[1] = zero16();
#pragma unroll
        for (int u = 0; u < 5; ++u) {
            if (nb > 0 || jt0 + u >= 4) {
                const bf16x8 pf0 = pack_step<0>(sa[u]), pf1 = pack_step<1>(sa[u]);
#pragma unroll
                for (int s2 = 0; s2 < 2; ++s2)
#pragma unroll
                    for (int dt = 0; dt < 2; ++dt) {
                        const LAS unsigned char* vp = Vimg + (32 * (jt0 + u) + 16 * s2 + 4 * hh + q4) * AT_VP + (32 * dt + 16 * blk + 4 * p4) * 2;
                        const bf16x8 vf = join4(tr_read(vp), tr_read(vp + 8 * AT_VP));
                        oa[dt] = MFMA32(vf, s2 == 0 ? pf0 : pf1, oa[dt]);
                    }
            }
        }
        const float inv = __builtin_amdgcn_rcpf(l);
#pragma unroll
        for (int dt = 0; dt < 2; ++dt)
#pragma unroll
            for (int g4 = 0; g4 < 4; ++g4) { u32x2 o; o.x = cvtpk(oa[dt][4 * g4] * inv, oa[dt][4 * g4 + 1] * inv); o.y = cvtpk(oa[dt][4 * g4 + 2] * inv, oa[dt][4 * g4 + 3] * inv);
                *(LAS u32x2*)(Ob + orb + ((((unsigned)(4 * dt + g4)) ^ orx) << 4) + 8 * hh) = o; }
    }
    asm volatile("s_waitcnt lgkmcnt(0)" ::: "memory"); __builtin_amdgcn_s_barrier(); asm volatile("" ::: "memory");
}

constexpr int QP = 272, KP = 320, VP = 512;
constexpr int RT_Q = 0, RT_KD = RT_Q + 128 * QP, RT_V = RT_KD + 128 * KP, RT_ST = RT_V + 128 * VP, RT_END = RT_ST + 8192;
__device__ __forceinline__ void ret_item(LAS unsigned char* lds, const bf16_t* pret, const bf16_t* prg, bf16_t* rout, const float* gain, int b, int h, int c0, int c1, int tid) {
    const int w = __builtin_amdgcn_readfirstlane(tid >> 6);
    LAS unsigned char* Qimg = lds + RT_Q; LAS unsigned char* KDimg = lds + RT_KD; LAS unsigned char* Vimg = lds + RT_V; LAS float* st = (LAS float*)(lds + RT_ST);
    const float lg = log2f(1.0f - exp2f(-5.0f - (float)h));
    const float g128 = exp2f(128.0f * lg), kbase = 0.08838834764831845f;
    const bf16_t* pb = pret + (size_t)b * SEQ * 2048 + h * 128;
    f32x16 state[4];
#pragma unroll
    for (int d = 0; d < 4; ++d) state[d] = zero16();
    u32x4 kr[4], qr[4];
#define RT_OFFS() const unsigned kqoff = (unsigned)(tid >> 4) * 2048u + (unsigned)(tid & 15) * 8u, voff = (unsigned)(tid >> 5) * 2048u + (unsigned)(tid & 31) * 8u
#define RT_LOAD_K(c) do { const bf16_t* cb_ = pb + (size_t)(c) * (128 * 2048) + 512; _Pragma("unroll") for (int i = 0; i < 4; ++i) kr[i] = *(const u32x4*)(cb_ + (size_t)i * (32 * 2048) + kqoff); } while (0)
#define RT_LOAD_Q(c) do { const bf16_t* cb_ = pb + (size_t)(c) * (128 * 2048); _Pragma("unroll") for (int i = 0; i < 4; ++i) qr[i] = *(const u32x4*)(cb_ + (size_t)i * (32 * 2048) + kqoff); } while (0)
#define RT_LOAD_V(c) do { const bf16_t* cb_ = pb + (size_t)(c) * (128 * 2048) + 1024 + h * 128; _Pragma("unroll") for (int i = 0; i < 8; ++i) vr[i] = *(const u32x4*)(cb_ + (size_t)i * (16 * 2048) + voff); } while (0)
#define RT_STORE_KD() do { _Pragma("unroll") for (int i = 0; i < 4; ++i) { const int cc = tid + 512 * i, row = cc >> 4, ch = cc & 15; float f[8]; unpack8(kr[i], f); const float sc = kbase * exp2f(lg * (float)(127 - row)); \
        u32x4 o_; o_.x = cvtpk(f[0] * sc, f[1] * sc); o_.y = cvtpk(f[2] * sc, f[3] * sc); o_.z = cvtpk(f[4] * sc, f[5] * sc); o_.w = cvtpk(f[6] * sc, f[7] * sc); *(LAS u32x4*)(KDimg + row * KP + ch * 16) = o_; } } while (0)
#define RT_STORE_Q() do { _Pragma("unroll") for (int i = 0; i < 4; ++i) { const int cc = tid + 512 * i, row = cc >> 4, ch = cc & 15; *(LAS u32x4*)(Qimg + row * QP + ch * 16) = qr[i]; } } while (0)
#define RT_STORE_V() do { _Pragma("unroll") for (int i = 0; i < 8; ++i) { const int cc = tid + 512 * i, row = cc >> 5, ch = cc & 31; *(LAS u32x4*)(Vimg + row * VP + ((ch ^ ((row & 3) << 2)) * 16)) = vr[i]; } } while (0)
    if (c0 > 0) {
    u32x4 vr[8];
    { asm volatile("" : "+v"(tid)); RT_OFFS(); RT_LOAD_K(0); RT_LOAD_V(0); }
    for (int c = 0; c < c0; ++c) {
        asm volatile("" : "+v"(tid));
        const int lane = tid & 63, hh = lane >> 5, q4 = (lane & 15) >> 2, p4 = lane & 3, blk = (lane >> 4) & 1;
        RT_STORE_KD(); RT_STORE_V();
        { const int cn = (c + 1 < c0) ? c + 1 : c; RT_OFFS(); RT_LOAD_K(cn); RT_LOAD_V(cn); }
        __syncthreads();
#pragma unroll
        for (int d = 0; d < 4; ++d)
#pragma unroll
            for (int r = 0; r < 16; ++r) state[d][r] *= g128;
        {
            const LAS unsigned char* vb = Vimg + (8 * hh + q4) * VP + ((4 * (w ^ q4) + 2 * blk) * 16 + 8 * p4);
            const LAS unsigned char* kb = KDimg + (8 * hh + q4) * KP + (16 * blk + 4 * p4) * 2;
            bf16x8 vf[2], kt[2][4];
#define RT_LDW(s_, b_) do { vf[b_] = join4(tr_read(vb + (16 * (s_)) * VP), tr_read(vb + (16 * (s_) + 4) * VP)); \
                _Pragma("unroll") for (int dkt = 0; dkt < 4; ++dkt) kt[b_][dkt] = join4(tr_read(kb + (16 * (s_)) * KP + 64 * dkt), tr_read(kb + (16 * (s_) + 4) * KP + 64 * dkt)); } while (0)
            RT_LDW(0, 0);
#pragma unroll
            for (int s = 0; s < 8; ++s) {
                if (s < 7) RT_LDW(s + 1, (s + 1) & 1);
#pragma unroll
                for (int dkt = 0; dkt < 4; ++dkt) state[dkt] = MFMA32(kt[s & 1][dkt], vf[s & 1], state[dkt]);
            }
#undef RT_LDW
        }
        __syncthreads();
    }
    }
    { asm volatile("" : "+v"(tid)); RT_OFFS(); RT_LOAD_K(c0); RT_LOAD_Q(c0); }
    __builtin_amdgcn_s_waitcnt(0x0070);
    for (int c = c0; c < c1; ++c) {
        const size_t tokc = (size_t)b * SEQ + (size_t)c * 128;
        asm volatile("" : "+v"(tid));
        const int lane = tid & 63, q = lane & 31, hh = lane >> 5, q4 = (lane & 15) >> 2, p4 = lane & 3, blk = (lane >> 4) & 1;
        RT_STORE_KD(); RT_STORE_Q();
        {
            const int vrow = 16 * w + (lane >> 5), vch = (lane & 31); const bf16_t* cb_ = pb + (size_t)c * (128 * 2048) + 1024 + h * 128;
#pragma unroll
            for (int i = 0; i < 8; ++i) { const int row = vrow + 2 * i, ch = vch ^ ((row & 3) << 2);
                __builtin_amdgcn_global_load_lds((const unsigned*)(cb_ + (unsigned)(row * 2048 + ch * 8)), (LAS unsigned*)(Vimg + (8 * w + i) * 1024), 16, 0, 0); }
        }
        asm volatile("s_waitcnt lgkmcnt(0)" ::: "memory"); __builtin_amdgcn_s_barrier(); asm volatile("" ::: "memory");
        f32x16 o[4];
        unsigned sp[2][8];
#pragma unroll
        for (int sl = 0; sl < 2; ++sl) {
            const int n = w + 8 * sl;
            if (n < 10) {
                const int it = n >= 6 ? 3 : (n >= 3 ? 2 : (n >= 1 ? 1 : 0)), jt = n - (it * (it + 1)) / 2;
                f32x16 a = zero16();
                {
                    const LAS unsigned char* kp1 = KDimg + (32 * jt + q) * KP + hh * 16; const LAS unsigned char* qp1 = Qimg + (32 * it + q) * QP + hh * 16;
                    bf16x8 kf[2], qq[2]; kf[0] = *(const LAS bf16x8*)kp1; qq[0] = *(const LAS bf16x8*)qp1;
#pragma unroll
                    for (int ks = 0; ks < 8; ++ks) { if (ks < 7) { kf[(ks + 1) & 1] = *(const LAS bf16x8*)(kp1 + 32 * (ks + 1)); qq[(ks + 1) & 1] = *(const LAS bf16x8*)(qp1 + 32 * (ks + 1)); }
                        a = MFMA32(kf[ks & 1], qq[ks & 1], a); }
                }
                const float fi = exp2f(lg * (float)(32 * it + q - 127));
#pragma unroll
                for (int r = 0; r < 16; ++r) { float v = a[r] * fi; if (it == jt && (cr(r) + 4 * hh > q)) v = 0.f; a[r] = v; }
#pragma unroll
                for (int g4 = 0; g4 < 4; ++g4) { sp[sl][2 * g4] = cvtpk(a[4 * g4], a[4 * g4 + 1]); sp[sl][2 * g4 + 1] = cvtpk(a[4 * g4 + 2], a[4 * g4 + 3]); }
            }
        }
#pragma unroll
        for (int it = 0; it < 4; ++it) o[it] = zero16();
        {
            const LAS unsigned char* qb3 = Qimg + q * QP + 8 * hh;
            bf16x8 bq[2][4];
#define RT_LD3(g_, b_) do { _Pragma("unroll") for (int it = 0; it < 4; ++it) bq[b_][it] = join4(*(const LAS s16x4*)(qb3 + (32 * it) * QP + 32 * (g_)), *(const LAS s16x4*)(qb3 + (32 * it) * QP + 32 * (g_) + 16)); } while (0)
            RT_LD3(0, 0);
#pragma unroll
            for (int g = 0; g < 8; ++g) {
                if (g < 7) RT_LD3(g + 1, (g + 1) & 1);
                const bf16x8 af = (g & 1) ? pack_step<1>(state[g >> 1]) : pack_step<0>(state[g >> 1]);
#pragma unroll
                for (int it = 0; it < 4; ++it) o[it] = MFMA32(af, bq[g & 1][it], o[it]);
            }
#undef RT_LD3
        }
        asm volatile("" ::: "memory"); __builtin_amdgcn_s_waitcnt(0x0070); __builtin_amdgcn_s_barrier(); asm volatile("" ::: "memory");
#pragma unroll
        for (int sl = 0; sl < 2; ++sl) {
            const int n = w + 8 * sl;
            if (n < 10) {
                const int it = n >= 6 ? 3 : (n >= 3 ? 2 : (n >= 1 ? 1 : 0)), jt = n - (it * (it + 1)) / 2;
#pragma unroll
                for (int g4 = 0; g4 < 4; ++g4) { u32x2 v; v.x = sp[sl][2 * g4]; v.y = sp[sl][2 * g4 + 1]; *(LAS u32x2*)(Qimg + (32 * it + q) * QP + (4 * jt + g4) * 16 + 8 * hh) = v; }
            }
        }
        __syncthreads();
        { const int cn = (c + 1 < c1) ? c + 1 : c; RT_OFFS(); RT_LOAD_K(cn); RT_LOAD_Q(cn); }
#pragma unroll
        for (int it = 0; it < 4; ++it) { const float gi = exp2f(lg * (float)(32 * it + q + 1));
#pragma unroll
            for (int r = 0; r < 16; ++r) o[it][r] *= gi; }
#pragma unroll
        for (int d = 0; d < 4; ++d)
#pragma unroll
            for (int r = 0; r < 16; ++r) state[d][r] *= g128;
        {
            const LAS unsigned char* vb = Vimg + (8 * hh + q4) * VP + ((4 * (w ^ q4) + 2 * blk) * 16 + 8 * p4);
            const LAS unsigned char* sb2 = Qimg + q * QP + hh * 16;
            bf16x8 vf[2], sf[2][4];
#define RT_LD2(s_, b_) do { vf[b_] = join4(tr_read(vb + (16 * (s_)) * VP), tr_read(vb + (16 * (s_) + 4) * VP)); \
                _Pragma("unroll") for (int it = 0; it < 4; ++it) if (2 * it + 1 >= (s_)) sf[b_][it] = *(const LAS bf16x8*)(sb2 + (32 * it) * QP + 32 * (s_)); } while (0)
            RT_LD2(0, 0);
#pragma unroll
            for (int s = 0; s < 8; ++s) {
                if (s < 7) RT_LD2(s + 1, (s + 1) & 1);
#pragma unroll
                for (int it = 0; it < 4; ++it) if (2 * it + 1 >= s) o[it] = MFMA32(vf[s & 1], sf[s & 1][it], o[it]);
            }
#undef RT_LD2
        }
        if (c < 15) {
            const LAS unsigned char* vb = Vimg + (8 * hh + q4) * VP + ((4 * (w ^ q4) + 2 * blk) * 16 + 8 * p4);
            const LAS unsigned char* kb = KDimg + (8 * hh + q4) * KP + (16 * blk + 4 * p4) * 2;
            bf16x8 vf[2], kt[2][4];
#define RT_LD4(s_, b_) do { vf[b_] = join4(tr_read(vb + (16 * (s_)) * VP), tr_read(vb + (16 * (s_) + 4) * VP)); \
                _Pragma("unroll") for (int dkt = 0; dkt < 4; ++dkt) kt[b_][dkt] = join4(tr_read(kb + (16 * (s_)) * KP + 64 * dkt), tr_read(kb + (16 * (s_) + 4) * KP + 64 * dkt)); } while (0)
            RT_LD4(0, 0);
#pragma unroll
            for (int s = 0; s < 8; ++s) {
                if (s < 7) RT_LD4(s + 1, (s + 1) & 1);
#pragma unroll
                for (int dkt = 0; dkt < 4; ++dkt) state[dkt] = MFMA32(kt[s & 1][dkt], vf[s & 1], state[dkt]);
            }
#undef RT_LD4
        }
        __syncthreads();
        {
            const int grow0 = 16 * w + (lane >> 5), gch = lane & 31; const bf16_t* gb_ = prg + tokc * 1024 + h * 256;
#pragma unroll
            for (int i = 0; i < 8; ++i) { const int row = grow0 + 2 * i, ch = gch ^ (row & 31);
                __builtin_amdgcn_global_load_lds((const unsigned*)(gb_ + (unsigned)(row * 1024 + ch * 8)), (LAS unsigned*)(Qimg + (8 * w + i) * 1024), 16, 0, 0); }
        }
        float mean[4], rstd[4];
#pragma unroll
        for (int it = 0; it < 4; ++it) { float ps = 0.f, pq = 0.f;
#pragma unroll
            for (int r = 0; r < 16; ++r) { ps += o[it][r]; pq += o[it][r] * o[it][r]; }
            ps += __shfl_xor(ps, 32); pq += __shfl_xor(pq, 32); if (hh == 0) { st[w * 128 + 32 * it + q] = ps; st[1024 + w * 128 + 32 * it + q] = pq; } }
        asm volatile("s_waitcnt lgkmcnt(0)" ::: "memory"); __builtin_amdgcn_s_barrier(); asm volatile("" ::: "memory");
#pragma unroll
        for (int it = 0; it < 4; ++it) { float s8 = 0.f, q8 = 0.f;
#pragma unroll
            for (int ww = 0; ww < 8; ++ww) { s8 += st[ww * 128 + 32 * it + q]; q8 += st[1024 + ww * 128 + 32 * it + q]; }
            mean[it] = s8 * (1.0f / 256.0f); rstd[it] = rsqrtf(fmaxf(q8 * (1.0f / 256.0f) - mean[it] * mean[it], 0.f) + EPS); }
        asm volatile("" ::: "memory"); __builtin_amdgcn_s_waitcnt(0x0070); __builtin_amdgcn_s_barrier(); asm volatile("" ::: "memory");
#pragma unroll
        for (int it = 0; it < 4; ++it) {
            const int row = 32 * it + q; const unsigned rbase = (unsigned)row * 512u, rx = (unsigned)(row & 31);
#pragma unroll
            for (int g4 = 0; g4 < 4; ++g4) {
                const unsigned c8 = (unsigned)(8 * w + 2 * g4 + hh);
                const unsigned off = rbase + (((c8 >> 1) ^ rx) << 4) + ((c8 & 1u) << 3);
                const u32x2 rw = *(const LAS u32x2*)(Qimg + off); const float ms = rstd[it];
                const float rg0 = __uint_as_float(rw.x << 16), rg1 = __uint_as_float(rw.x & 0xffff0000u), rg2 = __uint_as_float(rw.y << 16), rg3 = __uint_as_float(rw.y & 0xffff0000u);
                const float y0 = (o[it][4 * g4 + 0] - mean[it]) * ms * rg0, y1 = (o[it][4 * g4 + 1] - mean[it]) * ms * rg1;
                const float y2 = (o[it][4 * g4 + 2] - mean[it]) * ms * rg2, y3 = (o[it][4 * g4 + 3] - mean[it]) * ms * rg3;
                u32x2 ov; ov.x = cvtpk(y0, y1); ov.y = cvtpk(y2, y3); *(LAS u32x2*)(Vimg + off) = ov;
            }
        }
        asm volatile("s_waitcnt lgkmcnt(0)" ::: "memory"); __builtin_amdgcn_s_barrier(); asm volatile("" ::: "memory");
        {
            u32x4 yv[8]; bf16_t* ob_ = rout + tokc * 1024 + h * 256;
#pragma unroll
            for (int i = 0; i < 8; ++i) { const int cc = tid + 512 * i, row = cc >> 5, ch = cc & 31; yv[i] = *(const LAS u32x4*)(Vimg + row * 512 + ((ch ^ (row & 31)) << 4)); }
#pragma unroll
            for (int i = 0; i < 8; ++i) { const int cc = tid + 512 * i, row = cc >> 5, ch = cc & 31; st16_wt(ob_ + (unsigned)(row * 1024 + ch * 8), yv[i]); }
        }
        __syncthreads();
    }
#undef RT_OFFS
#undef RT_LOAD_K
#undef RT_LOAD_Q
#undef RT_LOAD_V
#undef RT_STORE_KD
#undef RT_STORE_Q
#undef RT_STORE_V
}
}

__device__ __forceinline__ int tid_from_wave(int wave) { unsigned z = 0u; asm volatile("" : "+v"(z));
    return wave * 64 + (int)__builtin_amdgcn_mbcnt_hi(~0u, __builtin_amdgcn_mbcnt_lo(~0u, z)); }
struct Args;
template <int WHAT  >
__device__ __forceinline__ void mixer_phase_impl(LAS unsigned char* lds, unsigned char* ws, const float* sinks, const float* gain, int bx, int G, bf16_t* aout, bf16_t* rout, int wave, bool consec) {
    const bf16_t* patt = (const bf16_t*)(ws + WS_PATT); const bf16_t* pret = (const bf16_t*)(ws + WS_PRET); const bf16_t* prg = (const bf16_t*)(ws + WS_PRG);
    int tid_ = tid_from_wave(wave); asm volatile("" : "+v"(tid_));
    const int tid = tid_;
    const int vcu = (G % 8 == 0) ? (bx % 8) * (G / 8) + bx / 8 : bx;
    if constexpr ((WHAT & 2) != 0)
    for (int it = vcu; it < BATCH * RH * 4; it += G) {
        const int bh = it >> 2, seg = it & 3, c0 = seg == 0 ? 0 : (seg == 1 ? 5 : (seg == 2 ? 9 : 13)), c1 = seg == 0 ? 5 : (seg == 1 ? 9 : (seg == 2 ? 13 : 16));
        mx::ret_item(lds, pret, prg, rout, gain, bh >> 2, bh & 3, c0, c1, tid);
    }
    if constexpr ((WHAT & 1) != 0)
    {
        if (tid < AH) ((LAS float*)(lds + mx::AT_SINK_OFF))[tid] = sinks[tid];
        const int NIT = BATCH * 16 * 2, npc = NIT / G, first = consec ? vcu * npc : vcu, step = consec ? 1 : G, last = consec ? first + npc : NIT;
        mx::AttnStage S; if (first < last) mx::attn_load(S, patt, first, tid);
        int prev = -1;
        for (int it = first; it < last; it += step) { mx::attn_item(lds, patt, aout, it, (it + step < last) ? it + step : -1, prev, S, tid); prev = it; }
        if (prev >= 0) mx::attn_flush(lds, aout, prev, tid);
    }
}


namespace pg8 {
typedef short bf16x8 __attribute__((ext_vector_type(8)));
constexpr int BM = 256, BK = 64, HALF = 128, HTB = HALF * BK * 2  , STAGE_BYTES = 8 * HTB, NXCD = 8;
#ifndef PG8_WGM
#define PG8_WGM 4
#endif
constexpr int WGM = PG8_WGM;
__host__ __device__ __forceinline__ int lds_byte(int r, int c) { const int st = (r >> 4) * 2 + (c >> 5), rr = r & 15, cc = c & 31, ob = rr * 64 + cc * 2; return st * 1024 + (ob ^ (((ob >> 9) & 1) << 5)); }
__host__ __device__ __forceinline__ void stage_rc(int b, int& R, int& C) { const int st = b / 1024, sb = b % 1024, swz = sb ^ (((sb >> 9) & 1) << 5); R = (st >> 1) * 16 + swz / 64; C = (st & 1) * 32 + (swz % 64) / 2; }
__host__ __device__ __forceinline__ int perm32(int rho) { const int n = rho >> 4, i = rho & 15; return 8 * (i >> 2) + 4 * n + (i & 3); }
struct Unit { int pm, pn; };
struct Gemm { const bf16_t* A; const bf16_t* Bt; int lda, ldb, M, N, K; bool apan = false; };
__device__ __forceinline__ const char* panelA(const Gemm& g, int pm, size_t tstepA) { return (const char*)g.A + (g.apan ? act_panel_off(pm) : (size_t)pm * tstepA); }
struct StaticOrder {
    int nM, nN, nwg, G, c;
    __host__ __device__ void init(int M, int N, int G_, int c_) { nM = M / BM; nN = N / BM; nwg = nM * nN; G = G_; c = c_; }
    __host__ __device__ bool next(int i, Unit& u) const {
        const long L = (long)i * G + c; if (L >= nwg) return false;
        int wgid = (int)L; { const int q = nwg / NXCD, r = nwg % NXCD, xcd = wgid % NXCD, off = wgid / NXCD; wgid = (xcd < r ? xcd * (q + 1) : r * (q + 1) + (xcd - r) * q) + off; }
        const int nig = WGM * nN, gid = wgid / nig, fm = gid * WGM, gsz = (nM - fm) < WGM ? (nM - fm) : WGM;
        u.pm = fm + ((wgid % nig) % gsz); u.pn = (wgid % nig) / gsz; return true;
    }
};
struct NoPre { __device__ __forceinline__ void operator()() const {} };
template <class Epi, class Sched, bool ALIGN_EPI, class Pre = NoPre>
__device__ __forceinline__ void gemm_phase(LAS unsigned char* lds, const Gemm g, const Sched& S, const Epi& E, int wave, const Pre& pre = Pre()) {
    int tid_ = tid_from_wave(wave); asm volatile("" : "+v"(tid_));
    int wid_ = wave; asm volatile("" : "+s"(wid_));
    const int tid = tid_, wid = wid_, lane = tid & 63, wr = wid >> 2, wc = wid & 3, fr = lane & 15, fq = lane >> 4;
    const int nt = g.K / BK;
#define KT(t) ((size_t)(t))
    unsigned voffA[2], voffB[2];
#pragma unroll
    for (int i = 0; i < 2; ++i) { int R, C; stage_rc(tid * 16 + i * 8192, R, C); const int Rb = 64 * (R >> 5) + perm32(R & 31);
        voffA[i] = (unsigned)(R * g.lda + C) * 2u; voffB[i] = (unsigned)(Rb * g.ldb + C) * 2u; }
    const size_t kstep = (size_t)(BK * 2);
    const size_t hstepA = (size_t)HALF * g.lda * 2, hstepB = (size_t)32 * g.ldb * 2, tstepA = 2 * hstepA, tstepB = (size_t)BM * g.ldb * 2;
    const unsigned ldsw = (unsigned)wid * 1024u;
    const int aoff = lds_byte(wr * 64 + fr, fq * 8), boff = lds_byte(wc * 32 + fr, fq * 8);
#define PG8_SA(b, h) (((b) * 2 + (h)) * HTB)
#define PG8_SB(b, h) ((4 + (b) * 2 + (h)) * HTB)
#define PG8_STAGE(bufoff, gbase, voff) do { _Pragma("unroll") for (int _i = 0; _i < 2; ++_i) \
        __builtin_amdgcn_global_load_lds((const unsigned*)((const char*)(gbase) + (voff)[_i]), (LAS unsigned*)(lds + (bufoff) + ldsw + _i * 8192), 16, 0, 0); } while (0)
#define PG8_LDA(dst, b, h) do { _Pragma("unroll") for (int m = 0; m < 4; ++m) _Pragma("unroll") for (int k = 0; k < 2; ++k) dst[m][k] = *(const LAS bf16x8*)(lds + PG8_SA(b, h) + aoff + m * 2048 + k * 1024); } while (0)
#define PG8_LDB(dst, b, h) do { _Pragma("unroll") for (int n = 0; n < 2; ++n) _Pragma("unroll") for (int k = 0; k < 2; ++k) dst[n][k] = *(const LAS bf16x8*)(lds + PG8_SB(b, h) + boff + n * 2048 + k * 1024); } while (0)
#define PG8_MMA(ai, bj, At, Bt) do { __builtin_amdgcn_s_setprio(1); _Pragma("unroll") for (int m = 0; m < 4; ++m) _Pragma("unroll") for (int n = 0; n < 2; ++n) _Pragma("unroll") for (int k = 0; k < 2; ++k) \
        acc[ai][bj][m][n] = __builtin_amdgcn_mfma_f32_16x16x32_bf16(Bt[n][k], At[m][k], acc[ai][bj][m][n], 0, 0, 0); __builtin_amdgcn_s_setprio(0); } while (0)
#define PG8_WAIT_V(n) asm volatile("s_waitcnt vmcnt(" #n ")" ::: "memory")
#define PG8_WAIT_L(n) asm volatile("s_waitcnt lgkmcnt(" #n ")" ::: "memory")
#define PG8_BAR __builtin_amdgcn_s_barrier()
#define PG8_SCHED __builtin_amdgcn_sched_barrier(0)
    Unit cur, nxt; int ui = 0;
    if (!S.next(0, cur)) return;
    f32x4 acc[2][2][4][2];
#pragma unroll
    for (int a = 0; a < 2; ++a)
#pragma unroll
        for (int b = 0; b < 2; ++b)
#pragma unroll
            for (int m = 0; m < 4; ++m)
#pragma unroll
                for (int n = 0; n < 2; ++n) acc[a][b][m][n] = (f32x4){0.f, 0.f, 0.f, 0.f};
    bf16x8 At[4][2], B0[2][2], B1[2][2];
    const char* cA = panelA(g, cur.pm, tstepA); const char* cB = (const char*)g.Bt + (size_t)cur.pn * tstepB;
    PG8_STAGE(PG8_SB(0, 0), cB, voffB); PG8_STAGE(PG8_SB(0, 1), cB + hstepB, voffB); PG8_STAGE(PG8_SA(0, 0), cA, voffA); PG8_STAGE(PG8_SA(0, 1), cA + hstepA, voffA);
    pre();
    if (wr == 1) PG8_BAR;
    PG8_WAIT_V(2); PG8_BAR;
    PG8_STAGE(PG8_SB(1, 0), cB + kstep, voffB); PG8_STAGE(PG8_SA(1, 0), cA + kstep, voffA); PG8_STAGE(PG8_SB(1, 1), cB + hstepB + kstep, voffB);
    PG8_WAIT_V(6); PG8_BAR;
    for (;;) {
        const bool has_next = S.next(ui + 1, nxt);
        const char* nA = has_next ? panelA(g, nxt.pm, tstepA) : cA; const char* nB = has_next ? (const char*)g.Bt + (size_t)nxt.pn * tstepB : cB;
        for (int t = 0; t < nt; t += 2) {
            const bool last = (t == nt - 2);
            const char* a1 = cA + KT(t + 1) * kstep;
            const char* a2 = last ? nA : cA + KT(t + 2) * kstep; const char* b2 = last ? nB : cB + KT(t + 2) * kstep;
            const char* a3 = last ? nA + kstep : cA + KT(t + 3) * kstep; const char* b3 = last ? nB + kstep : cB + KT(t + 3) * kstep;
            PG8_LDB(B0, 0, 0); PG8_LDB(B1, 0, 1); PG8_SCHED; PG8_LDA(At, 0, 0); PG8_STAGE(PG8_SA(1, 1), a1 + hstepA, voffA);
            PG8_WAIT_V(8); PG8_WAIT_L(0); PG8_BAR; PG8_MMA(0, 0, At, B0); PG8_MMA(0, 1, At, B1); PG8_BAR; PG8_SCHED;
            PG8_LDA(At, 0, 1); PG8_STAGE(PG8_SB(0, 0), b2, voffB); PG8_STAGE(PG8_SB(0, 1), b2 + hstepB, voffB); PG8_STAGE(PG8_SA(0, 0), a2, voffA);
            PG8_WAIT_V(8); PG8_WAIT_L(0); PG8_BAR; PG8_MMA(1, 0, At, B0); PG8_MMA(1, 1, At, B1); PG8_BAR; PG8_SCHED;
            PG8_LDB(B0, 1, 0); PG8_LDB(B1, 1, 1); PG8_SCHED; PG8_LDA(At, 1, 0); PG8_STAGE(PG8_SA(0, 1), a2 + hstepA, voffA);
            PG8_WAIT_V(8); PG8_WAIT_L(0); PG8_BAR; PG8_MMA(0, 0, At, B0); PG8_MMA(0, 1, At, B1); PG8_BAR; PG8_SCHED;
            PG8_LDA(At, 1, 1); PG8_STAGE(PG8_SB(1, 0), b3, voffB); PG8_STAGE(PG8_SB(1, 1), b3 + hstepB, voffB); PG8_STAGE(PG8_SA(1, 0), a3, voffA);
            PG8_WAIT_V(8); PG8_WAIT_L(0); PG8_BAR; PG8_MMA(1, 0, At, B0); PG8_MMA(1, 1, At, B1); PG8_BAR; PG8_SCHED;
        }
        if constexpr (ALIGN_EPI) { if (wr == 0) PG8_BAR; }
        E(acc, cur, wr, wc, fr, fq);
        if (!has_next) break;
#pragma unroll
        for (int a = 0; a < 2; ++a)
#pragma unroll
            for (int b = 0; b < 2; ++b)
#pragma unroll
                for (int m = 0; m < 4; ++m)
#pragma unroll
                    for (int n = 0; n < 2; ++n) acc[a][b][m][n] = (f32x4){0.f, 0.f, 0.f, 0.f};
        cur = nxt; cA = nA; cB = nB; ++ui;
        if constexpr (ALIGN_EPI) { if (wr == 1) PG8_BAR; }
    }
    PG8_WAIT_V(0);
    if constexpr (!ALIGN_EPI) { if (wr == 0) PG8_BAR; }
    PG8_BAR;
#undef KT
#undef PG8_SA
#undef PG8_SB
#undef PG8_STAGE
#undef PG8_LDA
#undef PG8_LDB
#undef PG8_MMA
#undef PG8_WAIT_V
#undef PG8_WAIT_L
#undef PG8_BAR
#undef PG8_SCHED
}
}

struct RsLds { const LAS float* tab; const LAS int* pml;
    __device__ __forceinline__ const LAS float* panel(int pm) const { const int p0 = pml[0], p1 = pml[1], p2 = pml[2]; const int slot = pm == p0 ? 0 : (pm == p1 ? 1 : (pm == p2 ? 2 : 3)); return tab + slot * 256; } };

template <int ACT  > __device__ __forceinline__ u32x4 proj_pack(const f32x4 a, const f32x4 b, float s) {
    const float v[8] = {a.x, a.y, a.z, a.w, b.x, b.y, b.z, b.w};
    if constexpr (ACT == 0) return pack8(v, s);
    else { const float s2 = s * -1.4426950408889634f; float e[8], o[8];
#pragma unroll
        for (int j = 0; j < 8; ++j) e[j] = __builtin_amdgcn_exp2f(v[j] * s2);
#pragma unroll
        for (int j = 0; j < 8; ++j) e[j] = __builtin_amdgcn_rcpf(1.0f + e[j]);
#pragma unroll
        for (int j = 0; j < 8; ++j) o[j] = ACT == 1 ? (v[j] * s) * e[j] : e[j];
        return pack8(o, 1.0f); }
}
template <int ACT> __device__ __forceinline__ void proj_rows(const f32x4 (&acc)[2][2][4][2], const LAS float* rt, LAS unsigned char* s, unsigned w0, unsigned w1, unsigned rd, bf16_t* tb, int ld, int r8, int c8) {
#pragma unroll
    for (int ai = 0; ai < 2; ++ai) {
        float sc[4];
#pragma unroll
        for (int m = 0; m < 4; ++m) sc[m] = rt[ai * 128 + m * 16];
#pragma unroll
        for (int mh = 0; mh < 2; ++mh) {
            u32x4 q[2][2];
#pragma unroll
            for (int mm = 0; mm < 2; ++mm) { const int m = 2 * mh + mm;
                *(LAS u32x4*)(s + w0) = proj_pack<ACT>(acc[ai][0][m][0], acc[ai][0][m][1], sc[m]);
                *(LAS u32x4*)(s + w1) = proj_pack<ACT>(acc[ai][1][m][0], acc[ai][1][m][1], sc[m]);
                q[mm][0] = *(const LAS u32x4*)(s + rd); q[mm][1] = *(const LAS u32x4*)(s + 1024 + rd); }
#pragma unroll
            for (int mm = 0; mm < 2; ++mm) { bf16_t* p = tb + (size_t)(ai * 128 + (2 * mh + mm) * 16 + r8) * ld + 8 * c8;
                st16_wt(p, q[mm][0]); st16_wt(p + (size_t)8 * ld, q[mm][1]); }
        }
    }
}
struct EpiProjT {
    static constexpr bool REPEATABLE = false;
    RsLds rs; bf16_t *patt, *pret, *prg, *pga, *pgr; LAS unsigned char* scr;
    __device__ __forceinline__ void operator()(const f32x4 (&acc)[2][2][4][2], const pg8::Unit& u, int wr, int wc, int fr, int fq) const {
        int lane_ = fq * 16 + fr; asm volatile("" : "+v"(lane_));
        const int wid = wr * 4 + wc, lane = lane_, r8 = lane >> 3, c8 = lane & 7; fr = lane & 15; fq = lane >> 4;
        LAS unsigned char* s = scr + wid * 2048;
        const int colw = u.pn * 256 + wc * 64; const size_t rowg = (size_t)u.pm * 256 + wr * 64;
        const unsigned w0 = (unsigned)fr * 128u + (((unsigned)fq ^ ((unsigned)fr & 7u)) << 4), w1 = (unsigned)fr * 128u + (((unsigned)(4 + fq) ^ ((unsigned)fr & 7u)) << 4);
        const unsigned rd = (unsigned)r8 * 128u + (((unsigned)c8 ^ (unsigned)r8) << 4);
        const LAS float* rt = rs.panel(u.pm) + wr * 64 + fr;
        if (colw < 768) proj_rows<0>(acc, rt, s, w0, w1, rd, patt + rowg * 768 + colw, 768, r8, c8);
        else if (colw < 2816) proj_rows<0>(acc, rt, s, w0, w1, rd, pret + rowg * 2048 + (colw - 768), 2048, r8, c8);
        else if (colw < 3840) proj_rows<1>(acc, rt, s, w0, w1, rd, prg + rowg * 1024 + (colw - 2816), 1024, r8, c8);
        else proj_rows<2>(acc, rt, s, w0, w1, rd, (colw < 4864 ? pga + (colw - 3840) : pgr + (colw - 4864)) + rowg * 1024, 1024, r8, c8);
    }
};
template <class Ap> struct Epi8Dual {
    static constexpr bool REPEATABLE = false; Ap ap;
    __device__ __forceinline__ void operator()(const f32x4 (&acc)[2][2][4][2], const pg8::Unit& u, int wr, int wc, int fr, int fq) const {
        const int row0 = u.pm * 256 + wr * 64 + fr, col0 = u.pn * 128 + wc * 32 + 8 * fq;
        const LAS float* rt = ap.rs.panel(u.pm); float sc[2][4];
#pragma unroll
        for (int ai = 0; ai < 2; ++ai)
#pragma unroll
            for (int m = 0; m < 4; ++m) sc[ai][m] = rt[ai * 128 + wr * 64 + m * 16 + fr];
#pragma unroll
        for (int ai = 0; ai < 2; ++ai)
#pragma unroll
            for (int m = 0; m < 4; ++m) { const f32x4 a = acc[ai][0][m][0], b = acc[ai][0][m][1], c = acc[ai][1][m][0], d = acc[ai][1][m][1];
                const float gv[8] = {a.x, a.y, a.z, a.w, b.x, b.y, b.z, b.w}, uv[8] = {c.x, c.y, c.z, c.w, d.x, d.y, d.z, d.w};
                ap.apply8(row0 + ai * 128 + m * 16, col0, sc[ai][m], gv, uv); }
    }
};
struct WaveTile {
    LAS unsigned char* s; unsigned w0, w1, rd; int r8, c8, fr, fq;
    __device__ __forceinline__ void init(LAS unsigned char* scr, int wr, int wc, int fr_, int fq_) {
        int lane_ = fq_ * 16 + fr_; asm volatile("" : "+v"(lane_));
        fr = lane_ & 15; fq = lane_ >> 4; r8 = lane_ >> 3; c8 = lane_ & 7; s = scr + (wr * 4 + wc) * 2048;
        w0 = (unsigned)fr * 128u + (((unsigned)fq ^ ((unsigned)fr & 7u)) << 4); w1 = (unsigned)fr * 128u + (((unsigned)(4 + fq) ^ ((unsigned)fr & 7u)) << 4);
        rd = (unsigned)r8 * 128u + (((unsigned)c8 ^ (unsigned)r8) << 4);
    }
    __device__ __forceinline__ void lines_to_acc(u32x4 l0, u32x4 l1, u32x4& a0, u32x4& a1) const { *(LAS u32x4*)(s + rd) = l0; *(LAS u32x4*)(s + 1024 + rd) = l1; a0 = *(const LAS u32x4*)(s + w0); a1 = *(const LAS u32x4*)(s + w1); }
    __device__ __forceinline__ void acc_to_lines(u32x4 a0, u32x4 a1, u32x4& l0, u32x4& l1) const { *(LAS u32x4*)(s + w0) = a0; *(LAS u32x4*)(s + w1) = a1; l0 = *(const LAS u32x4*)(s + rd); l1 = *(const LAS u32x4*)(s + 1024 + rd); }
};
struct EpiM1F {
    static constexpr bool REPEATABLE = false;
    const bf16_t* ga; bf16_t* m1; LAS unsigned char* scr;
    __device__ __forceinline__ void operator()(const f32x4 (&acc)[2][2][4][2], const pg8::Unit& u, int wr, int wc, int fr, int fq) const {
        WaveTile W; W.init(scr, wr, wc, fr, fq);
        const size_t base = ((size_t)u.pm * 256 + wr * 64 + W.r8) * 1024 + (u.pn * 256 + wc * 64) + 8 * W.c8;
#pragma unroll
        for (int ai = 0; ai < 2; ++ai)
#pragma unroll
            for (int mh = 0; mh < 2; ++mh) {
                u32x4 L[2][2];
#pragma unroll
                for (int mm = 0; mm < 2; ++mm) { const size_t o = base + (size_t)(ai * 128 + (2 * mh + mm) * 16) * 1024; L[mm][0] = *(const u32x4*)(ga + o); L[mm][1] = *(const u32x4*)(ga + o + 8 * 1024); }
#pragma unroll
                for (int mm = 0; mm < 2; ++mm) { const int m = 2 * mh + mm; u32x4 g0, g1, q0, q1; W.lines_to_acc(L[mm][0], L[mm][1], g0, g1);
                    float gv[8], o[8];
                    { unpack8(g0, gv); const f32x4 a = acc[ai][0][m][0], b = acc[ai][0][m][1]; const float v[8] = {a.x, a.y, a.z, a.w, b.x, b.y, b.z, b.w};
#pragma unroll
                      for (int j = 0; j < 8; ++j) o[j] = gv[j] * v[j];
                      g0 = pack8(o, 1.0f); }
                    { unpack8(g1, gv); const f32x4 a = acc[ai][1][m][0], b = acc[ai][1][m][1]; const float v[8] = {a.x, a.y, a.z, a.w, b.x, b.y, b.z, b.w};
#pragma unroll
                      for (int j = 0; j < 8; ++j) o[j] = gv[j] * v[j];
                      g1 = pack8(o, 1.0f); }
                    W.acc_to_lines(g0, g1, q0, q1);
                    const size_t oo = base + (size_t)(ai * 128 + m * 16) * 1024; *(u32x4*)(m1 + oo) = q0; *(u32x4*)(m1 + oo + 8 * 1024) = q1; }
            }
    }
};
struct EpiMrgF {
    static constexpr bool REPEATABLE = false;
    const bf16_t* gr; bf16_t* m1; LAS unsigned char* scr;
    __device__ __forceinline__ void operator()(const f32x4 (&acc)[2][2][4][2], const pg8::Unit& u, int wr, int wc, int fr, int fq) const {
        WaveTile W; W.init(scr, wr, wc, fr, fq);
        const size_t base = ((size_t)u.pm * 256 + wr * 64 + W.r8) * 1024 + (u.pn * 256 + wc * 64) + 8 * W.c8;
#pragma unroll
        for (int ai = 0; ai < 2; ++ai)
#pragma unroll
            for (int mh = 0; mh < 2; ++mh) {
                u32x4 L[2][2], M[2][2];
#pragma unroll
                for (int mm = 0; mm < 2; ++mm) { const size_t o = base + (size_t)(ai * 128 + (2 * mh + mm) * 16) * 1024;
                    L[mm][0] = *(const u32x4*)(gr + o); L[mm][1] = *(const u32x4*)(gr + o + 8 * 1024); M[mm][0] = *(const u32x4*)(m1 + o); M[mm][1] = *(const u32x4*)(m1 + o + 8 * 1024); }
#pragma unroll
                for (int mm = 0; mm < 2; ++mm) { const int m = 2 * mh + mm; u32x4 g0, g1, p0, p1, q0, q1; W.lines_to_acc(L[mm][0], L[mm][1], g0, g1); W.lines_to_acc(M[mm][0], M[mm][1], p0, p1);
                    float gv[8], mv[8], o[8];
                    { unpack8(g0, gv); unpack8(p0, mv); const f32x4 a = acc[ai][0][m][0], b = acc[ai][0][m][1]; const float v[8] = {a.x, a.y, a.z, a.w, b.x, b.y, b.z, b.w};
#pragma unroll
                      for (int j = 0; j < 8; ++j) o[j] = mv[j] + gv[j] * v[j];
                      g0 = pack8(o, 1.0f); }
                    { unpack8(g1, gv); unpack8(p1, mv); const f32x4 a = acc[ai][1][m][0], b = acc[ai][1][m][1]; const float v[8] = {a.x, a.y, a.z, a.w, b.x, b.y, b.z, b.w};
#pragma unroll
                      for (int j = 0; j < 8; ++j) o[j] = mv[j] + gv[j] * v[j];
                      g1 = pack8(o, 1.0f); }
                    W.acc_to_lines(g0, g1, q0, q1);
                    const size_t oo = base + (size_t)(ai * 128 + m * 16) * 1024; st16_wt(m1 + oo, q0); st16_wt(m1 + oo + 8 * 1024, q1); }
            }
    }
};
struct EpiResF {
    static constexpr bool REPEATABLE = false;
    bf16_t* xb; float* ssp; LAS unsigned char* scr;
    __device__ __forceinline__ void operator()(const f32x4 (&acc)[2][2][4][2], const pg8::Unit& u, int wr, int wc, int fr, int fq) const {
        WaveTile W; W.init(scr, wr, wc, fr, fq);
        const size_t base = ((size_t)u.pm * 256 + wr * 64 + W.r8) * D + (u.pn * 256 + wc * 64) + 8 * W.c8;
#pragma unroll
        for (int ai = 0; ai < 2; ++ai) {
            float ssm[4];
#pragma unroll
            for (int mh = 0; mh < 2; ++mh) {
                u32x4 L[2][2];
#pragma unroll
                for (int mm = 0; mm < 2; ++mm) { const size_t o = base + (size_t)(ai * 128 + (2 * mh + mm) * 16) * D; L[mm][0] = *(const u32x4*)(xb + o); L[mm][1] = *(const u32x4*)(xb + o + 8 * D); }
#pragma unroll
                for (int mm = 0; mm < 2; ++mm) { const int m = 2 * mh + mm; u32x4 b0, b1, q0, q1; W.lines_to_acc(L[mm][0], L[mm][1], b0, b1); float ss = 0.f;
                    { float x[8]; unpack8(b0, x); const f32x4 a = acc[ai][0][m][0], b = acc[ai][0][m][1];
                      x[0] += a.x; x[1] += a.y; x[2] += a.z; x[3] += a.w; x[4] += b.x; x[5] += b.y; x[6] += b.z; x[7] += b.w; b0 = pack8(x, 1.0f);
                      ss += (x[0] * x[0] + x[1] * x[1]) + (x[2] * x[2] + x[3] * x[3]) + (x[4] * x[4] + x[5] * x[5]) + (x[6] * x[6] + x[7] * x[7]); }
                    { float x[8]; unpack8(b1, x); const f32x4 a = acc[ai][1][m][0], b = acc[ai][1][m][1];
                      x[0] += a.x; x[1] += a.y; x[2] += a.z; x[3] += a.w; x[4] += b.x; x[5] += b.y; x[6] += b.z; x[7] += b.w; b1 = pack8(x, 1.0f);
                      ss += (x[0] * x[0] + x[1] * x[1]) + (x[2] * x[2] + x[3] * x[3]) + (x[4] * x[4] + x[5] * x[5]) + (x[6] * x[6] + x[7] * x[7]); }
                    ss += __shfl_xor(ss, 16); ss += __shfl_xor(ss, 32); ssm[m] = ss;
                    W.acc_to_lines(b0, b1, q0, q1);
                    const size_t oo = base + (size_t)(ai * 128 + m * 16) * D; st16_wt(xb + oo, q0); st16_wt(xb + oo + 8 * D, q1); }
            }
            { const float sel = W.fq == 0 ? ssm[0] : (W.fq == 1 ? ssm[1] : (W.fq == 2 ? ssm[2] : ssm[3]));
              ssp[((size_t)u.pm * 256 + wr * 64 + ai * 128 + W.fq * 16 + W.fr) * 16 + u.pn * 4 + wc] = sel; }
        }
    }
};

constexpr int NWAVES = 8;
constexpr int RING_OFF = 0, RING_BYTES = 131072;
constexpr int RS_OFF = RING_BYTES;
constexpr int EPI_OFF = RS_OFF + 4096;
constexpr int LDSCTL_OFF = 157696;   static_assert(LDSCTL_OFF >= mx::RT_END, "LDS map");
constexpr int LDS_BYTES = 158720;
constexpr size_t CTL_ZERO_BYTES = 131072;
constexpr int CW_BAR = 4096;
#define XB_TMO      128
#define XB_XCNT(j)  (256  + 64 * (j))
#define XB_XSUB(j)  (1280 + 64 * (j))
#define XB_XGEN(j)  (2304 + 64 * (j))
#define XB_TOP      3328
#define XB_TOPGEN   3392
#define XCD_BAR_WORDS 3456
#define XB_SPIN_CAP (1u << 22)
__device__ __forceinline__ unsigned xb_ld(unsigned* p)              { return __hip_atomic_load(p, __ATOMIC_RELAXED, __HIP_MEMORY_SCOPE_AGENT); }
__device__ __forceinline__ unsigned xb_add(unsigned* p, unsigned v) { return __hip_atomic_fetch_add(p, v, __ATOMIC_RELAXED, __HIP_MEMORY_SCOPE_AGENT); }
__device__ __forceinline__ unsigned xb_xcc_id() { return (unsigned)__builtin_amdgcn_s_getreg((3 << 11) | 20) & 0xFu; }
#define XB_SPIN(cond, bar) do { unsigned _sp = 0; while (cond) { __builtin_amdgcn_s_sleep(1); \
    if ((++_sp & 255u) == 0u) { if (xb_ld(&(bar)[XB_TMO])) break; if (_sp > XB_SPIN_CAP) { atomicAdd(&(bar)[XB_TMO], 1u); break; } } } } while (0)
struct XcdBarrier { unsigned* bar; unsigned x; volatile LAS unsigned* st; };
__device__ __forceinline__ XcdBarrier xcd_barrier_post(unsigned* bar, volatile LAS unsigned* st) {
    XcdBarrier b; b.bar = bar; b.x = xb_xcc_id(); b.st = st;
    if (threadIdx.x == 0) st[3] = xb_add(&bar[XB_XCNT(b.x)], 1u);
    return b;
}
__device__ __forceinline__ void xcd_barrier_complete(unsigned* bar, unsigned x, unsigned& nloc, unsigned& nx, unsigned& regular) {
    const unsigned G = gridDim.x * gridDim.y * gridDim.z;
    unsigned sum, cnt, mine, reg, sp = 0u;
    for (;;) {
        sum = 0u; cnt = 0u; mine = 0u; reg = (G % 8u == 0u) ? 1u : 0u;
#pragma unroll
        for (unsigned j = 0; j < 16; ++j) { const unsigned c = xb_ld(&bar[XB_XCNT(j)]); sum += c; cnt += (c > 0u) ? 1u : 0u; mine = (j == x) ? c : mine; reg = (c == (j < 8u ? G / 8u : 0u)) ? reg : 0u; }
        if (sum == G) break;
        __builtin_amdgcn_s_sleep(1);
        if ((++sp & 255u) == 0u) { if (xb_ld(&bar[XB_TMO])) break; if (sp > XB_SPIN_CAP) { atomicAdd(&bar[XB_TMO], 1u); break; } }
    }
    nloc = mine > 0u ? mine : 1u; nx = cnt > 0u ? cnt : 1u; regular = reg;
}
__device__ __forceinline__ void xcd_barrier(const XcdBarrier& b, int wave, bool local = false) {
    asm volatile("s_waitcnt vmcnt(0)" ::: "memory");
    __syncthreads();
    if (tid_from_wave(wave) == 0) {
        unsigned* bar = b.bar;
        __builtin_amdgcn_s_waitcnt(0);
        unsigned nloc = b.st[0], nx = b.st[1];
        if (nloc == 0u) { unsigned reg; xcd_barrier_complete(bar, b.x, nloc, nx, reg); b.st[0] = nloc; b.st[1] = nx; b.st[2] = reg; }
        const unsigned old = xb_add(&bar[XB_XSUB(b.x)], 1u);
        const unsigned gen = old / nloc;
        if (old + 1u == (gen + 1u) * nloc) {
            if (!local) { __builtin_amdgcn_fence(__ATOMIC_RELEASE, "agent"); asm volatile("s_waitcnt vmcnt(0)" ::: "memory"); }
            if (!local) {
                const unsigned og = xb_add(&bar[XB_TOP], 1u);
                const unsigned tg = og / nx;
                __builtin_amdgcn_fence(__ATOMIC_ACQUIRE, "agent");
                if (og + 1u == (tg + 1u) * nx) xb_add(&bar[XB_TOPGEN], 1u);
                else XB_SPIN(xb_ld(&bar[XB_TOPGEN]) == tg, bar);
            } else __builtin_amdgcn_fence(__ATOMIC_ACQUIRE, "agent");
            xb_add(&bar[XB_XGEN(b.x)], 1u);
            asm volatile("s_waitcnt vmcnt(0)" ::: "memory");
        } else {
            __builtin_amdgcn_fence(__ATOMIC_ACQUIRE, "agent");
            XB_SPIN(xb_ld(&bar[XB_XGEN(b.x)]) == gen, bar);
            asm volatile("s_waitcnt vmcnt(0)" ::: "memory");
        }
    }
    __syncthreads();
}

template <class Sched>
__device__ __forceinline__ void build_rstd_table(LAS unsigned char* lds, const Sched& S, const float* ssp, int wave) {
    LAS float* tab = (LAS float*)(lds + RS_OFF); volatile LAS int* pml = (volatile LAS int*)(lds + LDSCTL_OFF);
    int p0 = -1, p1 = -1, p2 = -1, p3 = -1; pg8::Unit u;
    for (int i = 0; S.next(i, u); ++i) { const int pm = u.pm; if (pm == p0 || pm == p1 || pm == p2 || pm == p3) continue;
        if (p0 < 0) p0 = pm; else if (p1 < 0) p1 = pm; else if (p2 < 0) p2 = pm; else if (p3 < 0) p3 = pm; }
    int t0_ = tid_from_wave(wave); asm volatile("" : "+v"(t0_));
    if (t0_ == 0) { pml[0] = p0; pml[1] = p1; pml[2] = p2; pml[3] = p3; }
    for (int idx = t0_; idx < 1024; idx += NWAVES * 64) { const int slot = idx >> 8; const int pm = slot == 0 ? p0 : (slot == 1 ? p1 : (slot == 2 ? p2 : p3));
        if (pm >= 0) { const f32x4* q = (const f32x4*)(ssp + (size_t)(pm * 256 + (idx & 255)) * 16); const f32x4 a = q[0], b = q[1], c = q[2], d = q[3];
            const float s = ((a.x + a.y) + (a.z + a.w)) + ((b.x + b.y) + (b.z + b.w)) + ((c.x + c.y) + (c.z + c.w)) + ((d.x + d.y) + (d.z + d.w));
            tab[idx] = rsqrtf(s * (1.0f / D) + EPS); } }
    __syncthreads();
}

__device__ __forceinline__ void st4_wt(void* p, float v) { asm volatile("global_store_dword %0, %1, off sc0 sc1\n\ts_nop 1" :: "v"(p), "v"(v) : "memory"); }
__device__ __forceinline__ void ld16x8_sys(f32x4 (&v)[8], const float* const (&p)[8]) {
    asm volatile("global_load_dwordx4 %0, %8, off sc0 sc1\n\tglobal_load_dwordx4 %1, %9, off sc0 sc1\n\tglobal_load_dwordx4 %2, %10, off sc0 sc1\n\tglobal_load_dwordx4 %3, %11, off sc0 sc1\n\t"
                 "global_load_dwordx4 %4, %12, off sc0 sc1\n\tglobal_load_dwordx4 %5, %13, off sc0 sc1\n\tglobal_load_dwordx4 %6, %14, off sc0 sc1\n\tglobal_load_dwordx4 %7, %15, off sc0 sc1\n\t"
                 "s_waitcnt vmcnt(0)"
                 : "=&v"(v[0]), "=&v"(v[1]), "=&v"(v[2]), "=&v"(v[3]), "=&v"(v[4]), "=&v"(v[5]), "=&v"(v[6]), "=&v"(v[7])
                 : "v"(p[0]), "v"(p[1]), "v"(p[2]), "v"(p[3]), "v"(p[4]), "v"(p[5]), "v"(p[6]), "v"(p[7]) : "memory"); }
constexpr int CW_CONV = 18432;
constexpr int CW_FIN = 16384;
struct EpiFinal {
    static constexpr bool REPEATABLE = false;
    const bf16_t* xb; float* ssp; const float* gfin; float* out; unsigned* cnt; LAS unsigned char* scr;
    __device__ __forceinline__ void operator()(f32x4 (&acc)[2][2][4][2], const pg8::Unit& u, int wr, int wc, int fr_, int fq_) const {
        WaveTile W; W.init(scr, wr, wc, fr_, fq_);
        const int fr = W.fr, fq = W.fq;
        const size_t rowb = (size_t)u.pm * 256 + wr * 64; const int colb = u.pn * 256 + wc * 64;
        const size_t base = (rowb + W.r8) * D + colb + 8 * W.c8;
#pragma unroll
        for (int ai = 0; ai < 2; ++ai) {
            float ssm[4];
#pragma unroll
            for (int mh = 0; mh < 2; ++mh) {
                u32x4 L[2][2];
#pragma unroll
                for (int mm = 0; mm < 2; ++mm) { const size_t o = base + (size_t)(ai * 128 + (2 * mh + mm) * 16) * D; L[mm][0] = *(const u32x4*)(xb + o); L[mm][1] = *(const u32x4*)(xb + o + 8 * D); }
#pragma unroll
                for (int mm = 0; mm < 2; ++mm) { const int m = 2 * mh + mm; u32x4 b0, b1; W.lines_to_acc(L[mm][0], L[mm][1], b0, b1); float ss = 0.f;
#pragma unroll
                    for (int bj = 0; bj < 2; ++bj) { float x[8]; unpack8(bj == 0 ? b0 : b1, x); f32x4& a = acc[ai][bj][m][0]; f32x4& b = acc[ai][bj][m][1];
                        a.x += x[0]; a.y += x[1]; a.z += x[2]; a.w += x[3]; b.x += x[4]; b.y += x[5]; b.z += x[6]; b.w += x[7];
                        ss += (a.x * a.x + a.y * a.y) + (a.z * a.z + a.w * a.w) + (b.x * b.x + b.y * b.y) + (b.z * b.z + b.w * b.w); }
                    ss += __shfl_xor(ss, 16); ss += __shfl_xor(ss, 32); ssm[m] = ss; }
            }
            const float sel = fq == 0 ? ssm[0] : (fq == 1 ? ssm[1] : (fq == 2 ? ssm[2] : ssm[3]));
            st4_wt(ssp + (rowb + ai * 128 + fq * 16 + fr) * 16 + u.pn * 4 + wc, sel);
        }
        asm volatile("s_waitcnt vmcnt(0)" ::: "memory");
        unsigned* c = cnt + u.pm * 16;
        if (fr_ == 0 && fq_ == 0) (void)xb_add(c, 1u);
        { unsigned sp = 0; while (xb_ld(c) < 32u) { __builtin_amdgcn_s_sleep(1); if (++sp > XB_SPIN_CAP) break; } }
        float rs[2][4]; f32x4 pp[8]; const float* pa[8];
#pragma unroll
        for (int i = 0; i < 8; ++i) pa[i] = ssp + (rowb + (i >> 2) * 128 + (i & 3) * 16 + fr) * 16 + 4 * fq;
        ld16x8_sys(pp, pa);
#pragma unroll
        for (int i = 0; i < 8; ++i) { const f32x4 p = pp[i]; float t = (p.x + p.y) + (p.z + p.w); t += __shfl_xor(t, 16); t += __shfl_xor(t, 32); rs[i >> 2][i & 3] = rsqrtf(t * (1.0f / D) + EPS); }
        const unsigned v0 = (unsigned)fr * 128u + ((((unsigned)(2 * fq)) ^ ((unsigned)fr & 7u)) << 4), v1 = (unsigned)fr * 128u + ((((unsigned)(2 * fq + 1)) ^ ((unsigned)fr & 7u)) << 4);
#pragma unroll
        for (int bj = 0; bj < 2; ++bj) {
            const f32x4 g0 = *(const f32x4*)(gfin + colb + 32 * bj + 8 * fq), g1 = *(const f32x4*)(gfin + colb + 32 * bj + 8 * fq + 4);
            float* ob = out + (rowb + W.r8) * D + colb + 32 * bj + 4 * W.c8;
#pragma unroll
            for (int ai = 0; ai < 2; ++ai)
#pragma unroll
                for (int m = 0; m < 4; ++m) { const float r = rs[ai][m]; const f32x4 a = acc[ai][bj][m][0], b = acc[ai][bj][m][1];
                    *(LAS f32x4*)(W.s + v0) = (f32x4){a.x * r * g0.x, a.y * r * g0.y, a.z * r * g0.z, a.w * r * g0.w};
                    *(LAS f32x4*)(W.s + v1) = (f32x4){b.x * r * g1.x, b.y * r * g1.y, b.z * r * g1.z, b.w * r * g1.w};
                    const f32x4 q0 = *(const LAS f32x4*)(W.s + W.rd), q1 = *(const LAS f32x4*)(W.s + 1024 + W.rd);
                    float* o = ob + (size_t)(ai * 128 + m * 16) * D; *(f32x4*)o = q0; *(f32x4*)(o + (size_t)8 * D) = q1; }
        }
    }
};

struct RstdPre { LAS unsigned char* lds; const pg8::StaticOrder* S; const float* ssp; int wave;
    __device__ __forceinline__ void operator()() const { build_rstd_table(lds, *S, ssp, wave); } };
constexpr int PH_PRO = 0, PH_FIN = 1 + 6 * DEPTH, NPH = PH_FIN + 1;
struct Args { const float* in[13]; float* out; unsigned char* ws; int ph_lo, ph_hi, li, pad; };
__global__ void __launch_bounds__(NWAVES * 64, 2) mega(Args args) {
    extern __shared__ __attribute__((aligned(16))) unsigned char lds_raw[];
    LAS unsigned char* lds = (LAS unsigned char*)lds_raw;
    const int tid = threadIdx.x, wave = __builtin_amdgcn_readfirstlane(tid >> 6);
    const int G = gridDim.x, bx = blockIdx.x, vcu = (G % 8 == 0) ? (bx % 8) * (G / 8) + bx / 8 : bx;
    unsigned char* ws = args.ws;
    for (int u = tid; u < 512 / 4; u += NWAVES * 64) ((LAS unsigned*)(lds + LDSCTL_OFF))[u] = 0u;
    __syncthreads();
    XcdBarrier bar = xcd_barrier_post((unsigned*)(ws + WS_CTL) + CW_BAR + args.li * XCD_BAR_WORDS, (volatile LAS unsigned*)(lds + LDSCTL_OFF) + 8);
    float* xf = args.out; bf16_t* xb = (bf16_t*)(ws + WS_XB); float* ssp = (float*)(ws + WS_SSP);
    bf16_t* patt = (bf16_t*)(ws + WS_PATT); bf16_t* pret = (bf16_t*)(ws + WS_PRET); bf16_t* prg = (bf16_t*)(ws + WS_PRG);
    bf16_t* pga = (bf16_t*)(ws + WS_PGA); bf16_t* pgr = (bf16_t*)(ws + WS_PGR); bf16_t* m1 = pga  ; bf16_t* act = (bf16_t*)(ws + WS_ACT);
    const int gw = vcu * NWAVES + wave, ngw = G * NWAVES;
    const RsLds rs{(const LAS float*)(lds + RS_OFF), (const LAS int*)(lds + LDSCTL_OFF)};

    const int lo = args.ph_lo, hi = args.ph_hi;
    const bool full = lo == 0 && hi == NPH;
    const bool fuse_fin = (G % 128 == 0) && full;
#define IN(k) (lo <= (k) && (k) < hi)
#define SEAM(k) do { if (IN(k) && IN((k) + 1)) xcd_barrier(bar, wave); } while (0)
#define SEAM_L(k) do { if (IN(k) && IN((k) + 1)) xcd_barrier(bar, wave, xl); } while (0)
    if (IN(PH_PRO)) {
        int tl_ = tid_from_wave(wave); asm volatile("" : "+v"(tl_)); const int lane = tl_ & 63;
        WPtrs P{args.in[1], args.in[2], args.in[5], args.in[6], args.in[7], args.in[8], args.in[9], args.in[10], args.in[11], args.in[4]};
        prologue_weights(P, ws, (float*)(lds_raw + wave * 16384), gw, ngw, lane, 0, PRO_I_IN0);
        const float* x = args.in[0];
        for (int t0 = gw * 4; t0 < T; t0 += ngw * 4) {
            f32x4 v[4][4];
#pragma unroll
            for (int rr = 0; rr < 4; ++rr) { const f32x4* xr = (const f32x4*)(x + (size_t)(t0 + rr) * D) + lane;
#pragma unroll
                for (int j = 0; j < 4; ++j) v[rr][j] = xr[64 * j]; }
#pragma unroll
            for (int rr = 0; rr < 4; ++rr) { const int t = t0 + rr; float s = 0.f;
#pragma unroll
                for (int j = 0; j < 4; ++j) s += (v[rr][j].x * v[rr][j].x + v[rr][j].y * v[rr][j].y) + (v[rr][j].z * v[rr][j].z + v[rr][j].w * v[rr][j].w);
                s = wave_sum(s);
                unsigned long long* o8 = (unsigned long long*)(xb + (size_t)t * D) + lane;
#pragma unroll
                for (int j = 0; j < 4; ++j) o8[64 * j] = (unsigned long long)pk2(v[rr][j].x, v[rr][j].y) | ((unsigned long long)pk2(v[rr][j].z, v[rr][j].w) << 32);
                if (lane < 16) ssp[(size_t)t * 16 + lane] = lane == 0 ? s : 0.f; }
        }
    }
    SEAM(PH_PRO);
    const bool xl = (G == 256) && (((volatile LAS unsigned*)(lds + LDSCTL_OFF))[10] != 0u);
    const int vb = xl ? (int)(((volatile LAS unsigned*)(lds + LDSCTL_OFF))[11] * 8u + bar.x) : bx;
    for (int l = 0; l < DEPTH; ++l) {
        const int pb = 1 + 6 * l;
        const unsigned char* wl = ws + WS_W + (size_t)l * W_LAYER;
        if (IN(pb + 0)) {
            pg8::StaticOrder S; S.init(T, DIN, G, vb);
            const pg8::Gemm g{xb, (const bf16_t*)(wl + W_IN), D, D, T, DIN, D};
            const EpiProjT E{rs, patt, pret, prg, pga, pgr, lds + EPI_OFF};
            pg8::gemm_phase<EpiProjT, pg8::StaticOrder, true>(lds + RING_OFF, g, S, E, wave, RstdPre{lds, &S, ssp, wave});
            if (2 * vb >= G) {
                int tl_ = tid_from_wave(wave); asm volatile("" : "+v"(tl_));
                WPtrs P{args.in[1], args.in[2], args.in[5], args.in[6], args.in[7], args.in[8], args.in[9], args.in[10], args.in[11], args.in[4]};
                prologue_weights(P, ws, (float*)(lds_raw + wave * 16384), (vb - G / 2) * NWAVES + wave, (G - G / 2) * NWAVES, tl_ & 63,
                                 l == 0 ? PRO_I_IN0 : PRO_PER_LAYER + PRO_I_IN0, l == 0 ? PRO_PER_LAYER + PRO_I_IN0 : 2 * PRO_PER_LAYER);
                asm volatile("s_waitcnt vmcnt(0)" ::: "memory");
                if ((tl_ & 63) == 0) (void)xb_add((unsigned*)(ws + WS_CTL) + CW_CONV + 16 * l, 1u);
            }
        }
        if (IN(pb + 0) && IN(pb + 1)) xcd_barrier(bar, wave, xl && full);
        if (IN(pb + 1)) mixer_phase_impl<3>(lds, ws, args.in[3] + l * AH, args.in[4] + l * RH * RDV, vb, G, patt, prg, wave, xl);
        if (full && IN(pb + 1) && IN(pb + 2) && tid_from_wave(wave) == 0) { unsigned* cw = (unsigned*)(ws + WS_CTL) + CW_CONV + 16 * l; const unsigned need = (unsigned)((G - G / 2) * NWAVES);
            unsigned sp = 0; while (xb_ld(cw) < need) { __builtin_amdgcn_s_sleep(1); if (++sp > XB_SPIN_CAP) break; } }
        SEAM_L(pb + 1);
        if (IN(pb + 2)) {
            pg8::StaticOrder S; S.init(T, D, G, vb);
            { const pg8::Gemm g{patt, (const bf16_t*)(wl + W_AO), 768, 512, T, D, 512}; const EpiM1F E{pga, m1, lds + EPI_OFF};
              pg8::gemm_phase<EpiM1F, pg8::StaticOrder, true>(lds + RING_OFF, g, S, E, wave); }
            { const pg8::Gemm g{prg, (const bf16_t*)(wl + W_RO), D, D, T, D, D}; const EpiMrgF E{pgr, m1, lds + EPI_OFF};
              pg8::gemm_phase<EpiMrgF, pg8::StaticOrder, true>(lds + RING_OFF, g, S, E, wave); }
        }
        SEAM_L(pb + 2);
        if (IN(pb + 3)) {
            pg8::StaticOrder S; S.init(T, D, G, vb);
            const pg8::Gemm g{m1, (const bf16_t*)(wl + W_OUT), D, D, T, D, D}; const EpiResF E{xb, ssp, lds + EPI_OFF};
            pg8::gemm_phase<EpiResF, pg8::StaticOrder, true>(lds + RING_OFF, g, S, E, wave);
        }
        SEAM_L(pb + 3);
        if (IN(pb + 4)) {
            pg8::StaticOrder S; S.init(T, 2 * DFF, G, vb);
            const pg8::Gemm g{xb, (const bf16_t*)(wl + W_GU), D, D, T, 2 * DFF, D}; const Epi8Dual<EpiAct<RsLds>> E{{rs, act}};
            pg8::gemm_phase<Epi8Dual<EpiAct<RsLds>>, pg8::StaticOrder, true>(lds + RING_OFF, g, S, E, wave, RstdPre{lds, &S, ssp, wave});
        }
        SEAM_L(pb + 4);
        if (IN(pb + 5)) {
            pg8::StaticOrder S; S.init(T, D, G, vb);
            const pg8::Gemm g{act, (const bf16_t*)(wl + W_DN), DFF, DFF, T, D, DFF, true};
            if (l == DEPTH - 1 && fuse_fin) { const EpiFinal E{xb, (float*)(ws + WS_SSP2), args.in[12], xf, (unsigned*)(ws + WS_CTL) + CW_FIN, lds + EPI_OFF};
                pg8::gemm_phase<EpiFinal, pg8::StaticOrder, true>(lds + RING_OFF, g, S, E, wave); }
            else { const EpiResF E{xb, ssp, lds + EPI_OFF};
                pg8::gemm_phase<EpiResF, pg8::StaticOrder, true>(lds + RING_OFF, g, S, E, wave); }
        }
        if (l < DEPTH - 1) SEAM_L(pb + 5); else if (!fuse_fin) SEAM(pb + 5);
    }
    if (IN(PH_FIN) && !fuse_fin) {
        int tl_ = tid_from_wave(wave); asm volatile("" : "+v"(tl_)); const int lane = tl_ & 63;
        const float* g = args.in[12];
        for (int t = gw; t < T; t += ngw) {
            const u32x4* xr = (const u32x4*)(xb + (size_t)t * D) + lane; u32x4 w[2]; float v[2][8]; float s = 0.f;
#pragma unroll
            for (int j = 0; j < 2; ++j) { w[j] = xr[64 * j]; unpack8(w[j], v[j]);
#pragma unroll
                for (int e = 0; e < 8; ++e) s += v[j][e] * v[j][e]; }
            s = wave_sum(s); const float r = rsqrtf(s * (1.0f / D) + EPS);
#pragma unroll
            for (int j = 0; j < 2; ++j) { const f32x4* gr = (const f32x4*)(g + 512 * j + 8 * lane); f32x4* o = (f32x4*)(xf + (size_t)t * D + 512 * j + 8 * lane); const f32x4 g0 = gr[0], g1 = gr[1];
                o[0] = (f32x4){v[j][0] * r * g0.x, v[j][1] * r * g0.y, v[j][2] * r * g0.z, v[j][3] * r * g0.w};
                o[1] = (f32x4){v[j][4] * r * g1.x, v[j][5] * r * g1.y, v[j][6] * r * g1.z, v[j][7] * r * g1.w}; }
        }
    }
#undef IN
#undef SEAM
#undef SEAM_L
}
extern "C" void kernel_launch(void* const* d_in, const int* in_sizes, int n_in, void* d_out, int out_size, void* d_ws, size_t ws_size, hipStream_t stream) {
    static int grid = 0;
    if (grid == 0) {
        if (n_in != 13 || in_sizes[0] != T * D || out_size != T * D || ws_size < WS_END) { fprintf(stderr, "kernel_launch: bad arguments (n_in %d, out %d, ws %zu)\n", n_in, out_size, ws_size); grid = -1; return; }
        int dev = 0, cus = 0, per_cu = 0;
        if (hipGetDevice(&dev) != hipSuccess || hipDeviceGetAttribute(&cus, hipDeviceAttributeMultiprocessorCount, dev) != hipSuccess) { grid = -1; return; }
        if (hipFuncSetAttribute((const void*)mega, hipFuncAttributeMaxDynamicSharedMemorySize, LDS_BYTES) != hipSuccess) { fprintf(stderr, "kernel_launch: hipFuncSetAttribute failed\n"); grid = -1; return; }
        if (hipOccupancyMaxActiveBlocksPerMultiprocessor(&per_cu, (const void*)mega, NWAVES * 64, LDS_BYTES) != hipSuccess || per_cu < 1) { fprintf(stderr, "kernel_launch: occupancy query says %d\n", per_cu); grid = -1; (void)hipGetLastError(); return; }
        grid = cus;
    }
    if (grid < 0) return;
    (void)hipMemsetAsync((char*)d_ws + WS_CTL, 0, CTL_ZERO_BYTES, stream);
    Args a{};
    for (int i = 0; i < 13; ++i) a.in[i] = (const float*)d_in[i];
    a.out = (float*)d_out; a.ws = (unsigned char*)d_ws; a.ph_lo = 0; a.ph_hi = NPH; a.li = 0;
    hipLaunchKernelGGL(mega, dim3(grid), dim3(NWAVES * 64), LDS_BYTES, stream, a);
}
```
